# Optimizing an MI355X kernel written in HIP

```python
import math
import jax, jax.numpy as jnp
from jax import lax
import numpy as np

D_MODEL = 1024
BATCH = 4
SEQ = 4096
DEPTH = 2

MEM_LEN = 256
EPS = 1e-6
NEG = -1e30
BLK = 128

DIL_HEADS = 8
DIL_HEAD_DIM = 64
DIL_PATTERNS = ((128, 1), (512, 4), (2048, 16))
RET_HEADS = 4
RET_KEY_DIM = 64
RET_VAL_DIM = 128
ROPE_BASE = 10000.0
DIFF_HEADS = 4
DIFF_HEAD_DIM = 64
SSM_D_INNER = 512
SSM_HEAD_DIM = 64
SSM_HEADS = SSM_D_INNER // SSM_HEAD_DIM
SSM_GROUPS = 2
SSM_STATE = 128
SSM_CONV = 4
N_BRANCH = 4
BRANCH_WIDTH = 512
X_HEADS = 4
X_HEAD_DIM = 128
FFN_HIDDEN = -(-8 * D_MODEL // (3 * 256)) * 256

A_QKV = DIL_HEADS * DIL_HEAD_DIM
B_QK = RET_HEADS * RET_KEY_DIM
B_VG = RET_HEADS * RET_VAL_DIM
C_QK = DIFF_HEADS * 2 * DIFF_HEAD_DIM
C_V = DIFF_HEADS * 2 * DIFF_HEAD_DIM
D_XBC = SSM_D_INNER + 2 * SSM_GROUPS * SSM_STATE
IN_SPLITS = (A_QKV, A_QKV, A_QKV, B_QK, B_QK, B_VG, B_VG, C_QK, C_QK, C_V,
             SSM_D_INNER, D_XBC, SSM_HEADS, N_BRANCH * D_MODEL)
IN_WIDTH = sum(IN_SPLITS)

kernel_name = 'hybrid_gated_parallel_mixer_trunk'


def rmsnorm(x, g):
    xf = x.astype(jnp.float32)
    y = xf * lax.rsqrt(jnp.mean(xf * xf, axis=-1, keepdims=True) + EPS)
    return (y * g.astype(jnp.float32)).astype(x.dtype)


def split_cols(h, sizes):
    offs = np.cumsum(sizes)[:-1].tolist()
    return jnp.split(h, offs, axis=-1)


def band_attention(q, k, v, w):
    *lead, L, hd = q.shape
    nb = L // BLK
    qb = q.reshape(*lead, nb, BLK, hd)

    def windows(t):
        tb = t.reshape(*lead, nb, BLK, t.shape[-1])
        tp = jnp.pad(tb, [(0, 0)] * len(lead) + [(1, 0), (0, 0), (0, 0)])
        return jnp.concatenate([tp[..., :-1, :, :], tp[..., 1:, :, :]], axis=-2)

    kw, vw = windows(k), windows(v)
    s = jnp.einsum('...nqd,...nkd->...nqk', qb, kw).astype(jnp.float32) * (hd ** -0.5)
    blk = jnp.arange(nb)[:, None, None]
    qpos = blk * BLK + jnp.arange(BLK)[None, :, None]
    kpos = (blk - 1) * BLK + jnp.arange(2 * BLK)[None, None, :]
    dist = qpos - kpos
    mask = (dist >= 0) & (dist <= w) & (kpos >= 0)
    s = jnp.where(mask, s, NEG)
    m = jnp.max(s, axis=-1, keepdims=True)
    p = jnp.exp(s - m)
    den = jnp.sum(p, axis=-1, keepdims=True)
    o = jnp.einsum('...nqk,...nkd->...nqd', (p / den).astype(v.dtype), vw)
    lse = (m + jnp.log(den))[..., 0]
    return o.reshape(*lead, L, hd), lse.reshape(*lead, L)


def dilated_attention(q, k, v):
    Bsz, S, H, hd = q.shape
    outs, lses = [], []
    for window, dil in DIL_PATTERNS:
        L = S // dil
        Lp = -(-L // BLK) * BLK

        def strided(t):
            t = t.reshape(Bsz, L, dil, H, hd).transpose(0, 3, 2, 1, 4)
            return jnp.pad(t, ((0, 0), (0, 0), (0, 0), (0, Lp - L), (0, 0)))

        o, lse = band_attention(strided(q), strided(k), strided(v), window // dil)
        outs.append(o[..., :L, :].transpose(0, 3, 2, 1, 4).reshape(Bsz, S, H, hd))
        lses.append(lse[..., :L].transpose(0, 3, 2, 1).reshape(Bsz, S, H))
    wts = jax.nn.softmax(jnp.stack(lses, axis=0), axis=0)
    o = jnp.sum(wts[..., None] * jnp.stack(outs, axis=0).astype(jnp.float32), axis=0)
    return o.reshape(Bsz, S, H * hd).astype(q.dtype)


def rotary(t, pos):
    half = t.shape[-1] // 2
    inv_freq = ROPE_BASE ** (-jnp.arange(half, dtype=jnp.float32) / half)
    ang = pos[:, None] * inv_freq[None, :]
    cos, sin = jnp.cos(ang)[:, None, :], jnp.sin(ang)[:, None, :]
    t1, t2 = t[..., :half], t[..., half:]
    return jnp.concatenate([t1 * cos - t2 * sin, t1 * sin + t2 * cos], axis=-1)


def retention(q, k, v, g, gn_g):
    Bsz, S, H, dk = q.shape
    dv = RET_VAL_DIM
    f32 = jnp.float32
    pos = jnp.arange(S, dtype=f32)
    q = rotary(q.astype(f32), pos)
    k = rotary(k.astype(f32), pos) * (dk ** -0.5)
    nc = S // BLK
    qc = q.reshape(Bsz, nc, BLK, H, dk)
    kc = k.reshape(Bsz, nc, BLK, H, dk)
    vc = v.astype(f32).reshape(Bsz, nc, BLK, H, dv)
    log_gamma = jnp.log1p(-jnp.exp2(-5.0 - jnp.arange(H, dtype=f32)))
    idx = jnp.arange(BLK, dtype=f32)
    rel = idx[:, None] - idx[None, :]
    decay = jnp.where(rel >= 0, jnp.exp(log_gamma[:, None, None] * jnp.maximum(rel, 0.0)), 0.0)
    s = jnp.einsum('bnihd,bnjhd->bnhij', qc, kc) * decay
    o_intra = jnp.einsum('bnhij,bnjhe->bnihe', s, vc)
    k_end = kc * jnp.exp((BLK - 1 - idx)[:, None] * log_gamma[None, :])[..., None]
    kv = jnp.einsum('bnjhd,bnjhe->nbhde', k_end, vc)
    chunk_decay = jnp.exp(log_gamma * BLK)[:, None, None]

    def step(state, kv_n):
        return state * chunk_decay + kv_n, state

    _, r_prev = lax.scan(step, jnp.zeros((Bsz, H, dk, dv), f32), kv)
    q_in = qc * jnp.exp((idx + 1.0)[:, None] * log_gamma[None, :])[..., None]
    o_cross = jnp.einsum('bnihd,nbhde->bnihe', q_in, r_prev)
    o = (o_intra + o_cross).reshape(Bsz, S, H, dv)
    mu = jnp.mean(o, axis=-1, keepdims=True)
    var = jnp.mean(jnp.square(o - mu), axis=-1, keepdims=True)
    o = ((o - mu) * lax.rsqrt(var + EPS)).reshape(Bsz, S, H * dv) * gn_g.astype(f32)
    return (jax.nn.silu(g.astype(f32)) * o).astype(g.dtype)


def diff_attention(q, k, v, lam_params, subln_g, lam_init):
    Bsz, S, H, _, d = q.shape
    lp = lam_params.astype(jnp.float32)
    lam = jnp.exp(jnp.sum(lp[0] * lp[1])) - jnp.exp(jnp.sum(lp[2] * lp[3])) + lam_init
    nb = S // BLK
    qb = q.reshape(Bsz, nb, BLK, H, 2, d).transpose(1, 0, 3, 4, 2, 5)
    kt = k.transpose(0, 2, 3, 1, 4)
    vt = v.transpose(0, 2, 1, 3)
    kpos = jnp.arange(S)

    def block(args):
        qi, i = args
        s = jnp.einsum('bhcqd,bhckd->bhcqk', qi, kt).astype(jnp.float32) * (d ** -0.5)
        qpos = i * BLK + jnp.arange(BLK)
        s = jnp.where(kpos[None, :] <= qpos[:, None], s, NEG)
        a = jax.nn.softmax(s, axis=-1)
        attn = a[:, :, 0] - lam * a[:, :, 1]
        return jnp.einsum('bhqk,bhke->bhqe', attn.astype(vt.dtype), vt)

    o = lax.map(block, (qb, jnp.arange(nb)))
    o = o.transpose(1, 0, 3, 2, 4).reshape(Bsz, S, H, 2 * d)
    o = rmsnorm(o, subln_g) * (1.0 - lam_init)
    return o.reshape(Bsz, S, H * 2 * d)


def mamba2_ssd(z, xbc, dt, conv_w, conv_b, dt_bias, A_log, D_skip, norm_g):
    Bsz, S, C = xbc.shape
    f32 = jnp.float32
    G, Hg, P, N = SSM_GROUPS, SSM_HEADS // SSM_GROUPS, SSM_HEAD_DIM, SSM_STATE
    xbc = lax.conv_general_dilated(xbc, conv_w[:, None, :], window_strides=(1,),
                                   padding=[(SSM_CONV - 1, 0)],
                                   dimension_numbers=('NWC', 'WIO', 'NWC'),
                                   feature_group_count=C) + conv_b
    xbc = jax.nn.silu(xbc.astype(f32))
    xs, Bm, Cm = split_cols(xbc, (SSM_D_INNER, G * N, G * N))
    dt = jax.nn.softplus(dt.astype(f32) + dt_bias.astype(f32))
    A = -jnp.exp(A_log.astype(f32)).reshape(G, Hg)
    nc = S // BLK
    xc = xs.reshape(Bsz, nc, BLK, G, Hg, P)
    Bc = Bm.reshape(Bsz, nc, BLK, G, N)
    Cc = Cm.reshape(Bsz, nc, BLK, G, N)
    dtc = dt.reshape(Bsz, nc, BLK, G, Hg)
    a_cum = jnp.cumsum(dtc * A, axis=2)
    seg = a_cum[:, :, :, None] - a_cum[:, :, None, :]
    causal = jnp.tril(jnp.ones((BLK, BLK), dtype=bool))[:, :, None, None]
    Lmat = jnp.exp(jnp.where(causal, seg, NEG))
    cb = jnp.einsum('bcign,bcjgn->bcijg', Cc, Bc)
    xdt = xc * dtc[..., None]
    y_diag = jnp.einsum('bcijg,bcijgh,bcjghp->bcighp', cb, Lmat, xdt)
    decay_end = jnp.exp(a_cum[:, :, -1:] - a_cum)
    states = jnp.einsum('bcjgn,bcjgh,bcjghp->cbghpn', Bc, decay_end, xdt)
    chunk_decay = jnp.exp(a_cum[:, :, -1]).transpose(1, 0, 2, 3)

    def step(h, inp):
        st, dec = inp
        return h * dec[..., None, None] + st, h

    _, h_prev = lax.scan(step, jnp.zeros((Bsz, G, Hg, P, N), f32), (states, chunk_decay))
    y_off = jnp.einsum('bcign,cbghpn,bcigh->bcighp', Cc, h_prev, jnp.exp(a_cum))
    y = y_diag + y_off + xc * D_skip.astype(f32).reshape(G, Hg)[:, :, None]
    y = y.reshape(Bsz, S, SSM_D_INNER)
    y = rmsnorm(y * jax.nn.silu(z.astype(f32)), norm_g)
    return y.astype(z.dtype)


def hybrid_mixer(h, w_in, ret_gn_g, diff_lambda, diff_subln_g, conv_w, conv_b, dt_bias,
                 A_log, D_skip, ssm_norm_g, w_branch, w_out, lam_init):
    Bsz, S, _ = h.shape
    proj = h @ w_in
    (aq, ak, av, bq, bk, bv, bg, cq, ck, cv, dz, dxbc, ddt, gates) = split_cols(proj, IN_SPLITS)
    ash = (Bsz, S, DIL_HEADS, DIL_HEAD_DIM)
    y_a = dilated_attention(aq.reshape(ash), ak.reshape(ash), av.reshape(ash))
    bsh = (Bsz, S, RET_HEADS, RET_KEY_DIM)
    y_b = retention(bq.reshape(bsh), bk.reshape(bsh), bv, bg, ret_gn_g)
    csh = (Bsz, S, DIFF_HEADS, 2, DIFF_HEAD_DIM)
    y_c = diff_attention(cq.reshape(csh), ck.reshape(csh),
                         cv.reshape(Bsz, S, DIFF_HEADS, 2 * DIFF_HEAD_DIM),
                         diff_lambda, diff_subln_g, lam_init)
    y_d = mamba2_ssd(dz, dxbc, ddt, conv_w, conv_b, dt_bias, A_log, D_skip, ssm_norm_g)
    branches = jnp.stack([y_a, y_b, y_c, y_d], axis=2)
    up = jnp.einsum('bsim,imd->bsid', branches, w_branch)
    gate = jax.nn.sigmoid(gates.reshape(Bsz, S, N_BRANCH, D_MODEL))
    return jnp.sum(gate * up, axis=2) @ w_out


def cross_attention(h, m, w_q, w_kv, w_o):
    Bsz, S, _ = h.shape
    M = m.shape[1]
    q = (h @ w_q).reshape(Bsz, S, X_HEADS, X_HEAD_DIM)
    kv = (m @ w_kv).reshape(Bsz, M, 2, X_HEADS, X_HEAD_DIM)
    k, v = kv[:, :, 0], kv[:, :, 1]
    s = jnp.einsum('bshd,bmhd->bhsm', q, k).astype(jnp.float32) * (X_HEAD_DIM ** -0.5)
    a = jax.nn.softmax(s, axis=-1)
    o = jnp.einsum('bhsm,bmhd->bshd', a.astype(v.dtype), v).reshape(Bsz, S, X_HEADS * X_HEAD_DIM)
    return o @ w_o


def swiglu(h, w_in, w_out):
    a, b = jnp.split(h @ w_in, 2, axis=-1)
    return (jax.nn.silu(a) * b) @ w_out


def setup_inputs(seed: int = 0) -> dict:
    key = jax.random.key(seed)
    ks = jax.random.split(key, 24)
    nrm = jax.random.normal
    L = DEPTH

    def gain(k, n):
        return 1.0 + 0.05 * nrm(k, (L, n), jnp.float32)

    u = jax.random.uniform(ks[9], (L, SSM_HEADS), jnp.float32)
    dt0 = jnp.exp(u * (math.log(0.1) - math.log(0.001)) + math.log(0.001))
    return {
        'x': nrm(ks[0], (BATCH, SEQ, D_MODEL), jnp.float32),
        'mem': nrm(ks[1], (BATCH, MEM_LEN, D_MODEL), jnp.float32),
        'norm_mix_g': gain(ks[2], D_MODEL),
        'w_in': nrm(ks[3], (L, D_MODEL, IN_WIDTH), jnp.float32) * D_MODEL ** -0.5,
        'ret_gn_g': gain(ks[4], RET_HEADS * RET_VAL_DIM),
        'diff_lambda': 0.1 * nrm(ks[5], (L, 4, DIFF_HEAD_DIM), jnp.float32),
        'diff_subln_g': gain(ks[6], 2 * DIFF_HEAD_DIM),
        'ssm_conv_w': nrm(ks[7], (L, SSM_CONV, D_XBC), jnp.float32) * SSM_CONV ** -0.5,
        'ssm_conv_b': 0.02 * nrm(ks[8], (L, D_XBC), jnp.float32),
        'ssm_dt_bias': dt0 + jnp.log(-jnp.expm1(-dt0)),
        'ssm_A_log': jnp.log(jax.random.uniform(ks[10], (L, SSM_HEADS), jnp.float32, 1.0, 16.0)),
        'ssm_D': 1.0 + 0.1 * nrm(ks[11], (L, SSM_HEADS), jnp.float32),
        'ssm_norm_g': gain(ks[12], SSM_D_INNER),
        'w_branch': nrm(ks[13], (L, N_BRANCH, BRANCH_WIDTH, D_MODEL), jnp.float32) * BRANCH_WIDTH ** -0.5,
        'w_mix_out': nrm(ks[14], (L, D_MODEL, D_MODEL), jnp.float32) * D_MODEL ** -0.5,
        'norm_x_g': gain(ks[15], D_MODEL),
        'norm_mem_g': gain(ks[16], D_MODEL),
        'w_xq': nrm(ks[17], (L, D_MODEL, X_HEADS * X_HEAD_DIM), jnp.float32) * D_MODEL ** -0.5,
        'w_xkv': nrm(ks[18], (L, D_MODEL, 2 * X_HEADS * X_HEAD_DIM), jnp.float32) * D_MODEL ** -0.5,
        'w_xo': nrm(ks[19], (L, X_HEADS * X_HEAD_DIM, D_MODEL), jnp.float32) * (X_HEADS * X_HEAD_DIM) ** -0.5,
        'norm_ffn_g': gain(ks[20], D_MODEL),
        'w_ffn_in': nrm(ks[21], (L, D_MODEL, 2 * FFN_HIDDEN), jnp.float32) * D_MODEL ** -0.5,
        'w_ffn_out': nrm(ks[22], (L, FFN_HIDDEN, D_MODEL), jnp.float32) * FFN_HIDDEN ** -0.5,
        'norm_f_g': 1.0 + 0.05 * nrm(ks[23], (D_MODEL,), jnp.float32),
    }


def reference(x, mem, norm_mix_g, w_in, ret_gn_g, diff_lambda, diff_subln_g, ssm_conv_w,
              ssm_conv_b, ssm_dt_bias, ssm_A_log, ssm_D, ssm_norm_g, w_branch, w_mix_out,
              norm_x_g, norm_mem_g, w_xq, w_xkv, w_xo, norm_ffn_g, w_ffn_in, w_ffn_out,
              norm_f_g):
    for l in range(DEPTH):
        lam_init = 0.8 - 0.6 * math.exp(-0.3 * l)
        h = rmsnorm(x, norm_mix_g[l])
        x = x + hybrid_mixer(h, w_in[l], ret_gn_g[l], diff_lambda[l], diff_subln_g[l],
                             ssm_conv_w[l], ssm_conv_b[l], ssm_dt_bias[l], ssm_A_log[l],
                             ssm_D[l], ssm_norm_g[l], w_branch[l], w_mix_out[l], lam_init)
        m = rmsnorm(mem, norm_mem_g[l])
        x = x + cross_attention(rmsnorm(x, norm_x_g[l]), m, w_xq[l], w_xkv[l], w_xo[l])
        x = x + swiglu(rmsnorm(x, norm_ffn_g[l]), w_ffn_in[l], w_ffn_out[l])
    return rmsnorm(x, norm_f_g)
```

```cpp
#include <hip/hip_runtime.h>
#include <hip/hip_cooperative_groups.h>
#include <cstdio>
#include <cstdint>
namespace cg = cooperative_groups;
namespace pg8 {
#define PG8_LAS __attribute__((address_space(3)))
typedef unsigned short bf16_t;
typedef short bf16x8 __attribute__((ext_vector_type(8)));
typedef float f32x4 __attribute__((ext_vector_type(4)));
typedef unsigned u32x4 __attribute__((ext_vector_type(4)));
constexpr int BM = 256, BK = 64, HALF = 128, HTB = HALF * BK * 2  , STAGE_BYTES = 8 * HTB, NXCD = 8, WGM = 8;

__host__ __device__ __forceinline__ int lds_byte(int r, int c) { const int st = (r >> 4) * 2 + (c >> 5), rr = r & 15, cc = c & 31, ob = rr * 64 + cc * 2; return st * 1024 + (ob ^ (((ob >> 9) & 1) << 5)); }
__host__ __device__ __forceinline__ void stage_rc(int b, int& R, int& C) { const int st = b / 1024, sb = b % 1024, swz = sb ^ (((sb >> 9) & 1) << 5); R = (st >> 1) * 16 + swz / 64; C = (st & 1) * 32 + (swz % 64) / 2; }
__host__ __device__ __forceinline__ int perm32(int rho) { const int n = rho >> 4, i = rho & 15; return 8 * (i >> 2) + 4 * n + (i & 3); }

struct Unit { int pm, pn; };
struct Gemm { const bf16_t* A; const bf16_t* Bt; int M, N, K, lda; };

struct StaticOrder {
    int nM, nN, nwg, G, c;
    __host__ __device__ void init(int M, int N, int G_, int c_) { nM = M / BM; nN = N / BM; nwg = nM * nN; G = G_; c = c_; }
    __host__ __device__ bool next(int i, Unit& u) const {
        const long L = (long)i * G + c; if (L >= nwg) return false;
        int wgid = (int)L; { const int q = nwg / NXCD, r = nwg % NXCD, xcd = wgid % NXCD, off = wgid / NXCD; wgid = (xcd < r ? xcd * (q + 1) : r * (q + 1) + (xcd - r) * q) + off; }
        const int nig = WGM * nN, gid = wgid / nig, fm = gid * WGM, gsz = (nM - fm) < WGM ? (nM - fm) : WGM;
        u.pm = fm + ((wgid % nig) % gsz); u.pn = (wgid % nig) / gsz; return true;
    }
    __device__ __forceinline__ void a_ready(const Unit&) const {}
    __device__ __forceinline__ void done(const Unit&) const {}
};

__device__ __forceinline__ unsigned cvt_pk_bf16(float lo, float hi) { unsigned r; asm volatile("v_cvt_pk_bf16_f32 %0, %1, %2" : "=v"(r) : "v"(lo), "v"(hi)); return r; }

template <class Epi, class Sched, bool ALIGN_EPI = false, bool SP2 = false>
__device__ __forceinline__ void gemm_phase(PG8_LAS unsigned char* lds, const Gemm g, const Sched& S, const Epi& E) {
    int tid_l = threadIdx.x; asm volatile("" : "+v"(tid_l));
    const int tid = tid_l, wid = __builtin_amdgcn_readfirstlane(tid >> 6), lane = tid & 63, wr = wid >> 2, wc = wid & 3, fr = lane & 15, fq = lane >> 4;
    const int K = g.K, nt = K / BK;
    unsigned voffA[2], voffB[2];
#pragma unroll
    for (int i = 0; i < 2; ++i) { int R, C; stage_rc(tid * 16 + i * 8192, R, C); const int Rb = Epi::PERM ? ((R & ~31) + perm32(R & 31)) : R;
        voffA[i] = (unsigned)(R * g.lda + C) * 2u; voffB[i] = (unsigned)(Rb * K + C) * 2u; }
    const size_t kstep = (size_t)(BK * 2);
    const size_t hstepA = (size_t)HALF * g.lda * 2, hstepB = (size_t)HALF * K * 2;
    const size_t tstepA = 2 * hstepA, tstepB = 2 * hstepB;
    const unsigned ldsw = (unsigned)wid * 1024u;
    const int aoff = lds_byte(wr * 64 + fr, fq * 8), boff = lds_byte(wc * 32 + fr, fq * 8);
#define PG8_SA(b, h) (((b) * 2 + (h)) * HTB)
#define PG8_SB(b, h) ((4 + (b) * 2 + (h)) * HTB)
#define PG8_STAGE(bufoff, gbase, voff) do { _Pragma("unroll") for (int _i = 0; _i < 2; ++_i) \
        __builtin_amdgcn_global_load_lds((const unsigned*)((const char*)(gbase) + (voff)[_i]), (PG8_LAS unsigned*)(lds + (bufoff) + ldsw + _i * 8192), 16, 0, 0); } while (0)
#define PG8_LDA(dst, b, h) do { _Pragma("unroll") for (int m = 0; m < 4; ++m) _Pragma("unroll") for (int k = 0; k < 2; ++k) dst[m][k] = *(const PG8_LAS bf16x8*)(lds + PG8_SA(b, h) + aoff + m * 2048 + k * 1024); } while (0)
#define PG8_LDB(dst, b, h) do { _Pragma("unroll") for (int n = 0; n < 2; ++n) _Pragma("unroll") for (int k = 0; k < 2; ++k) dst[n][k] = *(const PG8_LAS bf16x8*)(lds + PG8_SB(b, h) + boff + n * 2048 + k * 1024); } while (0)
#define PG8_MMA(ai, bj, At, Bt) do { __builtin_amdgcn_s_setprio(1); _Pragma("unroll") for (int m = 0; m < 4; ++m) _Pragma("unroll") for (int n = 0; n < 2; ++n) _Pragma("unroll") for (int k = 0; k < 2; ++k) \
        acc[ai][bj][m][n] = __builtin_amdgcn_mfma_f32_16x16x32_bf16(Bt[n][k], At[m][k], acc[ai][bj][m][n], 0, 0, 0); __builtin_amdgcn_s_setprio(0); } while (0)
#define PG8_WAIT_V(n) asm volatile("s_waitcnt vmcnt(" #n ")" ::: "memory")
#define PG8_WAIT_L(n) asm volatile("s_waitcnt lgkmcnt(" #n ")" ::: "memory")
#define PG8_BAR __builtin_amdgcn_s_barrier()
#define PG8_SCHED __builtin_amdgcn_sched_barrier(0)
    Unit cur, nxt; int ui = 0;
    if (!S.next(0, cur)) return;
    f32x4 acc[2][2][4][2];
#pragma unroll
    for (int a = 0; a < 2; ++a)
#pragma unroll
        for (int b = 0; b < 2; ++b)
#pragma unroll
            for (int m = 0; m < 4; ++m)
#pragma unroll
                for (int n = 0; n < 2; ++n) acc[a][b][m][n] = (f32x4){0.f, 0.f, 0.f, 0.f};
    bf16x8 At[4][2], B0[2][2], B1[2][2];
    const char* cA = (const char*)g.A + (size_t)cur.pm * tstepA; const char* cB = (const char*)g.Bt + (size_t)cur.pn * tstepB;
    S.a_ready(cur);
    if constexpr (SP2) {
        PG8_STAGE(PG8_SB(0, 0), cB, voffB); PG8_STAGE(PG8_SB(0, 1), cB + hstepB, voffB); PG8_STAGE(PG8_SA(0, 0), cA, voffA); PG8_STAGE(PG8_SA(0, 1), cA + hstepA, voffA);
        if (wr == 1) PG8_BAR;
        PG8_WAIT_V(2); PG8_BAR;
        PG8_STAGE(PG8_SB(1, 0), cB + kstep, voffB); PG8_STAGE(PG8_SA(1, 0), cA + kstep, voffA); PG8_STAGE(PG8_SB(1, 1), cB + hstepB + kstep, voffB);
        PG8_WAIT_V(6); PG8_BAR;
    } else {
        PG8_STAGE(PG8_SB(0, 0), cB, voffB); PG8_STAGE(PG8_SA(0, 0), cA, voffA); PG8_STAGE(PG8_SB(0, 1), cB + hstepB, voffB); PG8_STAGE(PG8_SA(0, 1), cA + hstepA, voffA);
        if (wr == 1) PG8_BAR;
        PG8_WAIT_V(4); PG8_BAR;
        PG8_STAGE(PG8_SB(1, 0), cB + kstep, voffB); PG8_STAGE(PG8_SA(1, 0), cA + kstep, voffA); PG8_STAGE(PG8_SB(1, 1), cB + hstepB + kstep, voffB);
        PG8_WAIT_V(6); PG8_BAR;
    }
    for (;;) {
        const bool has_next = S.next(ui + 1, nxt);
        const char* nA = has_next ? (const char*)g.A + (size_t)nxt.pm * tstepA : cA; const char* nB = has_next ? (const char*)g.Bt + (size_t)nxt.pn * tstepB : cB;
        for (int t = 0; t < nt; t += 2) {
            const bool last = (t == nt - 2);
            const char* a1 = cA + (size_t)(t + 1) * kstep;
            const char* a2 = last ? nA : cA + (size_t)(t + 2) * kstep; const char* b2 = last ? nB : cB + (size_t)(t + 2) * kstep;
            const char* a3 = a2 + kstep; const char* b3 = b2 + kstep;
            if (last && has_next) S.a_ready(nxt);
            if constexpr (SP2) {
            PG8_LDB(B0, 0, 0); PG8_LDB(B1, 0, 1); PG8_SCHED; PG8_LDA(At, 0, 0); PG8_STAGE(PG8_SA(1, 1), a1 + hstepA, voffA);
            PG8_WAIT_V(8); PG8_WAIT_L(0); PG8_BAR; PG8_MMA(0, 0, At, B0); PG8_MMA(0, 1, At, B1); PG8_BAR; PG8_SCHED;
            PG8_LDA(At, 0, 1); PG8_STAGE(PG8_SB(0, 0), b2, voffB); PG8_STAGE(PG8_SB(0, 1), b2 + hstepB, voffB); PG8_STAGE(PG8_SA(0, 0), a2, voffA);
            PG8_WAIT_V(8); PG8_WAIT_L(0); PG8_BAR; PG8_MMA(1, 0, At, B0); PG8_MMA(1, 1, At, B1); PG8_BAR; PG8_SCHED;
            PG8_LDB(B0, 1, 0); PG8_LDB(B1, 1, 1); PG8_SCHED; PG8_LDA(At, 1, 0); PG8_STAGE(PG8_SA(0, 1), a2 + hstepA, voffA);
            PG8_WAIT_V(8); PG8_WAIT_L(0); PG8_BAR; PG8_MMA(0, 0, At, B0); PG8_MMA(0, 1, At, B1); PG8_BAR; PG8_SCHED;
            PG8_LDA(At, 1, 1); PG8_STAGE(PG8_SB(1, 0), b3, voffB); PG8_STAGE(PG8_SB(1, 1), b3 + hstepB, voffB); PG8_STAGE(PG8_SA(1, 0), a3, voffA);
            PG8_WAIT_V(8); PG8_WAIT_L(0); PG8_BAR; PG8_MMA(1, 0, At, B0); PG8_MMA(1, 1, At, B1); PG8_BAR; PG8_SCHED;
            } else {
            PG8_LDB(B0, 0, 0); PG8_SCHED; PG8_LDA(At, 0, 0); PG8_STAGE(PG8_SA(1, 1), a1 + hstepA, voffA);
            PG8_WAIT_L(8); PG8_BAR; PG8_WAIT_L(0); PG8_MMA(0, 0, At, B0); PG8_BAR; PG8_SCHED;
            PG8_LDB(B1, 0, 1); PG8_STAGE(PG8_SB(0, 0), b2, voffB);
            PG8_BAR; PG8_WAIT_L(0); PG8_MMA(0, 1, At, B1); PG8_BAR;
            PG8_LDA(At, 0, 1); PG8_STAGE(PG8_SA(0, 0), a2, voffA);
            PG8_BAR; PG8_WAIT_L(0); PG8_MMA(1, 0, At, B0); PG8_BAR; PG8_SCHED;
            PG8_STAGE(PG8_SB(0, 1), b2 + hstepB, voffB);
            PG8_WAIT_V(6); PG8_BAR; PG8_MMA(1, 1, At, B1); PG8_BAR;
            PG8_LDB(B0, 1, 0); PG8_SCHED; PG8_LDA(At, 1, 0); PG8_STAGE(PG8_SA(0, 1), a2 + hstepA, voffA);
            PG8_WAIT_L(8); PG8_BAR; PG8_WAIT_L(0); PG8_MMA(0, 0, At, B0); PG8_BAR; PG8_SCHED;
            PG8_LDB(B1, 1, 1); PG8_STAGE(PG8_SB(1, 0), b3, voffB);
            PG8_BAR; PG8_WAIT_L(0); PG8_MMA(0, 1, At, B1); PG8_BAR;
            PG8_LDA(At, 1, 1); PG8_STAGE(PG8_SA(1, 0), a3, voffA);
            PG8_BAR; PG8_WAIT_L(0); PG8_MMA(1, 0, At, B0); PG8_BAR; PG8_SCHED;
            PG8_STAGE(PG8_SB(1, 1), b3 + hstepB, voffB);
            PG8_WAIT_V(6); PG8_BAR; PG8_MMA(1, 1, At, B1); PG8_BAR;
            }
        }
        if constexpr (ALIGN_EPI) { if (wr == 0) PG8_BAR; }
        if constexpr (!Epi::AFTER_DRAIN) { E(acc, cur, wr, wc, fr, fq); S.done(cur); }
        if (!has_next) break;
#pragma unroll
        for (int a = 0; a < 2; ++a)
#pragma unroll
            for (int b = 0; b < 2; ++b)
#pragma unroll
                for (int m = 0; m < 4; ++m)
#pragma unroll
                    for (int n = 0; n < 2; ++n) acc[a][b][m][n] = (f32x4){0.f, 0.f, 0.f, 0.f};
        cur = nxt; cA = nA; cB = nB; ++ui;
        if constexpr (ALIGN_EPI) { if (wr == 1) PG8_BAR; }
    }
    PG8_WAIT_V(0);
    if constexpr (!ALIGN_EPI) { if (wr == 0) PG8_BAR; }
    PG8_BAR;
    if constexpr (Epi::AFTER_DRAIN) { E.fused(acc, cur, wr, wc, fr, fq, lds, wid, lane); S.done(cur); }
#undef PG8_SA
#undef PG8_SB
#undef PG8_STAGE
#undef PG8_LDA
#undef PG8_LDB
#undef PG8_MMA
#undef PG8_WAIT_V
#undef PG8_WAIT_L
#undef PG8_BAR
#undef PG8_SCHED
}
}

namespace pg8 {
__device__ __forceinline__ float bfu_lo(unsigned w) { return __builtin_bit_cast(float, w << 16); }
__device__ __forceinline__ float bfu_hi(unsigned w) { return __builtin_bit_cast(float, w & 0xffff0000u); }
__device__ __forceinline__ float sigmoidf_(float x) { return 1.f / (1.f + __expf(-x)); }

template <int ACT  > struct EpiStore {
    static constexpr bool PERM = true, AFTER_DRAIN = false;
    bf16_t* O; int ldc;
    __device__ __forceinline__ void operator()(const f32x4 (&acc)[2][2][4][2], const Unit& u, int wr, int wc, int fr, int fq) const {
        const int row0 = u.pm * BM + wr * 64 + fr, col0 = u.pn * BM + wc * 32 + 8 * fq;
#pragma unroll
        for (int ai = 0; ai < 2; ++ai)
#pragma unroll
            for (int m = 0; m < 4; ++m) { bf16_t* rowp = O + (size_t)(row0 + ai * HALF + m * 16) * ldc + col0;
#pragma unroll
                for (int bj = 0; bj < 2; ++bj) { f32x4 v0 = acc[ai][bj][m][0], v1 = acc[ai][bj][m][1];
                    if (ACT == 1) {
#pragma unroll
                        for (int j = 0; j < 4; ++j) { v0[j] = sigmoidf_(v0[j]); v1[j] = sigmoidf_(v1[j]); } }
                    u32x4 w; w.x = cvt_pk_bf16(v0[0], v0[1]); w.y = cvt_pk_bf16(v0[2], v0[3]); w.z = cvt_pk_bf16(v1[0], v1[1]); w.w = cvt_pk_bf16(v1[2], v1[3]);
                    *(u32x4*)(rowp + bj * HALF) = w; } }
    }
};

struct EpiGateAcc {
    static constexpr bool PERM = true, AFTER_DRAIN = false;
    const bf16_t* GS; bf16_t* MG; int ld; int first; const float* ssq;
    __device__ __forceinline__ void operator()(const f32x4 (&acc)[2][2][4][2], const Unit& u, int wr, int wc, int fr, int fq) const {
        const int row0 = u.pm * BM + wr * 64 + fr, col0 = u.pn * BM + wc * 32 + 8 * fq;
#pragma unroll
        for (int ai = 0; ai < 2; ++ai)
#pragma unroll
            for (int m = 0; m < 4; ++m) { const int row = row0 + ai * HALF + m * 16; const size_t ro = (size_t)row * ld + col0;
                float rs = 1.f;
                if (ssq) { const f32x4 s0 = *(const f32x4*)(ssq + (size_t)row * 8), s1 = *(const f32x4*)(ssq + (size_t)row * 8 + 4);
                    const float s = ((s0[0] + s0[1]) + (s0[2] + s0[3])) + ((s1[0] + s1[1]) + (s1[2] + s1[3])); rs = rsqrtf(s * (1.f / 512.f) + 1e-6f); }
#pragma unroll
                for (int bj = 0; bj < 2; ++bj) { const f32x4 a0 = acc[ai][bj][m][0], a1 = acc[ai][bj][m][1];
                    const u32x4 g = *(const u32x4*)(GS + ro + bj * HALF);
                    u32x4 o = (u32x4){0u, 0u, 0u, 0u}; if (!first) o = *(const u32x4*)(MG + ro + bj * HALF);
                    float r[8];
                    r[0] = bfu_lo(o.x) + bfu_lo(g.x) * a0[0] * rs; r[1] = bfu_hi(o.x) + bfu_hi(g.x) * a0[1] * rs;
                    r[2] = bfu_lo(o.y) + bfu_lo(g.y) * a0[2] * rs; r[3] = bfu_hi(o.y) + bfu_hi(g.y) * a0[3] * rs;
                    r[4] = bfu_lo(o.z) + bfu_lo(g.z) * a1[0] * rs; r[5] = bfu_hi(o.z) + bfu_hi(g.z) * a1[1] * rs;
                    r[6] = bfu_lo(o.w) + bfu_lo(g.w) * a1[2] * rs; r[7] = bfu_hi(o.w) + bfu_hi(g.w) * a1[3] * rs;
                    u32x4 w; w.x = cvt_pk_bf16(r[0], r[1]); w.y = cvt_pk_bf16(r[2], r[3]); w.z = cvt_pk_bf16(r[4], r[5]); w.w = cvt_pk_bf16(r[6], r[7]);
                    *(u32x4*)(MG + ro + bj * HALF) = w; } }
    }
};

struct EpiResid {
    static constexpr bool PERM = true, AFTER_DRAIN = false;
    const float* XI; float* XO;
    __device__ __forceinline__ void operator()(const f32x4 (&acc)[2][2][4][2], const Unit& u, int wr, int wc, int fr, int fq) const {
        const int row0 = u.pm * BM + wr * 64 + fr, col0 = u.pn * BM + wc * 32 + 8 * fq;
#pragma unroll
        for (int ai = 0; ai < 2; ++ai)
#pragma unroll
            for (int m = 0; m < 4; ++m) { const size_t ro = (size_t)(row0 + ai * HALF + m * 16) * 1024 + col0;
#pragma unroll
                for (int bj = 0; bj < 2; ++bj) {
#pragma unroll
                    for (int n = 0; n < 2; ++n) { const f32x4 x0 = *(const f32x4*)(XI + ro + bj * HALF + 4 * n); *(f32x4*)(XO + ro + bj * HALF + 4 * n) = x0 + acc[ai][bj][m][n]; } } }
    }
};

struct EpiSwiglu {
    static constexpr bool PERM = true, AFTER_DRAIN = false;
    bf16_t* H; int ldc;
    __device__ __forceinline__ void operator()(const f32x4 (&acc)[2][2][4][2], const Unit& u, int wr, int wc, int fr, int fq) const {
        const int row0 = u.pm * BM + wr * 64 + fr, col0 = u.pn * 128 + wc * 16 + 4 * fq;
#pragma unroll
        for (int ai = 0; ai < 2; ++ai)
#pragma unroll
            for (int m = 0; m < 4; ++m) { bf16_t* rowp = H + (size_t)(row0 + ai * HALF + m * 16) * ldc + col0;
#pragma unroll
                for (int bj = 0; bj < 2; ++bj) { const f32x4 a = acc[ai][bj][m][0], b = acc[ai][bj][m][1]; float r[4];
#pragma unroll
                    for (int j = 0; j < 4; ++j) r[j] = a[j] * sigmoidf_(a[j]) * b[j];
                    unsigned long long w = (unsigned long long)cvt_pk_bf16(r[0], r[1]) | ((unsigned long long)cvt_pk_bf16(r[2], r[3]) << 32);
                    *(unsigned long long*)(rowp + bj * 64) = w; } }
    }
};
}

typedef unsigned short bf16;
typedef float f32x4 __attribute__((ext_vector_type(4)));
typedef unsigned u32x4 __attribute__((ext_vector_type(4)));
typedef unsigned u32x2 __attribute__((ext_vector_type(2)));
#define LAS __attribute__((address_space(3)))
constexpr int NT = 16384, SEQL = 4096, DM = 1024, PW = 6144, INW = 10248, FFH = 2816;
constexpr float EPSN = 1e-6f;
constexpr size_t MiB = 1u << 20;
constexpr size_t WS_W = 0, WS_XN = 48 * MiB, WS_PROJ = 80 * MiB, WS_MISC = 272 * MiB, WS_END = 280 * MiB;
constexpr size_t W_IN = 0, W_G = W_IN + (size_t)6144 * 1024, W_B = W_G + (size_t)4096 * 1024, W_MO = W_B + (size_t)4 * 1024 * 512, W_XQ = W_MO + (size_t)1024 * 1024,
                 W_XKV = W_XQ + (size_t)512 * 1024, W_XO = W_XKV + (size_t)1024 * 1024, W_FI = W_XO + (size_t)1024 * 512, W_FO = W_FI + (size_t)5632 * 1024, W_TOT = W_FO + (size_t)1024 * 2816;
static_assert(W_TOT * 2 <= 48 * MiB, "weights fit");
constexpr size_t MS_DT = 0, MS_SSQ = 512 * 1024, MS_MN = 1 * MiB, MS_KV = 3 * MiB;
constexpr int C_AQ = 0, C_AK = 512, C_AV = 1024, C_BQ = 1536, C_BK = 1792, C_BV = 2048, C_BG = 2560, C_CQ = 3072, C_CK = 3584, C_CV = 4096, C_DZ = 4608, C_DX = 5120;
constexpr int C_GS = 512, C_MG = 5120;
constexpr int LDS_BYTES = 147456;

__device__ __forceinline__ float bf2f(bf16 v) { return __builtin_bit_cast(float, (unsigned)v << 16); }
__device__ __forceinline__ float bflo(unsigned w) { return __builtin_bit_cast(float, w << 16); }
__device__ __forceinline__ float bfhi(unsigned w) { return __builtin_bit_cast(float, w & 0xffff0000u); }
__device__ __forceinline__ unsigned f2bf(float f) { unsigned u = __builtin_bit_cast(unsigned, f); return (u + 0x7fffu + ((u >> 16) & 1u)) >> 16; }
__device__ __forceinline__ unsigned pk2(float lo, float hi) { return f2bf(lo) | (f2bf(hi) << 16); }
__device__ __forceinline__ float wave_sum(float v) {
#pragma unroll
    for (int o = 1; o < 64; o <<= 1) v += __shfl_xor(v, o);
    return v;
}
__device__ __forceinline__ float siluf_(float x) { return x / (1.f + __expf(-x)); }
__device__ __forceinline__ void unpack8(const u32x4 w, float* f) { f[0] = bflo(w.x); f[1] = bfhi(w.x); f[2] = bflo(w.y); f[3] = bfhi(w.y); f[4] = bflo(w.z); f[5] = bfhi(w.z); f[6] = bflo(w.w); f[7] = bfhi(w.w); }

#ifndef PHMASK
#define PHMASK 0xFFFF
#endif
struct Args { const float* in[24]; float* out; unsigned char* ws; int ph_lo, ph_hi; };
typedef const __attribute__((address_space(4))) Args* ArgP;
struct Ctx {
    unsigned char* ws;
    int tid, lane, wave, wg, nwg;
};

__device__ __forceinline__ void conv_w(const Ctx& c, const float* W, int srcN, int K, int Ndst, bf16* WT, int mode, int off, int rot) {
    const int nb = Ndst / 64, kb = K / 64, tot = nb * kb;
    int start = c.wg - (rot % c.nwg); if (start < 0) start += c.nwg;
    for (int it = start; it < tot; it += c.nwg) {
        const int n = (it % nb) * 64 + (c.tid & 63), k0 = (it / nb) * 64 + (c.tid >> 6) * 8;
        const int sc = mode == 0 ? off + n : (((n & 7) < 4) ? (n >> 3) * 4 + (n & 3) : FFH + (n >> 3) * 4 + (n & 3));
        const float* src = W + (size_t)k0 * srcN + sc;
        float v[8];
#pragma unroll
        for (int j = 0; j < 8; ++j) v[j] = src[(size_t)j * srcN];
        u32x4 o; o.x = pk2(v[0], v[1]); o.y = pk2(v[2], v[3]); o.z = pk2(v[4], v[5]); o.w = pk2(v[6], v[7]);
        *(u32x4*)(WT + (size_t)n * K + k0) = o;
    }
}
__device__ __forceinline__ void convert_layer(const Ctx& c, ArgP A, int l) {
    bf16* Wb = (bf16*)(c.ws + WS_W);
    const float* w_in = A->in[3] + (size_t)l * DM * INW;
    conv_w(c, w_in, INW, 1024, 6144, Wb + W_IN, 0, 0, 0);
    conv_w(c, w_in, INW, 1024, 4096, Wb + W_G, 0, 6152, 0);
    for (int i = 0; i < 4; ++i) conv_w(c, A->in[13] + ((size_t)l * 4 + i) * 512 * 1024, 1024, 512, 1024, Wb + W_B + (size_t)i * 1024 * 512, 0, 0, 32 * i);
    conv_w(c, A->in[14] + (size_t)l * 1024 * 1024, 1024, 1024, 1024, Wb + W_MO, 0, 0, 128);
    conv_w(c, A->in[17] + (size_t)l * 1024 * 512, 512, 1024, 512, Wb + W_XQ, 0, 0, 0);
    conv_w(c, A->in[18] + (size_t)l * 1024 * 1024, 1024, 1024, 1024, Wb + W_XKV, 0, 0, 128);
    conv_w(c, A->in[19] + (size_t)l * 512 * 1024, 1024, 512, 1024, Wb + W_XO, 0, 0, 0);
    conv_w(c, A->in[21] + (size_t)l * 1024 * 5632, 5632, 1024, 5632, Wb + W_FI, 1, 0, 128);
    conv_w(c, A->in[22] + (size_t)l * FFH * 1024, 1024, FFH, 1024, Wb + W_FO, 0, 0, 0);
}

__device__ __forceinline__ void norm_rows(const Ctx& c, const float* X, const float* g, bf16* out, int nrows, const float* Wdt, float* dt_out) {
    const int gw = c.wg * 8 + c.wave, ngw = c.nwg * 8, lane = c.lane;
    f32x4 gv[4];
#pragma unroll
    for (int j = 0; j < 4; ++j) gv[j] = *((const f32x4*)g + lane + 64 * j);
    for (int row = gw; row < nrows; row += ngw) {
        const f32x4* xr = (const f32x4*)(X + (size_t)row * DM) + lane;
        f32x4 v[4]; float s = 0.f;
#pragma unroll
        for (int j = 0; j < 4; ++j) { v[j] = xr[64 * j]; s += (v[j].x * v[j].x + v[j].y * v[j].y) + (v[j].z * v[j].z + v[j].w * v[j].w); }
        const float rs = rsqrtf(wave_sum(s) * (1.f / DM) + EPSN);
        unsigned long long* o8 = (unsigned long long*)(out + (size_t)row * DM) + lane;
#pragma unroll
        for (int j = 0; j < 4; ++j) { v[j] = v[j] * rs * gv[j]; o8[64 * j] = (unsigned long long)pk2(v[j].x, v[j].y) | ((unsigned long long)pk2(v[j].z, v[j].w) << 32); }
        if (Wdt) {
            f32x4 a0 = (f32x4){0.f, 0.f, 0.f, 0.f}, a1 = a0;
#pragma unroll
            for (int j = 0; j < 4; ++j)
#pragma unroll
                for (int e = 0; e < 4; ++e) { const int k = 4 * lane + 256 * j + e; const float* wp = Wdt + (size_t)k * INW + 6144;
                    const f32x4 w0 = *(const f32x4*)wp, w1 = *(const f32x4*)(wp + 4); a0 += w0 * v[j][e]; a1 += w1 * v[j][e]; }
#pragma unroll
            for (int e = 0; e < 4; ++e) { a0[e] = wave_sum(a0[e]); a1[e] = wave_sum(a1[e]); }
            if (lane == 0) { *(f32x4*)(dt_out + (size_t)row * 8) = a0; *(f32x4*)(dt_out + (size_t)row * 8 + 4) = a1; }
        }
    }
}
__device__ __forceinline__ void final_norm(const Ctx& c, float* X, const float* g) {
    const int gw = c.wg * 8 + c.wave, ngw = c.nwg * 8, lane = c.lane;
    for (int row = gw; row < NT; row += ngw) {
        f32x4* xr = (f32x4*)(X + (size_t)row * DM) + lane;
        f32x4 v[4]; float s = 0.f;
#pragma unroll
        for (int j = 0; j < 4; ++j) { v[j] = xr[64 * j]; s += (v[j].x * v[j].x + v[j].y * v[j].y) + (v[j].z * v[j].z + v[j].w * v[j].w); }
        const float rs = rsqrtf(wave_sum(s) * (1.f / DM) + EPSN);
#pragma unroll
        for (int j = 0; j < 4; ++j) xr[64 * j] = v[j] * rs * *((const f32x4*)g + lane + 64 * j);
    }
}

#define OSM_UPDATE(sc, NV, vexpr) do { float _p; if ((sc) > mrun) { const float _r = __expf(mrun - (sc)); lrun *= _r; _Pragma("unroll") for (int _i = 0; _i < NV; ++_i) o[_i] *= _r; mrun = (sc); _p = 1.f; } \
    else _p = __expf((sc) - mrun); lrun += _p; _Pragma("unroll") for (int _i = 0; _i < NV; ++_i) o[_i] += _p * (vexpr); } while (0)

__device__ __forceinline__ void mixer_a_naive(const Ctx& c) {
    bf16* P = (bf16*)(c.ws + WS_PROJ);
    for (int item = c.wg * 512 + c.tid; item < NT * 8; item += c.nwg * 512) {
        const int w = item >> 6, h = w & 7, t = (w >> 3) * 64 + (item & 63), s = t & (SEQL - 1);
        bf16* qp = P + (size_t)t * PW + C_AQ + h * 64;
        float q[64], o[64];
#pragma unroll
        for (int i = 0; i < 8; ++i) { float f[8]; unpack8(*(const u32x4*)(qp + 8 * i), f);
#pragma unroll
            for (int j = 0; j < 8; ++j) { q[8 * i + j] = f[j] * 0.125f; o[8 * i + j] = 0.f; } }
        float mrun = -1e30f, lrun = 0.f;
        for (int p = 0; p < 3; ++p) {
            const int d = 1 << (2 * p);
            for (int j = 0; j <= 128; ++j) {
                const int s2 = s - j * d; if (s2 < 0) break;
                const bf16* kr = P + (size_t)(t - j * d) * PW + C_AK + h * 64; const bf16* vr = kr + (C_AV - C_AK);
                float sc = 0.f;
#pragma unroll
                for (int i = 0; i < 8; ++i) { float f[8]; unpack8(*(const u32x4*)(kr + 8 * i), f);
#pragma unroll
                    for (int jj = 0; jj < 8; ++jj) sc += q[8 * i + jj] * f[jj]; }
                float p_; if (sc > mrun) { const float r = __expf(mrun - sc); lrun *= r;
#pragma unroll
                    for (int i = 0; i < 64; ++i) o[i] *= r;
                    mrun = sc; p_ = 1.f; } else p_ = __expf(sc - mrun);
                lrun += p_;
#pragma unroll
                for (int i = 0; i < 8; ++i) { float f[8]; unpack8(*(const u32x4*)(vr + 8 * i), f);
#pragma unroll
                    for (int jj = 0; jj < 8; ++jj) o[8 * i + jj] += p_ * f[jj]; }
            }
        }
        const float inv = 1.f / lrun;
#pragma unroll
        for (int i = 0; i < 8; ++i) { u32x4 wv; wv.x = pk2(o[8 * i] * inv, o[8 * i + 1] * inv); wv.y = pk2(o[8 * i + 2] * inv, o[8 * i + 3] * inv);
            wv.z = pk2(o[8 * i + 4] * inv, o[8 * i + 5] * inv); wv.w = pk2(o[8 * i + 6] * inv, o[8 * i + 7] * inv); *(u32x4*)(qp + 8 * i) = wv; }
    }
}

__device__ __forceinline__ void mixer_c_naive(const Ctx& c, ArgP A, unsigned char* lds_raw, int l) {
    bf16* P = (bf16*)(c.ws + WS_PROJ);
    bf16* sK = (bf16*)lds_raw;
    bf16* sV = sK + 64 * 128;
    float* sX = (float*)(lds_raw + 32768);
    const float* lp = A->in[5] + (size_t)l * 256;
    float d0 = 0.f, d1 = 0.f;
    for (int i = 0; i < 64; ++i) { d0 += lp[i] * lp[64 + i]; d1 += lp[128 + i] * lp[192 + i]; }
    const float lam_init = 0.8f - 0.6f * expf(-0.3f * (float)l);
    const float lam = expf(d0) - expf(d1) + lam_init;
    const float* sg = A->in[6] + (size_t)l * 128;
    const int tid = c.tid, half = tid & 1, qi = (tid >> 1) & 127, mp = tid >> 8;
    for (int u0 = c.wg; u0 < 512; u0 += c.nwg) {
        const int r = u0 / c.nwg; const int idx = u0 % 256;
        int bh, qblk;
        if (c.nwg == 256) { bh = idx & 15; const int qq = idx >> 4; qblk = (r == 0) ? 31 - qq : qq; }
        else { bh = u0 & 15; qblk = u0 >> 4; }
        const int b = bh >> 2, h = bh & 3;
        const int s = qblk * 128 + qi, t = b * SEQL + s;
        bf16* qp = P + (size_t)t * PW + C_CQ + h * 128;
        float q[64], o[64];
#pragma unroll
        for (int i = 0; i < 8; ++i) { float f[8]; unpack8(*(const u32x4*)(qp + mp * 64 + 8 * i), f);
#pragma unroll
            for (int j = 0; j < 8; ++j) { q[8 * i + j] = f[j] * 0.125f; o[8 * i + j] = 0.f; } }
        float mrun = -1e30f, lrun = 0.f;
        const int ntile = 2 * (qblk + 1);
        for (int kt = 0; kt < ntile; ++kt) {
            __syncthreads();
            {
                const size_t rowb = (size_t)(b * SEQL + kt * 64);
#pragma unroll
                for (int i = 0; i < 2; ++i) { const int ch = tid + 512 * i, rr = ch >> 4, cc = (ch & 15) * 8;
                    *(u32x4*)(sK + rr * 128 + cc) = *(const u32x4*)(P + (rowb + rr) * PW + C_CK + h * 128 + cc);
                    *(u32x4*)(sV + rr * 128 + cc) = *(const u32x4*)(P + (rowb + rr) * PW + C_CV + h * 128 + cc); }
            }
            __syncthreads();
            const int kmax = s - kt * 64;
            for (int j = 0; j < 64; ++j) {
                if (j > kmax) break;
                const bf16* kr = sK + j * 128 + mp * 64; const bf16* vr = sV + j * 128 + half * 64;
                float sc = 0.f;
#pragma unroll
                for (int i = 0; i < 8; ++i) { float f[8]; unpack8(*(const u32x4*)(kr + 8 * i), f);
#pragma unroll
                    for (int jj = 0; jj < 8; ++jj) sc += q[8 * i + jj] * f[jj]; }
                float p_; if (sc > mrun) { const float rr = __expf(mrun - sc); lrun *= rr;
#pragma unroll
                    for (int i = 0; i < 64; ++i) o[i] *= rr;
                    mrun = sc; p_ = 1.f; } else p_ = __expf(sc - mrun);
                lrun += p_;
#pragma unroll
                for (int i = 0; i < 8; ++i) { float f[8]; unpack8(*(const u32x4*)(vr + 8 * i), f);
#pragma unroll
                    for (int jj = 0; jj < 8; ++jj) o[8 * i + jj] += p_ * f[jj]; }
            }
        }
        const float inv = 1.f / lrun;
        __syncthreads();
        if (mp == 1) {
#pragma unroll
            for (int i = 0; i < 64; ++i) sX[qi * 128 + half * 64 + i] = o[i] * inv;
        }
        __syncthreads();
        if (mp == 0) {
            float ss = 0.f;
#pragma unroll
            for (int i = 0; i < 64; ++i) { o[i] = o[i] * inv - lam * sX[qi * 128 + half * 64 + i]; ss += o[i] * o[i]; }
            ss += __shfl_xor(ss, 1);
            const float rs = rsqrtf(ss * (1.f / 128.f) + EPSN) * (1.f - lam_init);
#pragma unroll
            for (int i = 0; i < 8; ++i) { float y[8];
#pragma unroll
                for (int j = 0; j < 8; ++j) y[j] = o[8 * i + j] * rs * sg[half * 64 + 8 * i + j];
                u32x4 wv; wv.x = pk2(y[0], y[1]); wv.y = pk2(y[2], y[3]); wv.z = pk2(y[4], y[5]); wv.w = pk2(y[6], y[7]);
                *(u32x4*)(qp + half * 64 + 8 * i) = wv; }
        }
    }
    __syncthreads();
}

__device__ __forceinline__ void mixer_b_naive(const Ctx& c, ArgP A, unsigned char* lds_raw, int l, int unit) {
    bf16* P = (bf16*)(c.ws + WS_PROJ);
    float* sQ = (float*)lds_raw;
    float* sKk = sQ + 32 * 64;
    float* sVv = sKk + 32 * 64;
    float* sP = sVv + 32 * 128;
    const int b = unit >> 2, h = unit & 3, tid = c.tid, e = tid & 127, dg = tid >> 7;
    const float gamma = 1.f - exp2f(-5.f - (float)h);
    const float* gn = A->in[4] + (size_t)l * 512 + h * 128;
    float S[16];
#pragma unroll
    for (int i = 0; i < 16; ++i) S[i] = 0.f;
    for (int s0 = 0; s0 < SEQL; s0 += 32) {
        const size_t t0 = (size_t)b * SEQL + s0;
#pragma unroll
        for (int r = 0; r < 4; ++r) { const int it = tid + 512 * r, which = it >> 10, st = (it >> 5) & 31, i = it & 31;
            const bf16* src = P + (t0 + st) * PW + (which ? C_BK : C_BQ) + h * 64;
            const float t1 = bf2f(src[i]), t2 = bf2f(src[i + 32]);
            const float invf = powf(10000.f, -(float)i / 32.f); const float ang = (float)(s0 + st) * invf;
            float sn, cs; sincosf(ang, &sn, &cs);
            const float sc = which ? 0.125f : 1.f; float* dst = (which ? sKk : sQ) + st * 64;
            dst[i] = (t1 * cs - t2 * sn) * sc; dst[i + 32] = (t1 * sn + t2 * cs) * sc; }
#pragma unroll
        for (int r = 0; r < 8; ++r) { const int it = tid + 512 * r, st = it >> 7, ee = it & 127; sVv[st * 128 + ee] = bf2f(P[(t0 + st) * PW + C_BV + h * 128 + ee]); }
        __syncthreads();
        for (int st = 0; st < 32; ++st) {
            const float vv = sVv[st * 128 + e]; float po = 0.f;
#pragma unroll
            for (int i4 = 0; i4 < 4; ++i4) { const f32x4 kk = *(const f32x4*)(sKk + st * 64 + dg * 16 + 4 * i4), qq = *(const f32x4*)(sQ + st * 64 + dg * 16 + 4 * i4);
#pragma unroll
                for (int j = 0; j < 4; ++j) { S[4 * i4 + j] = gamma * S[4 * i4 + j] + kk[j] * vv; po += qq[j] * S[4 * i4 + j]; } }
            sP[(st * 4 + dg) * 128 + e] = po;
        }
        __syncthreads();
#pragma unroll
        for (int r = 0; r < 4; ++r) { const int st = c.wave * 4 + r, lane = c.lane;
            float o0 = 0.f, o1 = 0.f;
#pragma unroll
            for (int g = 0; g < 4; ++g) { o0 += sP[(st * 4 + g) * 128 + lane]; o1 += sP[(st * 4 + g) * 128 + lane + 64]; }
            const float mu = wave_sum(o0 + o1) * (1.f / 128.f); const float a0 = o0 - mu, a1 = o1 - mu;
            const float var = wave_sum(a0 * a0 + a1 * a1) * (1.f / 128.f); const float rstd = rsqrtf(var + EPSN);
            bf16* gp = P + (t0 + st) * PW + C_BG + h * 128;
            const float g0 = bf2f(gp[lane]), g1 = bf2f(gp[lane + 64]);
            gp[lane] = (bf16)f2bf(siluf_(g0) * a0 * rstd * gn[lane]); gp[lane + 64] = (bf16)f2bf(siluf_(g1) * a1 * rstd * gn[lane + 64]); }
    }
    __syncthreads();
}

__device__ __forceinline__ void mixer_d_naive(const Ctx& c, ArgP A, unsigned char* lds_raw, int l, int unit) {
    bf16* P = (bf16*)(c.ws + WS_PROJ);
    float* sXs = (float*)lds_raw;
    float* sB = sXs + 32 * 64;
    float* sC = sB + 32 * 128;
    float* sDt = sC + 32 * 128;
    float* sA = sDt + 32;
    float* sP = sA + 32;
    const int b = unit >> 3, hd = unit & 7, g = hd >> 2, tid = c.tid, p = tid & 63, ng = tid >> 6;
    const float* cw = A->in[7] + (size_t)l * 4 * 1024; const float* cb = A->in[8] + (size_t)l * 1024;
    const float dtb = A->in[9][l * 8 + hd], Aneg = -expf(A->in[10][l * 8 + hd]), Dsk = A->in[11][l * 8 + hd];
    const float* ng_ = A->in[12] + (size_t)l * 512 + hd * 64;
    const float* dtr = (const float*)(c.ws + WS_MISC + MS_DT); float* ssq = (float*)(c.ws + WS_MISC + MS_SSQ);
    float S[16];
#pragma unroll
    for (int i = 0; i < 16; ++i) S[i] = 0.f;
    for (int s0 = 0; s0 < SEQL; s0 += 32) {
        const size_t t0 = (size_t)b * SEQL + s0;
        for (int it = tid; it < 32 * 320; it += 512) { const int st = it / 320, ch = it % 320;
            int cc; float* dst;
            if (ch < 64) { cc = hd * 64 + ch; dst = sXs + st * 64 + ch; } else if (ch < 192) { cc = 512 + g * 128 + (ch - 64); dst = sB + st * 128 + (ch - 64); } else { cc = 768 + g * 128 + (ch - 192); dst = sC + st * 128 + (ch - 192); }
            float a = cb[cc];
#pragma unroll
            for (int w = 0; w < 4; ++w) { const int sp = s0 + st - 3 + w; if (sp >= 0) a += cw[w * 1024 + cc] * bf2f(P[((size_t)b * SEQL + sp) * PW + C_DX + cc]); }
            *dst = siluf_(a); }
        if (tid < 32) { const float x = dtr[(t0 + tid) * 8 + hd] + dtb; const float dt = fmaxf(x, 0.f) + log1pf(__expf(-fabsf(x))); sDt[tid] = dt; sA[tid] = __expf(dt * Aneg); }
        __syncthreads();
        for (int st = 0; st < 32; ++st) {
            const float a = sA[st], xdt = sDt[st] * sXs[st * 64 + p]; float po = 0.f;
#pragma unroll
            for (int i4 = 0; i4 < 4; ++i4) { const f32x4 bb = *(const f32x4*)(sB + st * 128 + ng * 16 + 4 * i4), cc4 = *(const f32x4*)(sC + st * 128 + ng * 16 + 4 * i4);
#pragma unroll
                for (int j = 0; j < 4; ++j) { S[4 * i4 + j] = a * S[4 * i4 + j] + bb[j] * xdt; po += cc4[j] * S[4 * i4 + j]; } }
            sP[(st * 8 + ng) * 64 + p] = po;
        }
        __syncthreads();
#pragma unroll
        for (int r = 0; r < 4; ++r) { const int st = c.wave * 4 + r, lane = c.lane;
            float y = 0.f;
#pragma unroll
            for (int q = 0; q < 8; ++q) y += sP[(st * 8 + q) * 64 + lane];
            y += Dsk * sXs[st * 64 + lane];
            bf16* zp = P + (t0 + st) * PW + C_DZ + hd * 64;
            const float yz = y * siluf_(bf2f(zp[lane]));
            const float sq = wave_sum(yz * yz);
            if (lane == 0) ssq[(t0 + st) * 8 + hd] = sq;
            zp[lane] = (bf16)f2bf(yz * ng_[lane]); }
    }
    __syncthreads();
}

__device__ __forceinline__ void xattn_naive(const Ctx& c) {
    const bf16* XQ = (const bf16*)(c.ws + WS_PROJ); bf16* AO = (bf16*)(c.ws + WS_PROJ + 16 * MiB);
    const bf16* KV = (const bf16*)(c.ws + WS_MISC + MS_KV);
    for (int item = c.wg * 512 + c.tid; item < NT * 8; item += c.nwg * 512) {
        const int w = item >> 6, h = w & 3, t = (w >> 2) * 32 + ((item & 63) >> 1), half = item & 1, b = t >> 12;
        const bf16* qp = XQ + (size_t)t * 512 + h * 128 + half * 64;
        float q[64], o[64];
#pragma unroll
        for (int i = 0; i < 8; ++i) { float f[8]; unpack8(*(const u32x4*)(qp + 8 * i), f);
#pragma unroll
            for (int j = 0; j < 8; ++j) { q[8 * i + j] = f[j] * 0.08838834764831845f; o[8 * i + j] = 0.f; } }
        float mrun = -1e30f, lrun = 0.f;
        for (int m = 0; m < 256; ++m) {
            const bf16* kr = KV + (size_t)(b * 256 + m) * 1024 + h * 128 + half * 64; const bf16* vr = kr + 512;
            float sc = 0.f;
#pragma unroll
            for (int i = 0; i < 8; ++i) { float f[8]; unpack8(*(const u32x4*)(kr + 8 * i), f);
#pragma unroll
                for (int jj = 0; jj < 8; ++jj) sc += q[8 * i + jj] * f[jj]; }
            sc += __shfl_xor(sc, 1);
            float p_; if (sc > mrun) { const float r = __expf(mrun - sc); lrun *= r;
#pragma unroll
                for (int i = 0; i < 64; ++i) o[i] *= r;
                mrun = sc; p_ = 1.f; } else p_ = __expf(sc - mrun);
            lrun += p_;
#pragma unroll
            for (int i = 0; i < 8; ++i) { float f[8]; unpack8(*(const u32x4*)(vr + 8 * i), f);
#pragma unroll
                for (int jj = 0; jj < 8; ++jj) o[8 * i + jj] += p_ * f[jj]; }
        }
        const float inv = 1.f / lrun;
        bf16* op = AO + (size_t)t * 512 + h * 128 + half * 64;
#pragma unroll
        for (int i = 0; i < 8; ++i) { u32x4 wv; wv.x = pk2(o[8 * i] * inv, o[8 * i + 1] * inv); wv.y = pk2(o[8 * i + 2] * inv, o[8 * i + 3] * inv);
            wv.z = pk2(o[8 * i + 4] * inv, o[8 * i + 5] * inv); wv.w = pk2(o[8 * i + 6] * inv, o[8 * i + 7] * inv); *(u32x4*)(op + 8 * i) = wv; }
    }
}


#define GEMM_PHASE(EPI_T, Aptr, LDA, Bptr, MM, NN, KK, ...) do { \
    pg8::Gemm g_{(const pg8::bf16_t*)(Aptr), (const pg8::bf16_t*)(Bptr), (MM), (NN), (KK), (LDA)}; pg8::StaticOrder S_; S_.init((MM), (NN), c.nwg, c.wg); \
    EPI_T E_{__VA_ARGS__}; pg8::gemm_phase<EPI_T, pg8::StaticOrder, true, true>((PG8_LAS unsigned char*)lds, g_, S_, E_); } while (0)

__global__ void __launch_bounds__(512, 2) mega_fwd(Args args) {
    extern __shared__ __attribute__((aligned(16))) unsigned char lds[];
    cg::grid_group grid = cg::this_grid();
    int ph = 0;
    const int lo = args.ph_lo, hi = args.ph_hi;
#define PHASE_BEGIN if (ph >= lo && ph < hi) { ArgP ap = (ArgP)__builtin_amdgcn_kernarg_segment_ptr(); asm volatile("" : "+s"(ap)); unsigned char* ws = ap->ws; Ctx c; c.ws = ws; \
    { int t_ = threadIdx.x, g_ = blockIdx.x, n_ = gridDim.x; asm volatile("" : "+v"(t_), "+s"(g_), "+s"(n_)); c.tid = t_; c.lane = t_ & 63; c.wave = __builtin_amdgcn_readfirstlane(t_ >> 6); c.wg = g_; c.nwg = n_; } \
    bf16* Wb = (bf16*)(ws + WS_W); bf16* XN = (bf16*)(ws + WS_XN); bf16* PJ = (bf16*)(ws + WS_PROJ); float* X = ap->out; (void)Wb; (void)XN; (void)PJ; (void)X;
#define PHASE_END   if (ph + 1 < hi) grid.sync(); } ++ph;

    for (int l = 0; l < 2; ++l) {
        asm volatile("" : "+s"(l));
        PHASE_BEGIN if ((PHMASK >> 0) & 1) {
            convert_layer(c, ap, l);
            norm_rows(c, (l == 0) ? ap->in[0] : X, ap->in[2] + (size_t)l * DM, XN, NT, ap->in[3] + (size_t)l * DM * INW, (float*)(ws + WS_MISC + MS_DT));
        } PHASE_END
        PHASE_BEGIN if ((PHMASK >> 1) & 1) {
            GEMM_PHASE(pg8::EpiStore<0>, XN, 1024, Wb + W_IN, NT, 6144, 1024, PJ, PW);
        } PHASE_END
        PHASE_BEGIN if ((PHMASK >> 2) & 1) {
            if (c.wg < 16) mixer_b_naive(c, ap, lds, l, c.wg);
            else if (c.wg < 48) mixer_d_naive(c, ap, lds, l, c.wg - 16);
            mixer_a_naive(c);
            mixer_c_naive(c, ap, lds, l);
        } PHASE_END
        PHASE_BEGIN if ((PHMASK >> 3) & 1) {
            for (int i = 0; i < 4; ++i) {
                asm volatile("" : "+s"(i));
                const int acol = (i == 0) ? C_AQ : (i == 1) ? C_BG : (i == 2) ? C_CQ : C_DZ;
                GEMM_PHASE(pg8::EpiStore<1>, XN, 1024, Wb + W_G + (size_t)i * 1024 * 1024, NT, 1024, 1024, PJ + C_GS, PW);
                GEMM_PHASE(pg8::EpiGateAcc, PJ + acol, PW, Wb + W_B + (size_t)i * 1024 * 512, NT, 1024, 512, PJ + C_GS, PJ + C_MG, PW, i == 0 ? 1 : 0, i == 3 ? (const float*)(ws + WS_MISC + MS_SSQ) : nullptr);
            }
        } PHASE_END
        PHASE_BEGIN if ((PHMASK >> 4) & 1) {
            GEMM_PHASE(pg8::EpiResid, PJ + C_MG, PW, Wb + W_MO, NT, 1024, 1024, (l == 0) ? ap->in[0] : X, X);
        } PHASE_END
        PHASE_BEGIN if ((PHMASK >> 5) & 1) {
            norm_rows(c, X, ap->in[15] + (size_t)l * DM, XN, NT, nullptr, nullptr);
            norm_rows(c, ap->in[1], ap->in[16] + (size_t)l * DM, (bf16*)(ws + WS_MISC + MS_MN), 1024, nullptr, nullptr);
        } PHASE_END
        PHASE_BEGIN if ((PHMASK >> 6) & 1) {
            GEMM_PHASE(pg8::EpiStore<0>, XN, 1024, Wb + W_XQ, NT, 512, 1024, PJ, 512);
            GEMM_PHASE(pg8::EpiStore<0>, (bf16*)(ws + WS_MISC + MS_MN), 1024, Wb + W_XKV, 1024, 1024, 1024, (bf16*)(ws + WS_MISC + MS_KV), 1024);
        } PHASE_END
        PHASE_BEGIN if ((PHMASK >> 7) & 1) {
            xattn_naive(c);
        } PHASE_END
        PHASE_BEGIN if ((PHMASK >> 8) & 1) {
            GEMM_PHASE(pg8::EpiResid, (bf16*)(ws + WS_PROJ + 16 * MiB), 512, Wb + W_XO, NT, 1024, 512, X, X);
        } PHASE_END
        PHASE_BEGIN if ((PHMASK >> 9) & 1) {
            norm_rows(c, X, ap->in[20] + (size_t)l * DM, XN, NT, nullptr, nullptr);
        } PHASE_END
        PHASE_BEGIN if ((PHMASK >> 10) & 1) {
            GEMM_PHASE(pg8::EpiSwiglu, XN, 1024, Wb + W_FI, NT, 5632, 1024, PJ, FFH);
        } PHASE_END
        PHASE_BEGIN if ((PHMASK >> 11) & 1) {
            GEMM_PHASE(pg8::EpiResid, PJ, FFH, Wb + W_FO, NT, 1024, FFH, X, X);
        } PHASE_END
    }
    PHASE_BEGIN if ((PHMASK >> 12) & 1) {
        final_norm(c, X, ap->in[23]);
    } PHASE_END
}

extern "C" void kernel_launch(void* const* d_in, const int* in_sizes, int n_in, void* d_out, int out_size, void* d_ws, size_t ws_size, hipStream_t stream) {
    static int grid_blocks = 0;
    if (grid_blocks == 0) {
        if (n_in != 24 || out_size != NT * DM || ws_size < WS_END) { fprintf(stderr, "kernel_launch: unexpected shapes (n_in %d out %d ws %zu)\n", n_in, out_size, ws_size); grid_blocks = -1; return; }
        int dev = 0, cus = 0, per_cu = 0;
        hipGetDevice(&dev);
        hipDeviceGetAttribute(&cus, hipDeviceAttributeMultiprocessorCount, dev);
        if (hipFuncSetAttribute((const void*)mega_fwd, hipFuncAttributeMaxDynamicSharedMemorySize, LDS_BYTES) != hipSuccess) { fprintf(stderr, "kernel_launch: hipFuncSetAttribute failed\n"); grid_blocks = -1; return; }
        if (hipOccupancyMaxActiveBlocksPerMultiprocessor(&per_cu, (const void*)mega_fwd, 512, LDS_BYTES) != hipSuccess || per_cu < 1) { fprintf(stderr, "kernel_launch: occupancy query says %d\n", per_cu); per_cu = 1; }
        (void)hipGetLastError();
        grid_blocks = cus * 1;
        fprintf(stderr, "kernel_launch: grid %d (cus %d, per_cu %d)\n", grid_blocks, cus, per_cu);
    }
    if (grid_blocks < 0) return;
    Args a{};
    for (int i = 0; i < 24; ++i) a.in[i] = (const float*)d_in[i];
    a.out = (float*)d_out; a.ws = (unsigned char*)d_ws; a.ph_lo = 0; a.ph_hi = 1000;
    void* kargs[] = {&a};
    hipError_t e = hipLaunchCooperativeKernel((const void*)mega_fwd, dim3(grid_blocks), dim3(512), kargs, LDS_BYTES, stream);
    if (e != hipSuccess) fprintf(stderr, "kernel_launch: cooperative launch failed: %s (grid %d)\n", hipGetErrorString(e), grid_blocks);
}
```

```cpp
#include <hip/hip_runtime.h>
#include <hip/hip_cooperative_groups.h>
#include <cstdio>
#include <cstdint>
namespace cg = cooperative_groups;
namespace pg8 {
#define PG8_LAS __attribute__((address_space(3)))
typedef unsigned short bf16_t;
typedef short bf16x8 __attribute__((ext_vector_type(8)));
typedef float f32x4 __attribute__((ext_vector_type(4)));
typedef unsigned u32x4 __attribute__((ext_vector_type(4)));
constexpr int BM = 256, BK = 64, HALF = 128, HTB = HALF * BK * 2  , STAGE_BYTES = 8 * HTB, NXCD = 8, WGM = 8;

__host__ __device__ __forceinline__ int lds_byte(int r, int c) { const int st = (r >> 4) * 2 + (c >> 5), rr = r & 15, cc = c & 31, ob = rr * 64 + cc * 2; return st * 1024 + (ob ^ (((ob >> 9) & 1) << 5)); }
__host__ __device__ __forceinline__ void stage_rc(int b, int& R, int& C) { const int st = b / 1024, sb = b % 1024, swz = sb ^ (((sb >> 9) & 1) << 5); R = (st >> 1) * 16 + swz / 64; C = (st & 1) * 32 + (swz % 64) / 2; }
__host__ __device__ __forceinline__ int perm32(int rho) { const int n = rho >> 4, i = rho & 15; return 8 * (i >> 2) + 4 * n + (i & 3); }

struct Unit { int pm, pn; };
struct Gemm { const bf16_t* A; const bf16_t* Bt; int M, N, K, lda; };

struct StaticOrder {
    int nM, nN, nwg, G, c;
    __host__ __device__ void init(int M, int N, int G_, int c_) { nM = M / BM; nN = N / BM; nwg = nM * nN; G = G_; c = c_; }
    __host__ __device__ bool next(int i, Unit& u) const {
        const long L = (long)i * G + c; if (L >= nwg) return false;
        int wgid = (int)L; { const int q = nwg / NXCD, r = nwg % NXCD, xcd = wgid % NXCD, off = wgid / NXCD; wgid = (xcd < r ? xcd * (q + 1) : r * (q + 1) + (xcd - r) * q) + off; }
        const int nig = WGM * nN, gid = wgid / nig, fm = gid * WGM, gsz = (nM - fm) < WGM ? (nM - fm) : WGM;
        u.pm = fm + ((wgid % nig) % gsz); u.pn = (wgid % nig) / gsz; return true;
    }
    __device__ __forceinline__ void a_ready(const Unit&) const {}
    __device__ __forceinline__ void done(const Unit&) const {}
};

__device__ __forceinline__ unsigned cvt_pk_bf16(float lo, float hi) { unsigned r; asm volatile("v_cvt_pk_bf16_f32 %0, %1, %2" : "=v"(r) : "v"(lo), "v"(hi)); return r; }

template <class Epi, class Sched, bool ALIGN_EPI = false, bool SP2 = false>
__device__ __forceinline__ void gemm_phase(PG8_LAS unsigned char* lds, const Gemm g, const Sched& S, const Epi& E) {
    int tid_l = threadIdx.x; asm volatile("" : "+v"(tid_l));
    const int tid = tid_l, wid = __builtin_amdgcn_readfirstlane(tid >> 6), lane = tid & 63, wr = wid >> 2, wc = wid & 3, fr = lane & 15, fq = lane >> 4;
    const int K = g.K, nt = K / BK;
    unsigned voffA[2], voffB[2];
#pragma unroll
    for (int i = 0; i < 2; ++i) { int R, C; stage_rc(tid * 16 + i * 8192, R, C); const int Rb = Epi::PERM ? ((R & ~31) + perm32(R & 31)) : R;
        voffA[i] = (unsigned)(R * g.lda + C) * 2u; voffB[i] = (unsigned)(Rb * K + C) * 2u; }
    const size_t kstep = (size_t)(BK * 2);
    const size_t hstepA = (size_t)HALF * g.lda * 2, hstepB = (size_t)HALF * K * 2;
    const size_t tstepA = 2 * hstepA, tstepB = 2 * hstepB;
    const unsigned ldsw = (unsigned)wid * 1024u;
    const int aoff = lds_byte(wr * 64 + fr, fq * 8), boff = lds_byte(wc * 32 + fr, fq * 8);
#define PG8_SA(b, h) (((b) * 2 + (h)) * HTB)
#define PG8_SB(b, h) ((4 + (b) * 2 + (h)) * HTB)
#define PG8_STAGE(bufoff, gbase, voff) do { _Pragma("unroll") for (int _i = 0; _i < 2; ++_i) \
        __builtin_amdgcn_global_load_lds((const unsigned*)((const char*)(gbase) + (voff)[_i]), (PG8_LAS unsigned*)(lds + (bufoff) + ldsw + _i * 8192), 16, 0, 0); } while (0)
#define PG8_LDA(dst, b, h) do { _Pragma("unroll") for (int m = 0; m < 4; ++m) _Pragma("unroll") for (int k = 0; k < 2; ++k) dst[m][k] = *(const PG8_LAS bf16x8*)(lds + PG8_SA(b, h) + aoff + m * 2048 + k * 1024); } while (0)
#define PG8_LDB(dst, b, h) do { _Pragma("unroll") for (int n = 0; n < 2; ++n) _Pragma("unroll") for (int k = 0; k < 2; ++k) dst[n][k] = *(const PG8_LAS bf16x8*)(lds + PG8_SB(b, h) + boff + n * 2048 + k * 1024); } while (0)
#define PG8_MMA(ai, bj, At, Bt) do { __builtin_amdgcn_s_setprio(1); _Pragma("unroll") for (int m = 0; m < 4; ++m) _Pragma("unroll") for (int n = 0; n < 2; ++n) _Pragma("unroll") for (int k = 0; k < 2; ++k) \
        acc[ai][bj][m][n] = __builtin_amdgcn_mfma_f32_16x16x32_bf16(Bt[n][k], At[m][k], acc[ai][bj][m][n], 0, 0, 0); __builtin_amdgcn_s_setprio(0); } while (0)
#define PG8_WAIT_V(n) asm volatile("s_waitcnt vmcnt(" #n ")" ::: "memory")
#define PG8_WAIT_L(n) asm volatile("s_waitcnt lgkmcnt(" #n ")" ::: "memory")
#define PG8_BAR __builtin_amdgcn_s_barrier()
#define PG8_SCHED __builtin_amdgcn_sched_barrier(0)
    Unit cur, nxt; int ui = 0;
    if (!S.next(0, cur)) return;
    f32x4 acc[2][2][4][2];
#pragma unroll
    for (int a = 0; a < 2; ++a)
#pragma unroll
        for (int b = 0; b < 2; ++b)
#pragma unroll
            for (int m = 0; m < 4; ++m)
#pragma unroll
                for (int n = 0; n < 2; ++n) acc[a][b][m][n] = (f32x4){0.f, 0.f, 0.f, 0.f};
    bf16x8 At[4][2], B0[2][2], B1[2][2];
    const char* cA = (const char*)g.A + (size_t)cur.pm * tstepA; const char* cB = (const char*)g.Bt + (size_t)cur.pn * tstepB;
    S.a_ready(cur);
    if constexpr (SP2) {
        PG8_STAGE(PG8_SB(0, 0), cB, voffB); PG8_STAGE(PG8_SB(0, 1), cB + hstepB, voffB); PG8_STAGE(PG8_SA(0, 0), cA, voffA); PG8_STAGE(PG8_SA(0, 1), cA + hstepA, voffA);
        if (wr == 1) PG8_BAR;
        PG8_WAIT_V(2); PG8_BAR;
        PG8_STAGE(PG8_SB(1, 0), cB + kstep, voffB); PG8_STAGE(PG8_SA(1, 0), cA + kstep, voffA); PG8_STAGE(PG8_SB(1, 1), cB + hstepB + kstep, voffB);
        PG8_WAIT_V(6); PG8_BAR;
    } else {
        PG8_STAGE(PG8_SB(0, 0), cB, voffB); PG8_STAGE(PG8_SA(0, 0), cA, voffA); PG8_STAGE(PG8_SB(0, 1), cB + hstepB, voffB); PG8_STAGE(PG8_SA(0, 1), cA + hstepA, voffA);
        if (wr == 1) PG8_BAR;
        PG8_WAIT_V(4); PG8_BAR;
        PG8_STAGE(PG8_SB(1, 0), cB + kstep, voffB); PG8_STAGE(PG8_SA(1, 0), cA + kstep, voffA); PG8_STAGE(PG8_SB(1, 1), cB + hstepB + kstep, voffB);
        PG8_WAIT_V(6); PG8_BAR;
    }
    for (;;) {
        const bool has_next = S.next(ui + 1, nxt);
        const char* nA = has_next ? (const char*)g.A + (size_t)nxt.pm * tstepA : cA; const char* nB = has_next ? (const char*)g.Bt + (size_t)nxt.pn * tstepB : cB;
        for (int t = 0; t < nt; t += 2) {
            const bool last = (t == nt - 2);
            const char* a1 = cA + (size_t)(t + 1) * kstep;
            const char* a2 = last ? nA : cA + (size_t)(t + 2) * kstep; const char* b2 = last ? nB : cB + (size_t)(t + 2) * kstep;
            const char* a3 = a2 + kstep; const char* b3 = b2 + kstep;
            if (last && has_next) S.a_ready(nxt);
            if constexpr (SP2) {
            PG8_LDB(B0, 0, 0); PG8_LDB(B1, 0, 1); PG8_SCHED; PG8_LDA(At, 0, 0); PG8_STAGE(PG8_SA(1, 1), a1 + hstepA, voffA);
            PG8_WAIT_V(8); PG8_WAIT_L(0); PG8_BAR; PG8_MMA(0, 0, At, B0); PG8_MMA(0, 1, At, B1); PG8_BAR; PG8_SCHED;
            PG8_LDA(At, 0, 1); PG8_STAGE(PG8_SB(0, 0), b2, voffB); PG8_STAGE(PG8_SB(0, 1), b2 + hstepB, voffB); PG8_STAGE(PG8_SA(0, 0), a2, voffA);
            PG8_WAIT_V(8); PG8_WAIT_L(0); PG8_BAR; PG8_MMA(1, 0, At, B0); PG8_MMA(1, 1, At, B1); PG8_BAR; PG8_SCHED;
            PG8_LDB(B0, 1, 0); PG8_LDB(B1, 1, 1); PG8_SCHED; PG8_LDA(At, 1, 0); PG8_STAGE(PG8_SA(0, 1), a2 + hstepA, voffA);
            PG8_WAIT_V(8); PG8_WAIT_L(0); PG8_BAR; PG8_MMA(0, 0, At, B0); PG8_MMA(0, 1, At, B1); PG8_BAR; PG8_SCHED;
            PG8_LDA(At, 1, 1); PG8_STAGE(PG8_SB(1, 0), b3, voffB); PG8_STAGE(PG8_SB(1, 1), b3 + hstepB, voffB); PG8_STAGE(PG8_SA(1, 0), a3, voffA);
            PG8_WAIT_V(8); PG8_WAIT_L(0); PG8_BAR; PG8_MMA(1, 0, At, B0); PG8_MMA(1, 1, At, B1); PG8_BAR; PG8_SCHED;
            } else {
            PG8_LDB(B0, 0, 0); PG8_SCHED; PG8_LDA(At, 0, 0); PG8_STAGE(PG8_SA(1, 1), a1 + hstepA, voffA);
            PG8_WAIT_L(8); PG8_BAR; PG8_WAIT_L(0); PG8_MMA(0, 0, At, B0); PG8_BAR; PG8_SCHED;
            PG8_LDB(B1, 0, 1); PG8_STAGE(PG8_SB(0, 0), b2, voffB);
            PG8_BAR; PG8_WAIT_L(0); PG8_MMA(0, 1, At, B1); PG8_BAR;
            PG8_LDA(At, 0, 1); PG8_STAGE(PG8_SA(0, 0), a2, voffA);
            PG8_BAR; PG8_WAIT_L(0); PG8_MMA(1, 0, At, B0); PG8_BAR; PG8_SCHED;
            PG8_STAGE(PG8_SB(0, 1), b2 + hstepB, voffB);
            PG8_WAIT_V(6); PG8_BAR; PG8_MMA(1, 1, At, B1); PG8_BAR;
            PG8_LDB(B0, 1, 0); PG8_SCHED; PG8_LDA(At, 1, 0); PG8_STAGE(PG8_SA(0, 1), a2 + hstepA, voffA);
            PG8_WAIT_L(8); PG8_BAR; PG8_WAIT_L(0); PG8_MMA(0, 0, At, B0); PG8_BAR; PG8_SCHED;
            PG8_LDB(B1, 1, 1); PG8_STAGE(PG8_SB(1, 0), b3, voffB);
            PG8_BAR; PG8_WAIT_L(0); PG8_MMA(0, 1, At, B1); PG8_BAR;
            PG8_LDA(At, 1, 1); PG8_STAGE(PG8_SA(1, 0), a3, voffA);
            PG8_BAR; PG8_WAIT_L(0); PG8_MMA(1, 0, At, B0); PG8_BAR; PG8_SCHED;
            PG8_STAGE(PG8_SB(1, 1), b3 + hstepB, voffB);
            PG8_WAIT_V(6); PG8_BAR; PG8_MMA(1, 1, At, B1); PG8_BAR;
            }
        }
        if constexpr (ALIGN_EPI) { if (wr == 0) PG8_BAR; }
        if constexpr (!Epi::AFTER_DRAIN) { E(acc, cur, wr, wc, fr, fq); S.done(cur); }
        if (!has_next) break;
#pragma unroll
        for (int a = 0; a < 2; ++a)
#pragma unroll
            for (int b = 0; b < 2; ++b)
#pragma unroll
                for (int m = 0; m < 4; ++m)
#pragma unroll
                    for (int n = 0; n < 2; ++n) acc[a][b][m][n] = (f32x4){0.f, 0.f, 0.f, 0.f};
        cur = nxt; cA = nA; cB = nB; ++ui;
        if constexpr (ALIGN_EPI) { if (wr == 1) PG8_BAR; }
    }
    PG8_WAIT_V(0);
    if constexpr (!ALIGN_EPI) { if (wr == 0) PG8_BAR; }
    PG8_BAR;
    if constexpr (Epi::AFTER_DRAIN) { E.fused(acc, cur, wr, wc, fr, fq, lds, wid, lane); S.done(cur); }
#undef PG8_SA
#undef PG8_SB
#undef PG8_STAGE
#undef PG8_LDA
#undef PG8_LDB
#undef PG8_MMA
#undef PG8_WAIT_V
#undef PG8_WAIT_L
#undef PG8_BAR
#undef PG8_SCHED
}
}

namespace pg8 {
__device__ __forceinline__ float bfu_lo(unsigned w) { return __builtin_bit_cast(float, w << 16); }
__device__ __forceinline__ float bfu_hi(unsigned w) { return __builtin_bit_cast(float, w & 0xffff0000u); }
__device__ __forceinline__ float sigmoidf_(float x) { return 1.f / (1.f + __expf(-x)); }

template <int ACT  > struct EpiStore {
    static constexpr bool PERM = true, AFTER_DRAIN = false;
    bf16_t* O; int ldc;
    __device__ __forceinline__ void operator()(const f32x4 (&acc)[2][2][4][2], const Unit& u, int wr, int wc, int fr, int fq) const {
        const int row0 = u.pm * BM + wr * 64 + fr, col0 = u.pn * BM + wc * 32 + 8 * fq;
#pragma unroll
        for (int ai = 0; ai < 2; ++ai)
#pragma unroll
            for (int m = 0; m < 4; ++m) { bf16_t* rowp = O + (size_t)(row0 + ai * HALF + m * 16) * ldc + col0;
#pragma unroll
                for (int bj = 0; bj < 2; ++bj) { f32x4 v0 = acc[ai][bj][m][0], v1 = acc[ai][bj][m][1];
                    if (ACT == 1) {
#pragma unroll
                        for (int j = 0; j < 4; ++j) { v0[j] = sigmoidf_(v0[j]); v1[j] = sigmoidf_(v1[j]); } }
                    u32x4 w; w.x = cvt_pk_bf16(v0[0], v0[1]); w.y = cvt_pk_bf16(v0[2], v0[3]); w.z = cvt_pk_bf16(v1[0], v1[1]); w.w = cvt_pk_bf16(v1[2], v1[3]);
                    *(u32x4*)(rowp + bj * HALF) = w; } }
    }
};

struct EpiGateAcc {
    static constexpr bool PERM = true, AFTER_DRAIN = false;
    const bf16_t* GS; bf16_t* MG; int ld; int first; const float* ssq;
    __device__ __forceinline__ void operator()(const f32x4 (&acc)[2][2][4][2], const Unit& u, int wr, int wc, int fr, int fq) const {
        const int row0 = u.pm * BM + wr * 64 + fr, col0 = u.pn * BM + wc * 32 + 8 * fq;
#pragma unroll
        for (int ai = 0; ai < 2; ++ai)
#pragma unroll
            for (int m = 0; m < 4; ++m) { const int row = row0 + ai * HALF + m * 16; const size_t ro = (size_t)row * ld + col0;
                float rs = 1.f;
                if (ssq) { float s = 0.f;
#pragma unroll
                    for (int q = 0; q < 8; ++q) { const f32x4 v = *(const f32x4*)(ssq + (size_t)row * 32 + 4 * q); s += (v[0] + v[1]) + (v[2] + v[3]); }
                    rs = rsqrtf(s * (1.f / 512.f) + 1e-6f); }
#pragma unroll
                for (int bj = 0; bj < 2; ++bj) { const f32x4 a0 = acc[ai][bj][m][0], a1 = acc[ai][bj][m][1];
                    const u32x4 g = *(const u32x4*)(GS + ro + bj * HALF);
                    u32x4 o = (u32x4){0u, 0u, 0u, 0u}; if (!first) o = *(const u32x4*)(MG + ro + bj * HALF);
                    float r[8];
                    r[0] = bfu_lo(o.x) + bfu_lo(g.x) * a0[0] * rs; r[1] = bfu_hi(o.x) + bfu_hi(g.x) * a0[1] * rs;
                    r[2] = bfu_lo(o.y) + bfu_lo(g.y) * a0[2] * rs; r[3] = bfu_hi(o.y) + bfu_hi(g.y) * a0[3] * rs;
                    r[4] = bfu_lo(o.z) + bfu_lo(g.z) * a1[0] * rs; r[5] = bfu_hi(o.z) + bfu_hi(g.z) * a1[1] * rs;
                    r[6] = bfu_lo(o.w) + bfu_lo(g.w) * a1[2] * rs; r[7] = bfu_hi(o.w) + bfu_hi(g.w) * a1[3] * rs;
                    u32x4 w; w.x = cvt_pk_bf16(r[0], r[1]); w.y = cvt_pk_bf16(r[2], r[3]); w.z = cvt_pk_bf16(r[4], r[5]); w.w = cvt_pk_bf16(r[6], r[7]);
                    *(u32x4*)(MG + ro + bj * HALF) = w; } }
    }
};

struct EpiResid {
    static constexpr bool PERM = true, AFTER_DRAIN = false;
    const float* XI; float* XO;
    __device__ __forceinline__ void operator()(const f32x4 (&acc)[2][2][4][2], const Unit& u, int wr, int wc, int fr, int fq) const {
        const int row0 = u.pm * BM + wr * 64 + fr, col0 = u.pn * BM + wc * 32 + 8 * fq;
#pragma unroll
        for (int ai = 0; ai < 2; ++ai)
#pragma unroll
            for (int m = 0; m < 4; ++m) { const size_t ro = (size_t)(row0 + ai * HALF + m * 16) * 1024 + col0;
#pragma unroll
                for (int bj = 0; bj < 2; ++bj) {
#pragma unroll
                    for (int n = 0; n < 2; ++n) { const f32x4 x0 = *(const f32x4*)(XI + ro + bj * HALF + 4 * n); *(f32x4*)(XO + ro + bj * HALF + 4 * n) = x0 + acc[ai][bj][m][n]; } } }
    }
};

struct EpiSwiglu {
    static constexpr bool PERM = true, AFTER_DRAIN = false;
    bf16_t* H; int ldc;
    __device__ __forceinline__ void operator()(const f32x4 (&acc)[2][2][4][2], const Unit& u, int wr, int wc, int fr, int fq) const {
        const int row0 = u.pm * BM + wr * 64 + fr, col0 = u.pn * 128 + wc * 16 + 4 * fq;
#pragma unroll
        for (int ai = 0; ai < 2; ++ai)
#pragma unroll
            for (int m = 0; m < 4; ++m) { bf16_t* rowp = H + (size_t)(row0 + ai * HALF + m * 16) * ldc + col0;
#pragma unroll
                for (int bj = 0; bj < 2; ++bj) { const f32x4 a = acc[ai][bj][m][0], b = acc[ai][bj][m][1]; float r[4];
#pragma unroll
                    for (int j = 0; j < 4; ++j) r[j] = a[j] * sigmoidf_(a[j]) * b[j];
                    unsigned long long w = (unsigned long long)cvt_pk_bf16(r[0], r[1]) | ((unsigned long long)cvt_pk_bf16(r[2], r[3]) << 32);
                    *(unsigned long long*)(rowp + bj * 64) = w; } }
    }
};
}

typedef unsigned short bf16;
typedef float f32x4 __attribute__((ext_vector_type(4)));
typedef unsigned u32x4 __attribute__((ext_vector_type(4)));
typedef unsigned u32x2 __attribute__((ext_vector_type(2)));
#define LAS __attribute__((address_space(3)))
constexpr int NT = 16384, SEQL = 4096, DM = 1024, PW = 4608, INW = 10248, FFH = 2816;
constexpr float EPSN = 1e-6f;
constexpr size_t MiB = 1u << 20;
constexpr size_t WS_W = 0, WS_XN = 48 * MiB, WS_PROJ = 80 * MiB, WS_MISC = 224 * MiB, WS_VT = 232 * MiB, WS_WVT = 280 * MiB, WS_XCT = 284 * MiB, WS_SSQ32 = 308 * MiB, WS_END = 310 * MiB;
constexpr size_t W_IN = 0, W_G = W_IN + (size_t)4608 * 1024, W_B = W_G + (size_t)4096 * 1024, W_MO = W_B + (size_t)4 * 1024 * 512, W_XQ = W_MO + (size_t)1024 * 1024,
                 W_XKV = W_XQ + (size_t)512 * 1024, W_XO = W_XKV + (size_t)1024 * 1024, W_FI = W_XO + (size_t)1024 * 512, W_FO = W_FI + (size_t)5632 * 1024, W_TOT = W_FO + (size_t)1024 * 2816;
static_assert(W_TOT * 2 <= 48 * MiB, "weights fit");
constexpr size_t MS_DT = 0, MS_SSQ = 512 * 1024, MS_MN = 1 * MiB, MS_KV = 3 * MiB, MS_VTX = 5 * MiB, MS_ROPE = 6 * MiB;
constexpr int C_AQ = 0, C_AK = 512, C_BQ = 1024, C_BK = 1280, C_BG = 1536, C_CQ = 2048, C_CK = 2560, C_DZ = 3072, C_DX = 3584;
constexpr int VT_A = 0, VT_C = 512, VT_B = 1024;
constexpr int C_GS = 512, C_MG = 3584;
constexpr int LDS_BYTES = 147456;

__device__ __forceinline__ float bf2f(bf16 v) { return __builtin_bit_cast(float, (unsigned)v << 16); }
__device__ __forceinline__ float bflo(unsigned w) { return __builtin_bit_cast(float, w << 16); }
__device__ __forceinline__ float bfhi(unsigned w) { return __builtin_bit_cast(float, w & 0xffff0000u); }
__device__ __forceinline__ unsigned f2bf(float f) { unsigned u = __builtin_bit_cast(unsigned, f); return (u + 0x7fffu + ((u >> 16) & 1u)) >> 16; }
__device__ __forceinline__ unsigned pk2(float lo, float hi) { return f2bf(lo) | (f2bf(hi) << 16); }
__device__ __forceinline__ float wave_sum(float v) {
#pragma unroll
    for (int o = 1; o < 64; o <<= 1) v += __shfl_xor(v, o);
    return v;
}
__device__ __forceinline__ float siluf_(float x) { return x / (1.f + __expf(-x)); }
__device__ __forceinline__ void unpack8(const u32x4 w, float* f) { f[0] = bflo(w.x); f[1] = bfhi(w.x); f[2] = bflo(w.y); f[3] = bfhi(w.y); f[4] = bflo(w.z); f[5] = bfhi(w.z); f[6] = bflo(w.w); f[7] = bfhi(w.w); }

#ifndef PHMASK
#define PHMASK 0xFFFF
#endif
struct Args { const float* in[24]; float* out; unsigned char* ws; int ph_lo, ph_hi; };
typedef const __attribute__((address_space(4))) Args* ArgP;
struct Ctx {
    unsigned char* ws;
    int tid, lane, wave, wg, nwg;
};

__device__ __forceinline__ void conv_w(const Ctx& c, const float* W, int srcN, int K, int Ndst, bf16* WT, int mode, int off, int rot) {
    const int nb = Ndst / 64, kb = K / 64, tot = nb * kb;
    int start = c.wg - (rot % c.nwg); if (start < 0) start += c.nwg;
    for (int it = start; it < tot; it += c.nwg) {
        const int n = (it % nb) * 64 + (c.tid & 63), k0 = (it / nb) * 64 + (c.tid >> 6) * 8;
        const int sc = mode == 0 ? off + n : (((n & 7) < 4) ? (n >> 3) * 4 + (n & 3) : FFH + (n >> 3) * 4 + (n & 3));
        const float* src = W + (size_t)k0 * srcN + sc;
        float v[8];
#pragma unroll
        for (int j = 0; j < 8; ++j) v[j] = src[(size_t)j * srcN];
        u32x4 o; o.x = pk2(v[0], v[1]); o.y = pk2(v[2], v[3]); o.z = pk2(v[4], v[5]); o.w = pk2(v[6], v[7]);
        *(u32x4*)(WT + (size_t)n * K + k0) = o;
    }
}
__device__ __forceinline__ void convert_layer(const Ctx& c, ArgP A, int l) {
    bf16* Wb = (bf16*)(c.ws + WS_W);
    const float* w_in = A->in[3] + (size_t)l * DM * INW;
    conv_w(c, w_in, INW, 1024, 1024, Wb + W_IN, 0, 0, 0);
    conv_w(c, w_in, INW, 1024, 512, Wb + W_IN + (size_t)1024 * 1024, 0, 1536, 16);
    conv_w(c, w_in, INW, 1024, 512, Wb + W_IN + (size_t)1536 * 1024, 0, 2560, 80);
    conv_w(c, w_in, INW, 1024, 1024, Wb + W_IN + (size_t)2048 * 1024, 0, 3072, 144);
    conv_w(c, w_in, INW, 1024, 1536, Wb + W_IN + (size_t)3072 * 1024, 0, 4608, 0);
    conv_w(c, w_in, INW, 1024, 4096, Wb + W_G, 0, 6152, 0);
    conv_w(c, w_in, INW, 1024, 512, (bf16*)(c.ws + WS_WVT), 0, 1024, 64);
    conv_w(c, w_in, INW, 1024, 512, (bf16*)(c.ws + WS_WVT) + (size_t)512 * 1024, 0, 4096, 192);
    conv_w(c, w_in, INW, 1024, 512, (bf16*)(c.ws + WS_WVT) + (size_t)1024 * 1024, 0, 2048, 128);
    for (int i = 0; i < 4; ++i) conv_w(c, A->in[13] + ((size_t)l * 4 + i) * 512 * 1024, 1024, 512, 1024, Wb + W_B + (size_t)i * 1024 * 512, 0, 0, 32 * i);
    conv_w(c, A->in[14] + (size_t)l * 1024 * 1024, 1024, 1024, 1024, Wb + W_MO, 0, 0, 128);
    conv_w(c, A->in[17] + (size_t)l * 1024 * 512, 512, 1024, 512, Wb + W_XQ, 0, 0, 0);
    conv_w(c, A->in[18] + (size_t)l * 1024 * 1024, 1024, 1024, 1024, Wb + W_XKV, 0, 0, 128);
    conv_w(c, A->in[19] + (size_t)l * 512 * 1024, 1024, 512, 1024, Wb + W_XO, 0, 0, 0);
    conv_w(c, A->in[21] + (size_t)l * 1024 * 5632, 5632, 1024, 5632, Wb + W_FI, 1, 0, 128);
    conv_w(c, A->in[22] + (size_t)l * FFH * 1024, 1024, FFH, 1024, Wb + W_FO, 0, 0, 0);
}

__device__ __forceinline__ void norm_rows(const Ctx& c, const float* X, const float* g, bf16* out, int nrows, const float* Wdt, float* dt_out) {
    const int gw = c.wg * 8 + c.wave, ngw = c.nwg * 8, lane = c.lane;
    f32x4 gv[4];
#pragma unroll
    for (int j = 0; j < 4; ++j) gv[j] = *((const f32x4*)g + lane + 64 * j);
    for (int row = gw; row < nrows; row += ngw) {
        const f32x4* xr = (const f32x4*)(X + (size_t)row * DM) + lane;
        f32x4 v[4]; float s = 0.f;
#pragma unroll
        for (int j = 0; j < 4; ++j) { v[j] = xr[64 * j]; s += (v[j].x * v[j].x + v[j].y * v[j].y) + (v[j].z * v[j].z + v[j].w * v[j].w); }
        const float rs = rsqrtf(wave_sum(s) * (1.f / DM) + EPSN);
        unsigned long long* o8 = (unsigned long long*)(out + (size_t)row * DM) + lane;
#pragma unroll
        for (int j = 0; j < 4; ++j) { v[j] = v[j] * rs * gv[j]; o8[64 * j] = (unsigned long long)pk2(v[j].x, v[j].y) | ((unsigned long long)pk2(v[j].z, v[j].w) << 32); }
        if (Wdt) {
            f32x4 a0 = (f32x4){0.f, 0.f, 0.f, 0.f}, a1 = a0;
#pragma unroll
            for (int j = 0; j < 4; ++j)
#pragma unroll
                for (int e = 0; e < 4; ++e) { const int k = 4 * lane + 256 * j + e; const float* wp = Wdt + (size_t)k * INW + 6144;
                    const f32x4 w0 = *(const f32x4*)wp, w1 = *(const f32x4*)(wp + 4); a0 += w0 * v[j][e]; a1 += w1 * v[j][e]; }
#pragma unroll
            for (int e = 0; e < 4; ++e) { a0[e] = wave_sum(a0[e]); a1[e] = wave_sum(a1[e]); }
            if (lane == 0) { *(f32x4*)(dt_out + (size_t)row * 8) = a0; *(f32x4*)(dt_out + (size_t)row * 8 + 4) = a1; }
        }
    }
}
__device__ __forceinline__ void final_norm(const Ctx& c, float* X, const float* g) {
    const int gw = c.wg * 8 + c.wave, ngw = c.nwg * 8, lane = c.lane;
    for (int row = gw; row < NT; row += ngw) {
        f32x4* xr = (f32x4*)(X + (size_t)row * DM) + lane;
        f32x4 v[4]; float s = 0.f;
#pragma unroll
        for (int j = 0; j < 4; ++j) { v[j] = xr[64 * j]; s += (v[j].x * v[j].x + v[j].y * v[j].y) + (v[j].z * v[j].z + v[j].w * v[j].w); }
        const float rs = rsqrtf(wave_sum(s) * (1.f / DM) + EPSN);
#pragma unroll
        for (int j = 0; j < 4; ++j) xr[64 * j] = v[j] * rs * *((const f32x4*)g + lane + 64 * j);
    }
}

#define OSM_UPDATE(sc, NV, vexpr) do { float _p; if ((sc) > mrun) { const float _r = __expf(mrun - (sc)); lrun *= _r; _Pragma("unroll") for (int _i = 0; _i < NV; ++_i) o[_i] *= _r; mrun = (sc); _p = 1.f; } \
    else _p = __expf((sc) - mrun); lrun += _p; _Pragma("unroll") for (int _i = 0; _i < NV; ++_i) o[_i] += _p * (vexpr); } while (0)

typedef short bf16x8_t __attribute__((ext_vector_type(8)));
typedef short s16x4_t __attribute__((ext_vector_type(4)));
typedef float f32x2_t __attribute__((ext_vector_type(2)));
typedef __bf16 bf16x2_t __attribute__((ext_vector_type(2)));
#define MFMA16(a, b, c) __builtin_amdgcn_mfma_f32_16x16x32_bf16((a), (b), (c), 0, 0, 0)
__device__ __forceinline__ unsigned cvtpk(float lo, float hi) { f32x2_t v = {lo, hi}; bf16x2_t b = __builtin_convertvector(v, bf16x2_t); return __builtin_bit_cast(unsigned, b); }
__device__ __forceinline__ bf16x8_t pack8(const float* p) { u32x4 w; w.x = cvtpk(p[0], p[1]); w.y = cvtpk(p[2], p[3]); w.z = cvtpk(p[4], p[5]); w.w = cvtpk(p[6], p[7]); return __builtin_bit_cast(bf16x8_t, w); }
__device__ __forceinline__ float ex2(float x) { return __builtin_amdgcn_exp2f(x); }

__device__ __forceinline__ void mixer_c_mfma(const Ctx& c, ArgP A, unsigned char* lds_raw, int l) {
    bf16* P = (bf16*)(c.ws + WS_PROJ); const bf16* VT = (const bf16*)(c.ws + WS_VT) + (size_t)VT_C * NT;
    unsigned char* sK = lds_raw;
    unsigned char* sV = lds_raw + 64 * 272;
    const float* lp = A->in[5] + (size_t)l * 256;
    float d0 = 0.f, d1 = 0.f;
    for (int i = 0; i < 64; ++i) { d0 += lp[i] * lp[64 + i]; d1 += lp[128 + i] * lp[192 + i]; }
    const float lam_init = 0.8f - 0.6f * expf(-0.3f * (float)l);
    const float lam = expf(d0) - expf(d1) + lam_init;
    const float* sg = A->in[6] + (size_t)l * 128;
    const int tid = c.tid, lane = c.lane, wave = c.wave, fr = lane & 15, fq = lane >> 4;
    constexpr float C2 = 0.125f * 1.4426950408889634f;
    for (int u0 = c.wg; u0 < 512; u0 += c.nwg) {
        const int r = u0 / c.nwg; const int idx = u0 % 256;
        int bh, qblk;
        if (c.nwg == 256) { bh = idx & 15; const int qq = idx >> 4; qblk = (r == 0) ? 31 - qq : qq; }
        else { bh = u0 & 15; qblk = u0 >> 4; }
        const int b = bh >> 2, h = bh & 3;
        const int qs = qblk * 128 + wave * 16 + fr;
        bf16* qp = P + ((size_t)b * SEQL + qs) * PW + C_CQ + h * 128;
        bf16x8_t qf[2][2];
#pragma unroll
        for (int c2 = 0; c2 < 2; ++c2)
#pragma unroll
            for (int ks = 0; ks < 2; ++ks) qf[c2][ks] = *(const bf16x8_t*)(qp + c2 * 64 + ks * 32 + fq * 8);
        f32x4 oacc[2][8];
#pragma unroll
        for (int c2 = 0; c2 < 2; ++c2)
#pragma unroll
            for (int eb = 0; eb < 8; ++eb) oacc[c2][eb] = (f32x4){0.f, 0.f, 0.f, 0.f};
        float mrun[2] = {-1e30f, -1e30f}, lrun[2] = {0.f, 0.f};
        const int qmax_w = qblk * 128 + wave * 16 + 15;
        const int ntile = 2 * (qblk + 1);
        for (int kt = 0; kt < ntile; ++kt) {
            __syncthreads();
            {
                const size_t rowb = (size_t)b * SEQL + kt * 64;
#pragma unroll
                for (int i = 0; i < 2; ++i) { const int ch = tid + 512 * i;
                    { const int rr = ch >> 4, cc = ch & 15; *(u32x4*)(sK + rr * 272 + cc * 16) = *(const u32x4*)(P + (rowb + rr) * PW + C_CK + h * 128 + cc * 8); }
                    { const int e = ch >> 3, cc = ch & 7; *(u32x4*)(sV + e * 144 + cc * 16) = *(const u32x4*)(VT + (size_t)(h * 128 + e) * NT + rowb + cc * 8); } }
            }
            __syncthreads();
#pragma unroll
            for (int kb2 = 0; kb2 < 2; ++kb2) {
                const int k0 = kt * 64 + kb2 * 32;
                if (k0 > qmax_w) continue;
                bf16x8_t vf[8];
#pragma unroll
                for (int eb = 0; eb < 8; ++eb) { const unsigned char* vp = sV + (eb * 16 + fr) * 144 + (kb2 * 32 + 4 * fq) * 2;
                    const s16x4_t lo = *(const s16x4_t*)vp, hi = *(const s16x4_t*)(vp + 32); vf[eb] = __builtin_shufflevector(lo, hi, 0, 1, 2, 3, 4, 5, 6, 7); }
#pragma unroll
                for (int c2 = 0; c2 < 2; ++c2) {
                    f32x4 s0 = (f32x4){0.f, 0.f, 0.f, 0.f}, s1 = s0;
#pragma unroll
                    for (int ks = 0; ks < 2; ++ks) { const unsigned char* kp = sK + (kb2 * 32 + fr) * 272 + (c2 * 64 + ks * 32 + fq * 8) * 2;
                        const bf16x8_t ka = *(const bf16x8_t*)kp, kb = *(const bf16x8_t*)(kp + 16 * 272);
                        s0 = MFMA16(ka, qf[c2][ks], s0); s1 = MFMA16(kb, qf[c2][ks], s1); }
                    float sc[8]; bool vis[8];
#pragma unroll
                    for (int j = 0; j < 4; ++j) { const int kp0 = k0 + 4 * fq + j; vis[j] = kp0 <= qs; vis[4 + j] = (kp0 + 16) <= qs;
                        sc[j] = vis[j] ? s0[j] * C2 : -1e30f; sc[4 + j] = vis[4 + j] ? s1[j] * C2 : -1e30f; }
                    float mx = fmaxf(fmaxf(fmaxf(sc[0], sc[1]), fmaxf(sc[2], sc[3])), fmaxf(fmaxf(sc[4], sc[5]), fmaxf(sc[6], sc[7])));
                    mx = fmaxf(mx, __shfl_xor(mx, 16)); mx = fmaxf(mx, __shfl_xor(mx, 32));
                    const float mnew = fmaxf(mrun[c2], mx); const float alpha = ex2(mrun[c2] - mnew); mrun[c2] = mnew;
                    float p[8], ps = 0.f;
#pragma unroll
                    for (int i = 0; i < 8; ++i) { p[i] = vis[i] ? ex2(sc[i] - mnew) : 0.f; ps += p[i]; }
                    lrun[c2] = lrun[c2] * alpha + ps;
                    const bf16x8_t pf = pack8(p);
#pragma unroll
                    for (int eb = 0; eb < 8; ++eb) { oacc[c2][eb] = oacc[c2][eb] * alpha; oacc[c2][eb] = MFMA16(vf[eb], pf, oacc[c2][eb]); }
                }
            }
        }
        float linv[2];
#pragma unroll
        for (int c2 = 0; c2 < 2; ++c2) { float lt = lrun[c2]; lt += __shfl_xor(lt, 16); lt += __shfl_xor(lt, 32); linv[c2] = 1.f / lt; }
        float ss = 0.f;
#pragma unroll
        for (int eb = 0; eb < 8; ++eb) { oacc[0][eb] = oacc[0][eb] * linv[0] - oacc[1][eb] * (lam * linv[1]);
            ss += (oacc[0][eb][0] * oacc[0][eb][0] + oacc[0][eb][1] * oacc[0][eb][1]) + (oacc[0][eb][2] * oacc[0][eb][2] + oacc[0][eb][3] * oacc[0][eb][3]); }
        ss += __shfl_xor(ss, 16); ss += __shfl_xor(ss, 32);
        const float rs = rsqrtf(ss * (1.f / 128.f) + EPSN) * (1.f - lam_init);
#pragma unroll
        for (int eb = 0; eb < 8; ++eb) { const int e0 = eb * 16 + 4 * fq; const f32x4 g4 = *(const f32x4*)(sg + e0);
            const unsigned lo = cvtpk(oacc[0][eb][0] * rs * g4[0], oacc[0][eb][1] * rs * g4[1]), hi = cvtpk(oacc[0][eb][2] * rs * g4[2], oacc[0][eb][3] * rs * g4[3]);
            *(unsigned long long*)(qp + e0) = (unsigned long long)lo | ((unsigned long long)hi << 32); }
    }
    __syncthreads();
}

__device__ __forceinline__ void mixer_a_mfma(const Ctx& c) {
    bf16* P = (bf16*)(c.ws + WS_PROJ); const bf16* VTa = (const bf16*)(c.ws + WS_VT) + (size_t)VT_A * NT;
    const int lane = c.lane, fr = lane & 15, fq = lane >> 4;
    constexpr float C2 = 0.125f * 1.4426950408889634f;
    const int gw = c.wg * 8 + c.wave, ngw = c.nwg * 8;
    for (int g = gw; g < 8192; g += ngw) {
        const int r16 = g & 15, h = (g >> 4) & 7, blk = (g >> 7) & 15, b = g >> 11;
        const int sbase = blk * 256 + r16, qs = sbase + 16 * fr;
        const size_t tb = (size_t)b * SEQL;
        bf16* qp = P + (tb + qs) * PW + C_AQ + h * 64;
        bf16x8_t qf[2];
#pragma unroll
        for (int ks = 0; ks < 2; ++ks) qf[ks] = *(const bf16x8_t*)(qp + ks * 32 + fq * 8);
        f32x4 oacc[4];
#pragma unroll
        for (int eb = 0; eb < 4; ++eb) oacc[eb] = (f32x4){0.f, 0.f, 0.f, 0.f};
        float mrun = -1e30f, lrun = 0.f;
        for (int p = 0; p < 3; ++p) {
            const int sh = 2 * p, d = 1 << sh, qm = (16 * fr) >> sh, mhi = 240 >> sh;
            for (int m0 = -128; m0 <= mhi; m0 += 32) {
                if (sbase + d * (m0 + 31) < 0) continue;
                int tk0 = sbase + d * (m0 + fr), tk1 = tk0 + 16 * d;
                tk0 = min(max(tk0, 0), SEQL - 1); tk1 = min(max(tk1, 0), SEQL - 1);
                const bf16* k0p = P + (tb + tk0) * PW + C_AK + h * 64 + fq * 8; const bf16* k1p = P + (tb + tk1) * PW + C_AK + h * 64 + fq * 8;
                f32x4 s0 = (f32x4){0.f, 0.f, 0.f, 0.f}, s1 = s0;
#pragma unroll
                for (int ks = 0; ks < 2; ++ks) { const bf16x8_t ka = *(const bf16x8_t*)(k0p + ks * 32), kb = *(const bf16x8_t*)(k1p + ks * 32);
                    s0 = MFMA16(ka, qf[ks], s0); s1 = MFMA16(kb, qf[ks], s1); }
                float sc[8]; bool vis[8]; int tokv[8];
#pragma unroll
                for (int j = 0; j < 4; ++j) { const int m = m0 + 4 * fq + j; const int dj0 = qm - m, dj1 = dj0 - 16; const int t0 = sbase + d * m, t1 = t0 + 16 * d;
                    vis[j] = (dj0 >= 0) && (dj0 <= 128) && (t0 >= 0); vis[4 + j] = (dj1 >= 0) && (dj1 <= 128) && (t1 >= 0);
                    tokv[j] = min(max(t0, 0), SEQL - 1); tokv[4 + j] = min(max(t1, 0), SEQL - 1);
                    sc[j] = vis[j] ? s0[j] * C2 : -1e30f; sc[4 + j] = vis[4 + j] ? s1[j] * C2 : -1e30f; }
                float mx = fmaxf(fmaxf(fmaxf(sc[0], sc[1]), fmaxf(sc[2], sc[3])), fmaxf(fmaxf(sc[4], sc[5]), fmaxf(sc[6], sc[7])));
                mx = fmaxf(mx, __shfl_xor(mx, 16)); mx = fmaxf(mx, __shfl_xor(mx, 32));
                const float mnew = fmaxf(mrun, mx); const float alpha = ex2(mrun - mnew); mrun = mnew;
                float pr[8], ps = 0.f;
#pragma unroll
                for (int i = 0; i < 8; ++i) { pr[i] = vis[i] ? ex2(sc[i] - mnew) : 0.f; ps += pr[i]; }
                lrun = lrun * alpha + ps;
                const bf16x8_t pf = pack8(pr);
                const bf16* vb = VTa + (size_t)(h * 64 + fr) * NT + tb;
#pragma unroll
                for (int eb = 0; eb < 4; ++eb) { bf16x8_t vf;
#pragma unroll
                    for (int j = 0; j < 8; ++j) vf[j] = (short)vb[(size_t)eb * 16 * NT + tokv[j]];
                    oacc[eb] = oacc[eb] * alpha; oacc[eb] = MFMA16(vf, pf, oacc[eb]); }
            }
        }
        float lt = lrun; lt += __shfl_xor(lt, 16); lt += __shfl_xor(lt, 32); const float linv = 1.f / lt;
#pragma unroll
        for (int eb = 0; eb < 4; ++eb) { const unsigned lo = cvtpk(oacc[eb][0] * linv, oacc[eb][1] * linv), hi = cvtpk(oacc[eb][2] * linv, oacc[eb][3] * linv);
            *(unsigned long long*)(qp + eb * 16 + 4 * fq) = (unsigned long long)lo | ((unsigned long long)hi << 32); }
    }
}

__device__ __forceinline__ void mixer_b_mfma(const Ctx& c, ArgP A, unsigned char* lds_raw, int l, int unit) {
    bf16* P = (bf16*)(c.ws + WS_PROJ); const bf16* VTb = (const bf16*)(c.ws + WS_VT) + (size_t)VT_B * NT;
    const float* rope = (const float*)(c.ws + WS_MISC + MS_ROPE);
    unsigned char* sQ = lds_raw;
    unsigned char* sK = lds_raw + 9216;
    unsigned char* sKT = lds_raw + 18432;
    unsigned char* sP = lds_raw + 27648;
    float* sSt = (float*)(lds_raw + 35840);
    const int b = unit >> 2, h = unit & 3, tid = c.tid, lane = c.lane, w = c.wave, fr = lane & 15, fq = lane >> 4;
    const float lg = log2f(1.f - exp2f(-5.f - (float)h));
    const float* gn = A->in[4] + (size_t)l * 512 + h * 128;
    f32x4 R[4];
#pragma unroll
    for (int i = 0; i < 4; ++i) R[i] = (f32x4){0.f, 0.f, 0.f, 0.f};
    const bf16* vrow = VTb + (size_t)(h * 128 + 16 * w + fr) * NT + (size_t)b * SEQL;
    for (int ch = 0; ch < 64; ++ch) {
        const int s0 = ch * 64; const size_t t0 = (size_t)b * SEQL + s0;
#pragma unroll
        for (int r = 0; r < 8; ++r) { const int it = tid + 512 * r, which = it >> 11, tk = (it >> 5) & 63, i = it & 31;
            const bf16* src = P + (t0 + tk) * PW + (which ? C_BK : C_BQ) + h * 64;
            const float t1 = bf2f(src[i]), t2 = bf2f(src[i + 32]);
            const float2 cs = *(const float2*)(rope + ((size_t)(s0 + tk) * 32 + i) * 2);
            float r1 = t1 * cs.x - t2 * cs.y, r2 = t1 * cs.y + t2 * cs.x;
            if (which) { r1 *= 0.125f; r2 *= 0.125f;
                *(bf16*)(sK + tk * 144 + i * 2) = (bf16)f2bf(r1); *(bf16*)(sK + tk * 144 + (i + 32) * 2) = (bf16)f2bf(r2);
                const float dk = ex2((float)(63 - tk) * lg);
                *(bf16*)(sKT + i * 144 + tk * 2) = (bf16)f2bf(r1 * dk); *(bf16*)(sKT + (i + 32) * 144 + tk * 2) = (bf16)f2bf(r2 * dk); }
            else { *(bf16*)(sQ + tk * 144 + i * 2) = (bf16)f2bf(r1); *(bf16*)(sQ + tk * 144 + (i + 32) * 2) = (bf16)f2bf(r2); } }
        __syncthreads();
        if (w < 6) {
            const int qb = (w == 0) ? 0 : (w == 1) ? 1 : (w < 4) ? 2 : 3, kp = (w == 3 || w == 5) ? 1 : 0;
            f32x4 sa = (f32x4){0.f, 0.f, 0.f, 0.f}, sb = sa;
            const bool two = (2 * kp + 1) <= qb;
#pragma unroll
            for (int ks = 0; ks < 2; ++ks) { const bf16x8_t qf = *(const bf16x8_t*)(sQ + (qb * 16 + fr) * 144 + (ks * 32 + fq * 8) * 2);
                const bf16x8_t ka = *(const bf16x8_t*)(sK + (kp * 32 + fr) * 144 + (ks * 32 + fq * 8) * 2);
                sa = MFMA16(ka, qf, sa);
                if (two) { const bf16x8_t kb = *(const bf16x8_t*)(sK + (kp * 32 + 16 + fr) * 144 + (ks * 32 + fq * 8) * 2); sb = MFMA16(kb, qf, sb); } }
            float p[8]; const int qi = qb * 16 + fr;
#pragma unroll
            for (int j = 0; j < 4; ++j) { const int k0 = kp * 32 + 4 * fq + j, k1 = k0 + 16;
                p[j] = (k0 <= qi) ? sa[j] * ex2((float)(qi - k0) * lg) : 0.f; p[4 + j] = (k1 <= qi) ? sb[j] * ex2((float)(qi - k1) * lg) : 0.f; }
            *(bf16x8_t*)(sP + (qb * 2 + kp) * 1024 + lane * 16) = pack8(p);
        }
        f32x4 acc[4];
        {
            bf16x8_t Rop[2];
#pragma unroll
            for (int ks = 0; ks < 2; ++ks) { float t8[8];
#pragma unroll
                for (int j = 0; j < 4; ++j) { t8[j] = R[2 * ks][j]; t8[4 + j] = R[2 * ks + 1][j]; }
                Rop[ks] = pack8(t8); }
#pragma unroll
            for (int qb = 0; qb < 4; ++qb) { acc[qb] = (f32x4){0.f, 0.f, 0.f, 0.f};
#pragma unroll
                for (int ks = 0; ks < 2; ++ks) { const unsigned char* qp = sQ + (qb * 16 + fr) * 144 + (ks * 32 + 4 * fq) * 2;
                    const s16x4_t lo = *(const s16x4_t*)qp, hi = *(const s16x4_t*)(qp + 32);
                    acc[qb] = MFMA16(Rop[ks], __builtin_shufflevector(lo, hi, 0, 1, 2, 3, 4, 5, 6, 7), acc[qb]); }
                acc[qb] = acc[qb] * ex2((float)(qb * 16 + fr + 1) * lg); }
            f32x4 kvn[4];
#pragma unroll
            for (int db = 0; db < 4; ++db) kvn[db] = (f32x4){0.f, 0.f, 0.f, 0.f};
#pragma unroll
            for (int ks = 0; ks < 2; ++ks) { const bf16x8_t vf = *(const bf16x8_t*)(vrow + s0 + ks * 32 + fq * 8);
#pragma unroll
                for (int db = 0; db < 4; ++db) { const bf16x8_t kt = *(const bf16x8_t*)(sKT + (db * 16 + fr) * 144 + (ks * 32 + fq * 8) * 2); kvn[db] = MFMA16(kt, vf, kvn[db]); } }
            const float g64 = ex2(64.f * lg);
#pragma unroll
            for (int db = 0; db < 4; ++db) R[db] = R[db] * g64 + kvn[db];
        }
        __syncthreads();
        {
            bf16x8_t vfr[2];
#pragma unroll
            for (int kp = 0; kp < 2; ++kp) { const s16x4_t lo = *(const s16x4_t*)(vrow + s0 + kp * 32 + 4 * fq), hi = *(const s16x4_t*)(vrow + s0 + kp * 32 + 16 + 4 * fq);
                vfr[kp] = __builtin_shufflevector(lo, hi, 0, 1, 2, 3, 4, 5, 6, 7); }
#pragma unroll
            for (int qb = 0; qb < 4; ++qb)
#pragma unroll
                for (int kp = 0; kp < 2; ++kp) { if (2 * kp > qb) continue;
                    const bf16x8_t pf = *(const bf16x8_t*)(sP + (qb * 2 + kp) * 1024 + lane * 16); acc[qb] = MFMA16(vfr[kp], pf, acc[qb]); }
        }
#pragma unroll
        for (int qb = 0; qb < 4; ++qb) { float s1 = (acc[qb][0] + acc[qb][1]) + (acc[qb][2] + acc[qb][3]);
            float s2 = (acc[qb][0] * acc[qb][0] + acc[qb][1] * acc[qb][1]) + (acc[qb][2] * acc[qb][2] + acc[qb][3] * acc[qb][3]);
            s1 += __shfl_xor(s1, 16); s1 += __shfl_xor(s1, 32); s2 += __shfl_xor(s2, 16); s2 += __shfl_xor(s2, 32);
            if (fq == 0) { sSt[((qb * 16 + fr) * 8 + w) * 2] = s1; sSt[((qb * 16 + fr) * 8 + w) * 2 + 1] = s2; } }
        __syncthreads();
#pragma unroll
        for (int qb = 0; qb < 4; ++qb) { const int tk = qb * 16 + fr; float s1 = 0.f, s2 = 0.f;
#pragma unroll
            for (int ww = 0; ww < 8; ww += 2) { const f32x4 v = *(const f32x4*)(sSt + (tk * 8 + ww) * 2); s1 += v[0] + v[2]; s2 += v[1] + v[3]; }
            const float mu = s1 * (1.f / 128.f); const float var = fmaxf(s2 * (1.f / 128.f) - mu * mu, 0.f); const float rstd = rsqrtf(var + EPSN);
            const int e0 = 16 * w + 4 * fq; bf16* gp = P + (t0 + tk) * PW + C_BG + h * 128 + e0;
            const u32x2 gw = *(const u32x2*)gp; const f32x4 g4 = *(const f32x4*)(gn + e0);
            const float y0 = siluf_(bflo(gw.x)) * (acc[qb][0] - mu) * rstd * g4[0], y1 = siluf_(bfhi(gw.x)) * (acc[qb][1] - mu) * rstd * g4[1];
            const float y2 = siluf_(bflo(gw.y)) * (acc[qb][2] - mu) * rstd * g4[2], y3 = siluf_(bfhi(gw.y)) * (acc[qb][3] - mu) * rstd * g4[3];
            u32x2 o; o.x = cvtpk(y0, y1); o.y = cvtpk(y2, y3); *(u32x2*)gp = o; }
    }
    __syncthreads();
}

__device__ __forceinline__ void conv_prepass(const Ctx& c, ArgP A, int l, cg::grid_group& grid) {
    bf16* P = (bf16*)(c.ws + WS_PROJ); bf16* XCT = (bf16*)(c.ws + WS_XCT);
    const int item = c.wg * 512 + c.tid; const bool act = item < 131072;
    const int cg8 = item & 127, run = (item >> 7) & 1023, ch0 = cg8 * 8;
    const size_t tok0 = (size_t)run * 16; const int s_in = (int)(tok0 & (SEQL - 1));
    unsigned outp[16][4];
    if (act) {
        const float* cw = A->in[7] + (size_t)l * 4 * 1024 + ch0; const float* cb = A->in[8] + (size_t)l * 1024 + ch0;
        float wt[4][8], bias[8];
#pragma unroll
        for (int k = 0; k < 8; ++k) { bias[k] = cb[k];
#pragma unroll
            for (int w = 0; w < 4; ++w) wt[w][k] = cw[w * 1024 + k]; }
        float win[3][8];
#pragma unroll
        for (int r = 0; r < 3; ++r) {
            if (s_in == 0) {
#pragma unroll
                for (int k = 0; k < 8; ++k) win[r][k] = 0.f; }
            else unpack8(*(const u32x4*)(P + (tok0 - 3 + r) * PW + C_DX + ch0), win[r]); }
#pragma unroll
        for (int tk = 0; tk < 16; ++tk) { float cur[8]; unpack8(*(const u32x4*)(P + (tok0 + tk) * PW + C_DX + ch0), cur); float o[8];
#pragma unroll
            for (int k = 0; k < 8; ++k) { const float a = bias[k] + wt[0][k] * win[0][k] + wt[1][k] * win[1][k] + wt[2][k] * win[2][k] + wt[3][k] * cur[k]; o[k] = siluf_(a);
                win[0][k] = win[1][k]; win[1][k] = win[2][k]; win[2][k] = cur[k]; }
#pragma unroll
            for (int q = 0; q < 4; ++q) outp[tk][q] = cvtpk(o[2 * q], o[2 * q + 1]); }
        if (cg8 < 96) {
#pragma unroll
            for (int q = 0; q < 4; ++q) { u32x4 lo0, lo1, hi0, hi1;
#pragma unroll
                for (int m = 0; m < 4; ++m) { const unsigned a0 = outp[2 * m][q], a1 = outp[2 * m + 1][q], b0 = outp[8 + 2 * m][q], b1 = outp[8 + 2 * m + 1][q];
                    lo0[m] = (a0 & 0xffffu) | (a1 << 16); hi0[m] = (a0 >> 16) | (a1 & 0xffff0000u); lo1[m] = (b0 & 0xffffu) | (b1 << 16); hi1[m] = (b0 >> 16) | (b1 & 0xffff0000u); }
                bf16* r0 = XCT + (size_t)(ch0 + 2 * q) * NT + tok0; bf16* r1 = r0 + NT;
                *(u32x4*)r0 = lo0; *(u32x4*)(r0 + 8) = lo1; *(u32x4*)r1 = hi0; *(u32x4*)(r1 + 8) = hi1; } }
    }
    grid.sync();
    if (act) {
#pragma unroll
        for (int tk = 0; tk < 16; ++tk) { u32x4 o; o.x = outp[tk][0]; o.y = outp[tk][1]; o.z = outp[tk][2]; o.w = outp[tk][3]; *(u32x4*)(P + (tok0 + tk) * PW + C_DX + ch0) = o; }
    }
}

__device__ __forceinline__ void mixer_d_mfma(const Ctx& c, ArgP A, unsigned char* lds_raw, int l, int unit) {
    bf16* P = (bf16*)(c.ws + WS_PROJ); const bf16* XCT = (const bf16*)(c.ws + WS_XCT);
    unsigned char* sB = lds_raw;
    unsigned char* sC = lds_raw + 17408;
    unsigned char* sS = lds_raw + 34816;
    float* sDt = (float*)(lds_raw + 45056);
    float* sAc = sDt + 256;
    const int b = unit >> 2, pair = unit & 3, g = pair >> 1;
    const int tid = c.tid, lane = c.lane, w = c.wave, fr = lane & 15, fq = lane >> 4, hh = w >> 2, pb = w & 3, head = pair * 2 + hh;
    constexpr float L2E = 1.4426950408889634f;
    const int head_s = pair * 2 + (w & 1);
    const float dtb_s = A->in[9][l * 8 + head_s], An_s = -expf(A->in[10][l * 8 + head_s]);
    const float Dsk = A->in[11][l * 8 + head];
    const float* ngp = A->in[12] + (size_t)l * 512 + head * 64 + pb * 16 + 4 * fq;
    const float* dtr = (const float*)(c.ws + WS_MISC + MS_DT); float* ssq = (float*)(c.ws + WS_SSQ32);
    f32x4 H[8];
#pragma unroll
    for (int i = 0; i < 8; ++i) H[i] = (f32x4){0.f, 0.f, 0.f, 0.f};
    const bf16* xrow = XCT + (size_t)(head * 64 + pb * 16 + fr) * NT + (size_t)b * SEQL;
    const bf16* btrow = XCT + (size_t)(512 + g * 128 + fr) * NT + (size_t)b * SEQL;
    for (int ch = 0; ch < 64; ++ch) {
        const int s0 = ch * 64, par = ch & 1; const size_t t0 = (size_t)b * SEQL + s0;
#pragma unroll
        for (int r = 0; r < 4; ++r) { const int cn = tid + 512 * r, which = cn >> 10, tk = (cn >> 4) & 63, cc = cn & 15;
            *(u32x4*)((which ? sC : sB) + tk * 272 + cc * 16) = *(const u32x4*)(P + (t0 + tk) * PW + C_DX + 512 + which * 256 + g * 128 + cc * 8); }
        if (w < 2) { const float x = dtr[(t0 + lane) * 8 + head_s] + dtb_s; const float dt = fmaxf(x, 0.f) + log1pf(__expf(-fabsf(x)));
            float a = dt * An_s * L2E;
#pragma unroll
            for (int off = 1; off < 64; off <<= 1) { const float v = __shfl_up(a, off); if (lane >= off) a += v; }
            sDt[(par * 2 + w) * 64 + lane] = dt; sAc[(par * 2 + w) * 64 + lane] = a; }
        __syncthreads();
        const float* dtv = sDt + (par * 2 + hh) * 64; const float* acv = sAc + (par * 2 + hh) * 64;
        for (int ti = w; ti < 10; ti += 8) { const int qb = (ti >= 6) ? 3 : (ti >= 3) ? 2 : (ti >= 1) ? 1 : 0, kb = ti - qb * (qb + 1) / 2;
            f32x4 s = (f32x4){0.f, 0.f, 0.f, 0.f};
#pragma unroll
            for (int ks = 0; ks < 4; ++ks) { const bf16x8_t bfv = *(const bf16x8_t*)(sB + (kb * 16 + fr) * 272 + (ks * 32 + fq * 8) * 2), cfv = *(const bf16x8_t*)(sC + (qb * 16 + fr) * 272 + (ks * 32 + fq * 8) * 2);
                s = MFMA16(bfv, cfv, s); }
            *(f32x4*)(sS + ti * 1024 + lane * 16) = s; }
        f32x4 acc[4];
        {
            bf16x8_t Hop[4];
#pragma unroll
            for (int ks = 0; ks < 4; ++ks) { float t8[8];
#pragma unroll
                for (int j = 0; j < 4; ++j) { t8[j] = H[2 * ks][j]; t8[4 + j] = H[2 * ks + 1][j]; }
                Hop[ks] = pack8(t8); }
#pragma unroll
            for (int qb = 0; qb < 4; ++qb) { acc[qb] = (f32x4){0.f, 0.f, 0.f, 0.f};
#pragma unroll
                for (int ks = 0; ks < 4; ++ks) { const unsigned char* cp = sC + (qb * 16 + fr) * 272 + (ks * 32 + 4 * fq) * 2;
                    const s16x4_t lo = *(const s16x4_t*)cp, hi = *(const s16x4_t*)(cp + 32);
                    acc[qb] = MFMA16(Hop[ks], __builtin_shufflevector(lo, hi, 0, 1, 2, 3, 4, 5, 6, 7), acc[qb]); }
                acc[qb] = acc[qb] * ex2(acv[qb * 16 + fr]); }
        }
        {
            const float aend = acv[63];
            f32x4 kvn[8];
#pragma unroll
            for (int nb = 0; nb < 8; ++nb) kvn[nb] = (f32x4){0.f, 0.f, 0.f, 0.f};
#pragma unroll
            for (int ks = 0; ks < 2; ++ks) { float xv[8]; unpack8(*(const u32x4*)(xrow + s0 + ks * 32 + fq * 8), xv);
                const f32x4 d0 = *(const f32x4*)(dtv + ks * 32 + fq * 8), d1 = *(const f32x4*)(dtv + ks * 32 + fq * 8 + 4), a0 = *(const f32x4*)(acv + ks * 32 + fq * 8), a1 = *(const f32x4*)(acv + ks * 32 + fq * 8 + 4);
#pragma unroll
                for (int j = 0; j < 4; ++j) { xv[j] *= d0[j] * ex2(aend - a0[j]); xv[4 + j] *= d1[j] * ex2(aend - a1[j]); }
                const bf16x8_t xw = pack8(xv);
#pragma unroll
                for (int nb = 0; nb < 8; ++nb) { const bf16x8_t bt = *(const bf16x8_t*)(btrow + (size_t)nb * 16 * NT + s0 + ks * 32 + fq * 8); kvn[nb] = MFMA16(bt, xw, kvn[nb]); } }
            const float ge = ex2(aend);
#pragma unroll
            for (int nb = 0; nb < 8; ++nb) H[nb] = H[nb] * ge + kvn[nb];
        }
        __syncthreads();
        {
            bf16x8_t xfr[2];
#pragma unroll
            for (int kp = 0; kp < 2; ++kp) { const s16x4_t lo = *(const s16x4_t*)(xrow + s0 + kp * 32 + 4 * fq), hi = *(const s16x4_t*)(xrow + s0 + kp * 32 + 16 + 4 * fq);
                xfr[kp] = __builtin_shufflevector(lo, hi, 0, 1, 2, 3, 4, 5, 6, 7); }
#pragma unroll
            for (int qb = 0; qb < 4; ++qb) { const int qi = qb * 16 + fr; const float aq = acv[qi];
#pragma unroll
                for (int kp = 0; kp < 2; ++kp) { if (2 * kp > qb) continue;
                    const int ti = qb * (qb + 1) / 2 + 2 * kp; const bool two = (2 * kp + 1) <= qb;
                    const f32x4 sa = *(const f32x4*)(sS + ti * 1024 + lane * 16); f32x4 sb = (f32x4){0.f, 0.f, 0.f, 0.f}; if (two) sb = *(const f32x4*)(sS + (ti + 1) * 1024 + lane * 16);
                    const int k0 = kp * 32 + 4 * fq;
                    const f32x4 da = *(const f32x4*)(dtv + k0), db = *(const f32x4*)(dtv + k0 + 16), aa = *(const f32x4*)(acv + k0), ab = *(const f32x4*)(acv + k0 + 16);
                    float p[8];
#pragma unroll
                    for (int j = 0; j < 4; ++j) { p[j] = (k0 + j <= qi) ? sa[j] * da[j] * ex2(aq - aa[j]) : 0.f; p[4 + j] = (k0 + 16 + j <= qi) ? sb[j] * db[j] * ex2(aq - ab[j]) : 0.f; }
                    acc[qb] = MFMA16(xfr[kp], pack8(p), acc[qb]); } }
        }
#pragma unroll
        for (int qb = 0; qb < 4; ++qb) { const size_t t = t0 + qb * 16 + fr; const int p0 = head * 64 + pb * 16 + 4 * fq;
            const u32x2 xw = *(const u32x2*)(P + t * PW + C_DX + p0); bf16* zp = P + t * PW + C_DZ + p0; const u32x2 zw = *(const u32x2*)zp;
            const float y0 = (acc[qb][0] + Dsk * bflo(xw.x)) * siluf_(bflo(zw.x)), y1 = (acc[qb][1] + Dsk * bfhi(xw.x)) * siluf_(bfhi(zw.x));
            const float y2 = (acc[qb][2] + Dsk * bflo(xw.y)) * siluf_(bflo(zw.y)), y3 = (acc[qb][3] + Dsk * bfhi(xw.y)) * siluf_(bfhi(zw.y));
            float sq = (y0 * y0 + y1 * y1) + (y2 * y2 + y3 * y3); sq += __shfl_xor(sq, 16); sq += __shfl_xor(sq, 32);
            if (fq == 0) ssq[t * 32 + head * 4 + pb] = sq;
            const f32x4 g4 = *(const f32x4*)ngp; u32x2 o; o.x = cvtpk(y0 * g4[0], y1 * g4[1]); o.y = cvtpk(y2 * g4[2], y3 * g4[3]); *(u32x2*)zp = o; }
    }
    __syncthreads();
}

__device__ __forceinline__ void mixer_b_naive(const Ctx& c, ArgP A, unsigned char* lds_raw, int l, int unit) {
    bf16* P = (bf16*)(c.ws + WS_PROJ); const bf16* VTb = (const bf16*)(c.ws + WS_VT) + (size_t)VT_B * NT;
    float* sQ = (float*)lds_raw;
    float* sKk = sQ + 32 * 64;
    float* sVv = sKk + 32 * 64;
    float* sP = sVv + 32 * 128;
    const int b = unit >> 2, h = unit & 3, tid = c.tid, e = tid & 127, dg = tid >> 7;
    const float gamma = 1.f - exp2f(-5.f - (float)h);
    const float* gn = A->in[4] + (size_t)l * 512 + h * 128;
    float S[16];
#pragma unroll
    for (int i = 0; i < 16; ++i) S[i] = 0.f;
    for (int s0 = 0; s0 < SEQL; s0 += 32) {
        const size_t t0 = (size_t)b * SEQL + s0;
#pragma unroll
        for (int r = 0; r < 4; ++r) { const int it = tid + 512 * r, which = it >> 10, st = (it >> 5) & 31, i = it & 31;
            const bf16* src = P + (t0 + st) * PW + (which ? C_BK : C_BQ) + h * 64;
            const float t1 = bf2f(src[i]), t2 = bf2f(src[i + 32]);
            const float invf = powf(10000.f, -(float)i / 32.f); const float ang = (float)(s0 + st) * invf;
            float sn, cs; sincosf(ang, &sn, &cs);
            const float sc = which ? 0.125f : 1.f; float* dst = (which ? sKk : sQ) + st * 64;
            dst[i] = (t1 * cs - t2 * sn) * sc; dst[i + 32] = (t1 * sn + t2 * cs) * sc; }
#pragma unroll
        for (int r = 0; r < 8; ++r) { const int it = tid + 512 * r, st = it >> 7, ee = it & 127; sVv[st * 128 + ee] = bf2f(VTb[(size_t)(h * 128 + ee) * NT + t0 + st]); }
        __syncthreads();
        for (int st = 0; st < 32; ++st) {
            const float vv = sVv[st * 128 + e]; float po = 0.f;
#pragma unroll
            for (int i4 = 0; i4 < 4; ++i4) { const f32x4 kk = *(const f32x4*)(sKk + st * 64 + dg * 16 + 4 * i4), qq = *(const f32x4*)(sQ + st * 64 + dg * 16 + 4 * i4);
#pragma unroll
                for (int j = 0; j < 4; ++j) { S[4 * i4 + j] = gamma * S[4 * i4 + j] + kk[j] * vv; po += qq[j] * S[4 * i4 + j]; } }
            sP[(st * 4 + dg) * 128 + e] = po;
        }
        __syncthreads();
#pragma unroll
        for (int r = 0; r < 4; ++r) { const int st = c.wave * 4 + r, lane = c.lane;
            float o0 = 0.f, o1 = 0.f;
#pragma unroll
            for (int g = 0; g < 4; ++g) { o0 += sP[(st * 4 + g) * 128 + lane]; o1 += sP[(st * 4 + g) * 128 + lane + 64]; }
            const float mu = wave_sum(o0 + o1) * (1.f / 128.f); const float a0 = o0 - mu, a1 = o1 - mu;
            const float var = wave_sum(a0 * a0 + a1 * a1) * (1.f / 128.f); const float rstd = rsqrtf(var + EPSN);
            bf16* gp = P + (t0 + st) * PW + C_BG + h * 128;
            const float g0 = bf2f(gp[lane]), g1 = bf2f(gp[lane + 64]);
            gp[lane] = (bf16)f2bf(siluf_(g0) * a0 * rstd * gn[lane]); gp[lane + 64] = (bf16)f2bf(siluf_(g1) * a1 * rstd * gn[lane + 64]); }
    }
    __syncthreads();
}

__device__ __forceinline__ void mixer_d_naive(const Ctx& c, ArgP A, unsigned char* lds_raw, int l, int unit) {
    bf16* P = (bf16*)(c.ws + WS_PROJ);
    float* sXs = (float*)lds_raw;
    float* sB = sXs + 32 * 64;
    float* sC = sB + 32 * 128;
    float* sDt = sC + 32 * 128;
    float* sA = sDt + 32;
    float* sP = sA + 32;
    const int b = unit >> 3, hd = unit & 7, g = hd >> 2, tid = c.tid, p = tid & 63, ng = tid >> 6;
    const float* cw = A->in[7] + (size_t)l * 4 * 1024; const float* cb = A->in[8] + (size_t)l * 1024;
    const float dtb = A->in[9][l * 8 + hd], Aneg = -expf(A->in[10][l * 8 + hd]), Dsk = A->in[11][l * 8 + hd];
    const float* ng_ = A->in[12] + (size_t)l * 512 + hd * 64;
    const float* dtr = (const float*)(c.ws + WS_MISC + MS_DT); float* ssq = (float*)(c.ws + WS_MISC + MS_SSQ);
    float S[16];
#pragma unroll
    for (int i = 0; i < 16; ++i) S[i] = 0.f;
    for (int s0 = 0; s0 < SEQL; s0 += 32) {
        const size_t t0 = (size_t)b * SEQL + s0;
        for (int it = tid; it < 32 * 320; it += 512) { const int st = it / 320, ch = it % 320;
            int cc; float* dst;
            if (ch < 64) { cc = hd * 64 + ch; dst = sXs + st * 64 + ch; } else if (ch < 192) { cc = 512 + g * 128 + (ch - 64); dst = sB + st * 128 + (ch - 64); } else { cc = 768 + g * 128 + (ch - 192); dst = sC + st * 128 + (ch - 192); }
            float a = cb[cc];
#pragma unroll
            for (int w = 0; w < 4; ++w) { const int sp = s0 + st - 3 + w; if (sp >= 0) a += cw[w * 1024 + cc] * bf2f(P[((size_t)b * SEQL + sp) * PW + C_DX + cc]); }
            *dst = siluf_(a); }
        if (tid < 32) { const float x = dtr[(t0 + tid) * 8 + hd] + dtb; const float dt = fmaxf(x, 0.f) + log1pf(__expf(-fabsf(x))); sDt[tid] = dt; sA[tid] = __expf(dt * Aneg); }
        __syncthreads();
        for (int st = 0; st < 32; ++st) {
            const float a = sA[st], xdt = sDt[st] * sXs[st * 64 + p]; float po = 0.f;
#pragma unroll
            for (int i4 = 0; i4 < 4; ++i4) { const f32x4 bb = *(const f32x4*)(sB + st * 128 + ng * 16 + 4 * i4), cc4 = *(const f32x4*)(sC + st * 128 + ng * 16 + 4 * i4);
#pragma unroll
                for (int j = 0; j < 4; ++j) { S[4 * i4 + j] = a * S[4 * i4 + j] + bb[j] * xdt; po += cc4[j] * S[4 * i4 + j]; } }
            sP[(st * 8 + ng) * 64 + p] = po;
        }
        __syncthreads();
#pragma unroll
        for (int r = 0; r < 4; ++r) { const int st = c.wave * 4 + r, lane = c.lane;
            float y = 0.f;
#pragma unroll
            for (int q = 0; q < 8; ++q) y += sP[(st * 8 + q) * 64 + lane];
            y += Dsk * sXs[st * 64 + lane];
            bf16* zp = P + (t0 + st) * PW + C_DZ + hd * 64;
            const float yz = y * siluf_(bf2f(zp[lane]));
            const float sq = wave_sum(yz * yz);
            if (lane == 0) ssq[(t0 + st) * 8 + hd] = sq;
            zp[lane] = (bf16)f2bf(yz * ng_[lane]); }
    }
    __syncthreads();
}

__device__ __forceinline__ void xattn_naive(const Ctx& c) {
    const bf16* XQ = (const bf16*)(c.ws + WS_PROJ); bf16* AO = (bf16*)(c.ws + WS_PROJ + 16 * MiB);
    const bf16* KV = (const bf16*)(c.ws + WS_MISC + MS_KV);
    for (int item = c.wg * 512 + c.tid; item < NT * 8; item += c.nwg * 512) {
        const int w = item >> 6, h = w & 3, t = (w >> 2) * 32 + ((item & 63) >> 1), half = item & 1, b = t >> 12;
        const bf16* qp = XQ + (size_t)t * 512 + h * 128 + half * 64;
        float q[64], o[64];
#pragma unroll
        for (int i = 0; i < 8; ++i) { float f[8]; unpack8(*(const u32x4*)(qp + 8 * i), f);
#pragma unroll
            for (int j = 0; j < 8; ++j) { q[8 * i + j] = f[j] * 0.08838834764831845f; o[8 * i + j] = 0.f; } }
        float mrun = -1e30f, lrun = 0.f;
        for (int m = 0; m < 256; ++m) {
            const bf16* kr = KV + (size_t)(b * 256 + m) * 1024 + h * 128 + half * 64; const bf16* vr = kr + 512;
            float sc = 0.f;
#pragma unroll
            for (int i = 0; i < 8; ++i) { float f[8]; unpack8(*(const u32x4*)(kr + 8 * i), f);
#pragma unroll
                for (int jj = 0; jj < 8; ++jj) sc += q[8 * i + jj] * f[jj]; }
            sc += __shfl_xor(sc, 1);
            float p_; if (sc > mrun) { const float r = __expf(mrun - sc); lrun *= r;
#pragma unroll
                for (int i = 0; i < 64; ++i) o[i] *= r;
                mrun = sc; p_ = 1.f; } else p_ = __expf(sc - mrun);
            lrun += p_;
#pragma unroll
            for (int i = 0; i < 8; ++i) { float f[8]; unpack8(*(const u32x4*)(vr + 8 * i), f);
#pragma unroll
                for (int jj = 0; jj < 8; ++jj) o[8 * i + jj] += p_ * f[jj]; }
        }
        const float inv = 1.f / lrun;
        bf16* op = AO + (size_t)t * 512 + h * 128 + half * 64;
#pragma unroll
        for (int i = 0; i < 8; ++i) { u32x4 wv; wv.x = pk2(o[8 * i] * inv, o[8 * i + 1] * inv); wv.y = pk2(o[8 * i + 2] * inv, o[8 * i + 3] * inv);
            wv.z = pk2(o[8 * i + 4] * inv, o[8 * i + 5] * inv); wv.w = pk2(o[8 * i + 6] * inv, o[8 * i + 7] * inv); *(u32x4*)(op + 8 * i) = wv; }
    }
}


#define GEMM_PHASE(EPI_T, Aptr, LDA, Bptr, MM, NN, KK, ...) do { \
    pg8::Gemm g_{(const pg8::bf16_t*)(Aptr), (const pg8::bf16_t*)(Bptr), (MM), (NN), (KK), (LDA)}; pg8::StaticOrder S_; S_.init((MM), (NN), c.nwg, c.wg); \
    EPI_T E_{__VA_ARGS__}; pg8::gemm_phase<EPI_T, pg8::StaticOrder, true, true>((PG8_LAS unsigned char*)lds, g_, S_, E_); } while (0)

__global__ void __launch_bounds__(512, 2) mega_fwd(Args args) {
    extern __shared__ __attribute__((aligned(16))) unsigned char lds[];
    cg::grid_group grid = cg::this_grid();
    int ph = 0;
    const int lo = args.ph_lo, hi = args.ph_hi;
#define PHASE_BEGIN if (ph >= lo && ph < hi) { ArgP ap = (ArgP)__builtin_amdgcn_kernarg_segment_ptr(); asm volatile("" : "+s"(ap)); unsigned char* ws = ap->ws; Ctx c; c.ws = ws; \
    { int t_ = threadIdx.x, g_ = blockIdx.x, n_ = gridDim.x; asm volatile("" : "+v"(t_), "+s"(g_), "+s"(n_)); c.tid = t_; c.lane = t_ & 63; c.wave = __builtin_amdgcn_readfirstlane(t_ >> 6); c.wg = g_; c.nwg = n_; } \
    bf16* Wb = (bf16*)(ws + WS_W); bf16* XN = (bf16*)(ws + WS_XN); bf16* PJ = (bf16*)(ws + WS_PROJ); float* X = ap->out; (void)Wb; (void)XN; (void)PJ; (void)X;
#define PHASE_END   if (ph + 1 < hi) grid.sync(); } ++ph;

    for (int l = 0; l < 2; ++l) {
        asm volatile("" : "+s"(l));
        PHASE_BEGIN if ((PHMASK >> 0) & 1) {
            convert_layer(c, ap, l);
            if (l == 0) { float* rope = (float*)(ws + WS_MISC + MS_ROPE);
                for (int it = c.wg * 512 + c.tid; it < SEQL * 32; it += c.nwg * 512) { const int i = it & 31; const float ang = (float)(it >> 5) * powf(10000.f, -(float)i / 32.f); float sn, cs; sincosf(ang, &sn, &cs); rope[2 * it] = cs; rope[2 * it + 1] = sn; } }
            norm_rows(c, (l == 0) ? ap->in[0] : X, ap->in[2] + (size_t)l * DM, XN, NT, ap->in[3] + (size_t)l * DM * INW, (float*)(ws + WS_MISC + MS_DT));
        } PHASE_END
        PHASE_BEGIN if ((PHMASK >> 1) & 1) {
            GEMM_PHASE(pg8::EpiStore<0>, XN, 1024, Wb + W_IN, NT, 4608, 1024, PJ, PW);
            GEMM_PHASE(pg8::EpiStore<0>, (bf16*)(ws + WS_WVT), 1024, XN, 1536, NT, 1024, (bf16*)(ws + WS_VT), NT);
        } PHASE_END
        PHASE_BEGIN if ((PHMASK >> 2) & 1) {
            conv_prepass(c, ap, l, grid);
            grid.sync();
            if (c.wg < 16) mixer_b_mfma(c, ap, lds, l, c.wg);
            else if (c.wg < 32) mixer_d_mfma(c, ap, lds, l, c.wg - 16);
            mixer_a_mfma(c);
            mixer_c_mfma(c, ap, lds, l);
        } PHASE_END
        PHASE_BEGIN if ((PHMASK >> 3) & 1) {
            for (int i = 0; i < 4; ++i) {
                asm volatile("" : "+s"(i));
                const int acol = (i == 0) ? C_AQ : (i == 1) ? C_BG : (i == 2) ? C_CQ : C_DZ;
                GEMM_PHASE(pg8::EpiStore<1>, XN, 1024, Wb + W_G + (size_t)i * 1024 * 1024, NT, 1024, 1024, PJ + C_GS, PW);
                GEMM_PHASE(pg8::EpiGateAcc, PJ + acol, PW, Wb + W_B + (size_t)i * 1024 * 512, NT, 1024, 512, PJ + C_GS, PJ + C_MG, PW, i == 0 ? 1 : 0, i == 3 ? (const float*)(ws + WS_SSQ32) : nullptr);
            }
        } PHASE_END
        PHASE_BEGIN if ((PHMASK >> 4) & 1) {
            GEMM_PHASE(pg8::EpiResid, PJ + C_MG, PW, Wb + W_MO, NT, 1024, 1024, (l == 0) ? ap->in[0] : X, X);
        } PHASE_END
        PHASE_BEGIN if ((PHMASK >> 5) & 1) {
            norm_rows(c, X, ap->in[15] + (size_t)l * DM, XN, NT, nullptr, nullptr);
            norm_rows(c, ap->in[1], ap->in[16] + (size_t)l * DM, (bf16*)(ws + WS_MISC + MS_MN), 1024, nullptr, nullptr);
        } PHASE_END
        PHASE_BEGIN if ((PHMASK >> 6) & 1) {
            GEMM_PHASE(pg8::EpiStore<0>, XN, 1024, Wb + W_XQ, NT, 512, 1024, PJ, 512);
            GEMM_PHASE(pg8::EpiStore<0>, (bf16*)(ws + WS_MISC + MS_MN), 1024, Wb + W_XKV, 1024, 1024, 1024, (bf16*)(ws + WS_MISC + MS_KV), 1024);
        } PHASE_END
        PHASE_BEGIN if ((PHMASK >> 7) & 1) {
            xattn_naive(c);
        } PHASE_END
        PHASE_BEGIN if ((PHMASK >> 8) & 1) {
            GEMM_PHASE(pg8::EpiResid, (bf16*)(ws + WS_PROJ + 16 * MiB), 512, Wb + W_XO, NT, 1024, 512, X, X);
        } PHASE_END
        PHASE_BEGIN if ((PHMASK >> 9) & 1) {
            norm_rows(c, X, ap->in[20] + (size_t)l * DM, XN, NT, nullptr, nullptr);
        } PHASE_END
        PHASE_BEGIN if ((PHMASK >> 10) & 1) {
            GEMM_PHASE(pg8::EpiSwiglu, XN, 1024, Wb + W_FI, NT, 5632, 1024, PJ, FFH);
        } PHASE_END
        PHASE_BEGIN if ((PHMASK >> 11) & 1) {
            GEMM_PHASE(pg8::EpiResid, PJ, FFH, Wb + W_FO, NT, 1024, FFH, X, X);
        } PHASE_END
    }
    PHASE_BEGIN if ((PHMASK >> 12) & 1) {
        final_norm(c, X, ap->in[23]);
    } PHASE_END
}

extern "C" void kernel_launch(void* const* d_in, const int* in_sizes, int n_in, void* d_out, int out_size, void* d_ws, size_t ws_size, hipStream_t stream) {
    static int grid_blocks = 0;
    if (grid_blocks == 0) {
        if (n_in != 24 || out_size != NT * DM || ws_size < WS_END) { fprintf(stderr, "kernel_launch: unexpected shapes (n_in %d out %d ws %zu)\n", n_in, out_size, ws_size); grid_blocks = -1; return; }
        int dev = 0, cus = 0, per_cu = 0;
        hipGetDevice(&dev);
        hipDeviceGetAttribute(&cus, hipDeviceAttributeMultiprocessorCount, dev);
        if (hipFuncSetAttribute((const void*)mega_fwd, hipFuncAttributeMaxDynamicSharedMemorySize, LDS_BYTES) != hipSuccess) { fprintf(stderr, "kernel_launch: hipFuncSetAttribute failed\n"); grid_blocks = -1; return; }
        if (hipOccupancyMaxActiveBlocksPerMultiprocessor(&per_cu, (const void*)mega_fwd, 512, LDS_BYTES) != hipSuccess || per_cu < 1) { fprintf(stderr, "kernel_launch: occupancy query says %d\n", per_cu); per_cu = 1; }
        (void)hipGetLastError();
        grid_blocks = cus * 1;
        fprintf(stderr, "kernel_launch: grid %d (cus %d, per_cu %d)\n", grid_blocks, cus, per_cu);
    }
    if (grid_blocks < 0) return;
    Args a{};
    for (int i = 0; i < 24; ++i) a.in[i] = (const float*)d_in[i];
    a.out = (float*)d_out; a.ws = (unsigned char*)d_ws; a.ph_lo = 0; a.ph_hi = 1000;
    void* kargs[] = {&a};
    hipError_t e = hipLaunchCooperativeKernel((const void*)mega_fwd, dim3(grid_blocks), dim3(512), kargs, LDS_BYTES, stream);
    if (e != hipSuccess) fprintf(stderr, "kernel_launch: cooperative launch failed: %s (grid %d)\n", hipGetErrorString(e), grid_blocks);
}
```

```cpp
#include <hip/hip_runtime.h>
#include <hip/hip_cooperative_groups.h>
#include <cstdio>
#include <cstdint>
namespace cg = cooperative_groups;
namespace pg8 {
#define PG8_LAS __attribute__((address_space(3)))
typedef unsigned short bf16_t;
typedef short bf16x8 __attribute__((ext_vector_type(8)));
typedef float f32x4 __attribute__((ext_vector_type(4)));
typedef unsigned u32x4 __attribute__((ext_vector_type(4)));
constexpr int BM = 256, BK = 64, HALF = 128, HTB = HALF * BK * 2  , STAGE_BYTES = 8 * HTB, NXCD = 8, WGM = 8;

__host__ __device__ __forceinline__ int lds_byte(int r, int c) { const int st = (r >> 4) * 2 + (c >> 5), rr = r & 15, cc = c & 31, ob = rr * 64 + cc * 2; return st * 1024 + (ob ^ (((ob >> 9) & 1) << 5)); }
__host__ __device__ __forceinline__ void stage_rc(int b, int& R, int& C) { const int st = b / 1024, sb = b % 1024, swz = sb ^ (((sb >> 9) & 1) << 5); R = (st >> 1) * 16 + swz / 64; C = (st & 1) * 32 + (swz % 64) / 2; }
__host__ __device__ __forceinline__ int perm32(int rho) { const int n = rho >> 4, i = rho & 15; return 8 * (i >> 2) + 4 * n + (i & 3); }

struct Unit { int pm, pn; };
struct Gemm { const bf16_t* A; const bf16_t* Bt; int M, N, K, lda; };

struct StaticOrder {
    int nM, nN, nwg, G, c;
    __host__ __device__ void init(int M, int N, int G_, int c_) { nM = M / BM; nN = N / BM; nwg = nM * nN; G = G_; c = c_; }
    __host__ __device__ bool next(int i, Unit& u) const {
        const long L = (long)i * G + c; if (L >= nwg) return false;
        int wgid = (int)L; { const int q = nwg / NXCD, r = nwg % NXCD, xcd = wgid % NXCD, off = wgid / NXCD; wgid = (xcd < r ? xcd * (q + 1) : r * (q + 1) + (xcd - r) * q) + off; }
        const int nig = WGM * nN, gid = wgid / nig, fm = gid * WGM, gsz = (nM - fm) < WGM ? (nM - fm) : WGM;
        u.pm = fm + ((wgid % nig) % gsz); u.pn = (wgid % nig) / gsz; return true;
    }
    __device__ __forceinline__ void a_ready(const Unit&) const {}
    __device__ __forceinline__ void done(const Unit&) const {}
};

__device__ __forceinline__ unsigned cvt_pk_bf16(float lo, float hi) { unsigned r; asm volatile("v_cvt_pk_bf16_f32 %0, %1, %2" : "=v"(r) : "v"(lo), "v"(hi)); return r; }

template <class Epi, class Sched, bool ALIGN_EPI = false, bool SP2 = false>
__device__ __forceinline__ void gemm_phase(PG8_LAS unsigned char* lds, const Gemm g, const Sched& S, const Epi& E) {
    int tid_l = threadIdx.x; asm volatile("" : "+v"(tid_l));
    const int tid = tid_l, wid = __builtin_amdgcn_readfirstlane(tid >> 6), lane = tid & 63, wr = wid >> 2, wc = wid & 3, fr = lane & 15, fq = lane >> 4;
    const int K = g.K, nt = K / BK;
    unsigned voffA[2], voffB[2];
#pragma unroll
    for (int i = 0; i < 2; ++i) { int R, C; stage_rc(tid * 16 + i * 8192, R, C); const int Rb = Epi::PERM ? ((R & ~31) + perm32(R & 31)) : R;
        voffA[i] = (unsigned)(R * g.lda + C) * 2u; voffB[i] = (unsigned)(Rb * K + C) * 2u; }
    const size_t kstep = (size_t)(BK * 2);
    const size_t hstepA = (size_t)HALF * g.lda * 2, hstepB = (size_t)HALF * K * 2;
    const size_t tstepA = 2 * hstepA, tstepB = 2 * hstepB;
    const unsigned ldsw = (unsigned)wid * 1024u;
    const int aoff = lds_byte(wr * 64 + fr, fq * 8), boff = lds_byte(wc * 32 + fr, fq * 8);
#define PG8_SA(b, h) (((b) * 2 + (h)) * HTB)
#define PG8_SB(b, h) ((4 + (b) * 2 + (h)) * HTB)
#define PG8_STAGE(bufoff, gbase, voff) do { _Pragma("unroll") for (int _i = 0; _i < 2; ++_i) \
        __builtin_amdgcn_global_load_lds((const unsigned*)((const char*)(gbase) + (voff)[_i]), (PG8_LAS unsigned*)(lds + (bufoff) + ldsw + _i * 8192), 16, 0, 0); } while (0)
#define PG8_LDA(dst, b, h) do { _Pragma("unroll") for (int m = 0; m < 4; ++m) _Pragma("unroll") for (int k = 0; k < 2; ++k) dst[m][k] = *(const PG8_LAS bf16x8*)(lds + PG8_SA(b, h) + aoff + m * 2048 + k * 1024); } while (0)
#define PG8_LDB(dst, b, h) do { _Pragma("unroll") for (int n = 0; n < 2; ++n) _Pragma("unroll") for (int k = 0; k < 2; ++k) dst[n][k] = *(const PG8_LAS bf16x8*)(lds + PG8_SB(b, h) + boff + n * 2048 + k * 1024); } while (0)
#define PG8_MMA(ai, bj, At, Bt) do { __builtin_amdgcn_s_setprio(1); _Pragma("unroll") for (int m = 0; m < 4; ++m) _Pragma("unroll") for (int n = 0; n < 2; ++n) _Pragma("unroll") for (int k = 0; k < 2; ++k) \
        acc[ai][bj][m][n] = __builtin_amdgcn_mfma_f32_16x16x32_bf16(Bt[n][k], At[m][k], acc[ai][bj][m][n], 0, 0, 0); __builtin_amdgcn_s_setprio(0); } while (0)
#define PG8_WAIT_V(n) asm volatile("s_waitcnt vmcnt(" #n ")" ::: "memory")
#define PG8_WAIT_L(n) asm volatile("s_waitcnt lgkmcnt(" #n ")" ::: "memory")
#define PG8_BAR __builtin_amdgcn_s_barrier()
#define PG8_SCHED __builtin_amdgcn_sched_barrier(0)
    Unit cur, nxt; int ui = 0;
    if (!S.next(0, cur)) return;
    f32x4 acc[2][2][4][2];
#pragma unroll
    for (int a = 0; a < 2; ++a)
#pragma unroll
        for (int b = 0; b < 2; ++b)
#pragma unroll
            for (int m = 0; m < 4; ++m)
#pragma unroll
                for (int n = 0; n < 2; ++n) acc[a][b][m][n] = (f32x4){0.f, 0.f, 0.f, 0.f};
    bf16x8 At[4][2], B0[2][2], B1[2][2];
    const char* cA = (const char*)g.A + (size_t)cur.pm * tstepA; const char* cB = (const char*)g.Bt + (size_t)cur.pn * tstepB;
    S.a_ready(cur);
    if constexpr (SP2) {
        PG8_STAGE(PG8_SB(0, 0), cB, voffB); PG8_STAGE(PG8_SB(0, 1), cB + hstepB, voffB); PG8_STAGE(PG8_SA(0, 0), cA, voffA); PG8_STAGE(PG8_SA(0, 1), cA + hstepA, voffA);
        if (wr == 1) PG8_BAR;
        PG8_WAIT_V(2); PG8_BAR;
        PG8_STAGE(PG8_SB(1, 0), cB + kstep, voffB); PG8_STAGE(PG8_SA(1, 0), cA + kstep, voffA); PG8_STAGE(PG8_SB(1, 1), cB + hstepB + kstep, voffB);
        PG8_WAIT_V(6); PG8_BAR;
    } else {
        PG8_STAGE(PG8_SB(0, 0), cB, voffB); PG8_STAGE(PG8_SA(0, 0), cA, voffA); PG8_STAGE(PG8_SB(0, 1), cB + hstepB, voffB); PG8_STAGE(PG8_SA(0, 1), cA + hstepA, voffA);
        if (wr == 1) PG8_BAR;
        PG8_WAIT_V(4); PG8_BAR;
        PG8_STAGE(PG8_SB(1, 0), cB + kstep, voffB); PG8_STAGE(PG8_SA(1, 0), cA + kstep, voffA); PG8_STAGE(PG8_SB(1, 1), cB + hstepB + kstep, voffB);
        PG8_WAIT_V(6); PG8_BAR;
    }
    for (;;) {
        const bool has_next = S.next(ui + 1, nxt);
        const char* nA = has_next ? (const char*)g.A + (size_t)nxt.pm * tstepA : cA; const char* nB = has_next ? (const char*)g.Bt + (size_t)nxt.pn * tstepB : cB;
        for (int t = 0; t < nt; t += 2) {
            const bool last = (t == nt - 2);
            const char* a1 = cA + (size_t)(t + 1) * kstep;
            const char* a2 = last ? nA : cA + (size_t)(t + 2) * kstep; const char* b2 = last ? nB : cB + (size_t)(t + 2) * kstep;
            const char* a3 = a2 + kstep; const char* b3 = b2 + kstep;
            if (last && has_next) S.a_ready(nxt);
            if constexpr (SP2) {
            PG8_LDB(B0, 0, 0); PG8_LDB(B1, 0, 1); PG8_SCHED; PG8_LDA(At, 0, 0); PG8_STAGE(PG8_SA(1, 1), a1 + hstepA, voffA);
            PG8_WAIT_V(8); PG8_WAIT_L(0); PG8_BAR; PG8_MMA(0, 0, At, B0); PG8_MMA(0, 1, At, B1); PG8_BAR; PG8_SCHED;
            PG8_LDA(At, 0, 1); PG8_STAGE(PG8_SB(0, 0), b2, voffB); PG8_STAGE(PG8_SB(0, 1), b2 + hstepB, voffB); PG8_STAGE(PG8_SA(0, 0), a2, voffA);
            PG8_WAIT_V(8); PG8_WAIT_L(0); PG8_BAR; PG8_MMA(1, 0, At, B0); PG8_MMA(1, 1, At, B1); PG8_BAR; PG8_SCHED;
            PG8_LDB(B0, 1, 0); PG8_LDB(B1, 1, 1); PG8_SCHED; PG8_LDA(At, 1, 0); PG8_STAGE(PG8_SA(0, 1), a2 + hstepA, voffA);
            PG8_WAIT_V(8); PG8_WAIT_L(0); PG8_BAR; PG8_MMA(0, 0, At, B0); PG8_MMA(0, 1, At, B1); PG8_BAR; PG8_SCHED;
            PG8_LDA(At, 1, 1); PG8_STAGE(PG8_SB(1, 0), b3, voffB); PG8_STAGE(PG8_SB(1, 1), b3 + hstepB, voffB); PG8_STAGE(PG8_SA(1, 0), a3, voffA);
            PG8_WAIT_V(8); PG8_WAIT_L(0); PG8_BAR; PG8_MMA(1, 0, At, B0); PG8_MMA(1, 1, At, B1); PG8_BAR; PG8_SCHED;
            } else {
            PG8_LDB(B0, 0, 0); PG8_SCHED; PG8_LDA(At, 0, 0); PG8_STAGE(PG8_SA(1, 1), a1 + hstepA, voffA);
            PG8_WAIT_L(8); PG8_BAR; PG8_WAIT_L(0); PG8_MMA(0, 0, At, B0); PG8_BAR; PG8_SCHED;
            PG8_LDB(B1, 0, 1); PG8_STAGE(PG8_SB(0, 0), b2, voffB);
            PG8_BAR; PG8_WAIT_L(0); PG8_MMA(0, 1, At, B1); PG8_BAR;
            PG8_LDA(At, 0, 1); PG8_STAGE(PG8_SA(0, 0), a2, voffA);
            PG8_BAR; PG8_WAIT_L(0); PG8_MMA(1, 0, At, B0); PG8_BAR; PG8_SCHED;
            PG8_STAGE(PG8_SB(0, 1), b2 + hstepB, voffB);
            PG8_WAIT_V(6); PG8_BAR; PG8_MMA(1, 1, At, B1); PG8_BAR;
            PG8_LDB(B0, 1, 0); PG8_SCHED; PG8_LDA(At, 1, 0); PG8_STAGE(PG8_SA(0, 1), a2 + hstepA, voffA);
            PG8_WAIT_L(8); PG8_BAR; PG8_WAIT_L(0); PG8_MMA(0, 0, At, B0); PG8_BAR; PG8_SCHED;
            PG8_LDB(B1, 1, 1); PG8_STAGE(PG8_SB(1, 0), b3, voffB);
            PG8_BAR; PG8_WAIT_L(0); PG8_MMA(0, 1, At, B1); PG8_BAR;
            PG8_LDA(At, 1, 1); PG8_STAGE(PG8_SA(1, 0), a3, voffA);
            PG8_BAR; PG8_WAIT_L(0); PG8_MMA(1, 0, At, B0); PG8_BAR; PG8_SCHED;
            PG8_STAGE(PG8_SB(1, 1), b3 + hstepB, voffB);
            PG8_WAIT_V(6); PG8_BAR; PG8_MMA(1, 1, At, B1); PG8_BAR;
            }
        }
        if constexpr (ALIGN_EPI) { if (wr == 0) PG8_BAR; }
        if constexpr (!Epi::AFTER_DRAIN) { E(acc, cur, wr, wc, fr, fq); S.done(cur); }
        if (!has_next) break;
#pragma unroll
        for (int a = 0; a < 2; ++a)
#pragma unroll
            for (int b = 0; b < 2; ++b)
#pragma unroll
                for (int m = 0; m < 4; ++m)
#pragma unroll
                    for (int n = 0; n < 2; ++n) acc[a][b][m][n] = (f32x4){0.f, 0.f, 0.f, 0.f};
        cur = nxt; cA = nA; cB = nB; ++ui;
        if constexpr (ALIGN_EPI) { if (wr == 1) PG8_BAR; }
    }
    PG8_WAIT_V(0);
    if constexpr (!ALIGN_EPI) { if (wr == 0) PG8_BAR; }
    PG8_BAR;
    if constexpr (Epi::AFTER_DRAIN) { E.fused(acc, cur, wr, wc, fr, fq, lds, wid, lane); S.done(cur); }
#undef PG8_SA
#undef PG8_SB
#undef PG8_STAGE
#undef PG8_LDA
#undef PG8_LDB
#undef PG8_MMA
#undef PG8_WAIT_V
#undef PG8_WAIT_L
#undef PG8_BAR
#undef PG8_SCHED
}
}

namespace pg8 {
__device__ __forceinline__ float bfu_lo(unsigned w) { return __builtin_bit_cast(float, w << 16); }
__device__ __forceinline__ float bfu_hi(unsigned w) { return __builtin_bit_cast(float, w & 0xffff0000u); }
__device__ __forceinline__ float sigmoidf_(float x) { return 1.f / (1.f + __expf(-x)); }

template <int ACT  > struct EpiStore {
    static constexpr bool PERM = true, AFTER_DRAIN = false;
    bf16_t* O; int ldc;
    __device__ __forceinline__ void operator()(const f32x4 (&acc)[2][2][4][2], const Unit& u, int wr, int wc, int fr, int fq) const {
        const int row0 = u.pm * BM + wr * 64 + fr, col0 = u.pn * BM + wc * 32 + 8 * fq;
#pragma unroll
        for (int ai = 0; ai < 2; ++ai)
#pragma unroll
            for (int m = 0; m < 4; ++m) { bf16_t* rowp = O + (size_t)(row0 + ai * HALF + m * 16) * ldc + col0;
#pragma unroll
                for (int bj = 0; bj < 2; ++bj) { f32x4 v0 = acc[ai][bj][m][0], v1 = acc[ai][bj][m][1];
                    if (ACT == 1) {
#pragma unroll
                        for (int j = 0; j < 4; ++j) { v0[j] = sigmoidf_(v0[j]); v1[j] = sigmoidf_(v1[j]); } }
                    u32x4 w; w.x = cvt_pk_bf16(v0[0], v0[1]); w.y = cvt_pk_bf16(v0[2], v0[3]); w.z = cvt_pk_bf16(v1[0], v1[1]); w.w = cvt_pk_bf16(v1[2], v1[3]);
                    *(u32x4*)(rowp + bj * HALF) = w; } }
    }
};

struct EpiGateAcc {
    static constexpr bool PERM = true, AFTER_DRAIN = false;
    const bf16_t* GS; bf16_t* MG; int ld; int first; const float* ssq;
    __device__ __forceinline__ void operator()(const f32x4 (&acc)[2][2][4][2], const Unit& u, int wr, int wc, int fr, int fq) const {
        const int row0 = u.pm * BM + wr * 64 + fr, col0 = u.pn * BM + wc * 32 + 8 * fq;
#pragma unroll
        for (int ai = 0; ai < 2; ++ai)
#pragma unroll
            for (int m = 0; m < 4; ++m) { const int row = row0 + ai * HALF + m * 16; const size_t ro = (size_t)row * ld + col0;
                float rs = 1.f;
                if (ssq) { float s = 0.f;
#pragma unroll
                    for (int q = 0; q < 8; ++q) { const f32x4 v = *(const f32x4*)(ssq + (size_t)row * 32 + 4 * q); s += (v[0] + v[1]) + (v[2] + v[3]); }
                    rs = rsqrtf(s * (1.f / 512.f) + 1e-6f); }
#pragma unroll
                for (int bj = 0; bj < 2; ++bj) { const f32x4 a0 = acc[ai][bj][m][0], a1 = acc[ai][bj][m][1];
                    const u32x4 g = *(const u32x4*)(GS + ro + bj * HALF);
                    u32x4 o = (u32x4){0u, 0u, 0u, 0u}; if (!first) o = *(const u32x4*)(MG + ro + bj * HALF);
                    float r[8];
                    r[0] = bfu_lo(o.x) + bfu_lo(g.x) * a0[0] * rs; r[1] = bfu_hi(o.x) + bfu_hi(g.x) * a0[1] * rs;
                    r[2] = bfu_lo(o.y) + bfu_lo(g.y) * a0[2] * rs; r[3] = bfu_hi(o.y) + bfu_hi(g.y) * a0[3] * rs;
                    r[4] = bfu_lo(o.z) + bfu_lo(g.z) * a1[0] * rs; r[5] = bfu_hi(o.z) + bfu_hi(g.z) * a1[1] * rs;
                    r[6] = bfu_lo(o.w) + bfu_lo(g.w) * a1[2] * rs; r[7] = bfu_hi(o.w) + bfu_hi(g.w) * a1[3] * rs;
                    u32x4 w; w.x = cvt_pk_bf16(r[0], r[1]); w.y = cvt_pk_bf16(r[2], r[3]); w.z = cvt_pk_bf16(r[4], r[5]); w.w = cvt_pk_bf16(r[6], r[7]);
                    *(u32x4*)(MG + ro + bj * HALF) = w; } }
    }
};

struct EpiResid {
    static constexpr bool PERM = true, AFTER_DRAIN = false;
    const float* XI; float* XO;
    __device__ __forceinline__ void operator()(const f32x4 (&acc)[2][2][4][2], const Unit& u, int wr, int wc, int fr, int fq) const {
        const int row0 = u.pm * BM + wr * 64 + fr, col0 = u.pn * BM + wc * 32 + 8 * fq;
#pragma unroll
        for (int ai = 0; ai < 2; ++ai)
#pragma unroll
            for (int m = 0; m < 4; ++m) { const size_t ro = (size_t)(row0 + ai * HALF + m * 16) * 1024 + col0;
#pragma unroll
                for (int bj = 0; bj < 2; ++bj) {
#pragma unroll
                    for (int n = 0; n < 2; ++n) { const f32x4 x0 = *(const f32x4*)(XI + ro + bj * HALF + 4 * n); *(f32x4*)(XO + ro + bj * HALF + 4 * n) = x0 + acc[ai][bj][m][n]; } } }
    }
};

struct EpiSwiglu {
    static constexpr bool PERM = true, AFTER_DRAIN = false;
    bf16_t* H; int ldc;
    __device__ __forceinline__ void operator()(const f32x4 (&acc)[2][2][4][2], const Unit& u, int wr, int wc, int fr, int fq) const {
        const int row0 = u.pm * BM + wr * 64 + fr, col0 = u.pn * 128 + wc * 16 + 4 * fq;
#pragma unroll
        for (int ai = 0; ai < 2; ++ai)
#pragma unroll
            for (int m = 0; m < 4; ++m) { bf16_t* rowp = H + (size_t)(row0 + ai * HALF + m * 16) * ldc + col0;
#pragma unroll
                for (int bj = 0; bj < 2; ++bj) { const f32x4 a = acc[ai][bj][m][0], b = acc[ai][bj][m][1]; float r[4];
#pragma unroll
                    for (int j = 0; j < 4; ++j) r[j] = a[j] * sigmoidf_(a[j]) * b[j];
                    unsigned long long w = (unsigned long long)cvt_pk_bf16(r[0], r[1]) | ((unsigned long long)cvt_pk_bf16(r[2], r[3]) << 32);
                    *(unsigned long long*)(rowp + bj * 64) = w; } }
    }
};
}

typedef unsigned short bf16;
typedef float f32x4 __attribute__((ext_vector_type(4)));
typedef unsigned u32x4 __attribute__((ext_vector_type(4)));
typedef unsigned u32x2 __attribute__((ext_vector_type(2)));
#define LAS __attribute__((address_space(3)))
constexpr int NT = 16384, SEQL = 4096, DM = 1024, PW = 4608, INW = 10248, FFH = 2816;
constexpr float EPSN = 1e-6f;
constexpr size_t MiB = 1u << 20;
constexpr size_t WS_W = 0, WS_XN = 48 * MiB, WS_PROJ = 80 * MiB, WS_MISC = 224 * MiB, WS_VT = 232 * MiB, WS_WVT = 280 * MiB, WS_XCT = 284 * MiB, WS_SSQ32 = 308 * MiB, WS_END = 310 * MiB;
constexpr size_t W_IN = 0, W_G = W_IN + (size_t)4608 * 1024, W_B = W_G + (size_t)4096 * 1024, W_MO = W_B + (size_t)4 * 1024 * 512, W_XQ = W_MO + (size_t)1024 * 1024,
                 W_XKV = W_XQ + (size_t)512 * 1024, W_XO = W_XKV + (size_t)1024 * 1024, W_FI = W_XO + (size_t)1024 * 512, W_FO = W_FI + (size_t)5632 * 1024, W_TOT = W_FO + (size_t)1024 * 2816;
static_assert(W_TOT * 2 <= 48 * MiB, "weights fit");
constexpr size_t MS_DT = 0, MS_SSQ = 512 * 1024, MS_MN = 1 * MiB, MS_KV = 3 * MiB, MS_BAR = 4 * MiB, MS_VTX = 5 * MiB, MS_ROPE = 6 * MiB, MS_CNT = 7 * MiB;
constexpr int C_AQ = 0, C_AK = 512, C_BQ = 1024, C_BK = 1280, C_BG = 1536, C_CQ = 2048, C_CK = 2560, C_DZ = 3072, C_DX = 3584;
constexpr int VT_A = 0, VT_C = 512, VT_B = 1024;
constexpr int C_GS = 512, C_MG = 3584;
constexpr int LDS_BYTES = 147456;

__device__ __forceinline__ float bf2f(bf16 v) { return __builtin_bit_cast(float, (unsigned)v << 16); }
__device__ __forceinline__ float bflo(unsigned w) { return __builtin_bit_cast(float, w << 16); }
__device__ __forceinline__ float bfhi(unsigned w) { return __builtin_bit_cast(float, w & 0xffff0000u); }
__device__ __forceinline__ unsigned f2bf(float f) { unsigned u = __builtin_bit_cast(unsigned, f); return (u + 0x7fffu + ((u >> 16) & 1u)) >> 16; }
__device__ __forceinline__ unsigned pk2(float lo, float hi) { return f2bf(lo) | (f2bf(hi) << 16); }
__device__ __forceinline__ float wave_sum(float v) {
#pragma unroll
    for (int o = 1; o < 64; o <<= 1) v += __shfl_xor(v, o);
    return v;
}
__device__ __forceinline__ float siluf_(float x) { return x / (1.f + __expf(-x)); }
__device__ __forceinline__ void unpack8(const u32x4 w, float* f) { f[0] = bflo(w.x); f[1] = bfhi(w.x); f[2] = bflo(w.y); f[3] = bfhi(w.y); f[4] = bflo(w.z); f[5] = bfhi(w.z); f[6] = bflo(w.w); f[7] = bfhi(w.w); }

#ifndef PHMASK
#define PHMASK 0xFFFF
#endif
#ifndef DRYMASK
#define DRYMASK 0
#endif
#ifndef XSYNC
#define XSYNC 0
#endif
#ifndef REPMASK
#define REPMASK 0
#endif
struct Args { const float* in[24]; float* out; unsigned char* ws; int ph_lo, ph_hi; };
typedef const __attribute__((address_space(4))) Args* ArgP;
struct Ctx {
    unsigned char* ws;
    int tid, lane, wave, wg, nwg;
};

__device__ __forceinline__ void conv_w(const Ctx& c, const float* W, int srcN, int K, int Ndst, bf16* WT, int mode, int off, int rot) {
    const int nb = Ndst / 64, kb = K / 64, tot = nb * kb;
    int start = c.wg - (rot % c.nwg); if (start < 0) start += c.nwg;
    for (int it = start; it < tot; it += c.nwg) {
        const int n = (it % nb) * 64 + (c.tid & 63), k0 = (it / nb) * 64 + (c.tid >> 6) * 8;
        const int sc = mode == 0 ? off + n : (((n & 7) < 4) ? (n >> 3) * 4 + (n & 3) : FFH + (n >> 3) * 4 + (n & 3));
        const float* src = W + (size_t)k0 * srcN + sc;
        float v[8];
#pragma unroll
        for (int j = 0; j < 8; ++j) v[j] = src[(size_t)j * srcN];
        u32x4 o; o.x = pk2(v[0], v[1]); o.y = pk2(v[2], v[3]); o.z = pk2(v[4], v[5]); o.w = pk2(v[6], v[7]);
        *(u32x4*)(WT + (size_t)n * K + k0) = o;
    }
}
__device__ __forceinline__ void convert_layer(const Ctx& c, ArgP A, int l) {
    bf16* Wb = (bf16*)(c.ws + WS_W);
    const float* w_in = A->in[3] + (size_t)l * DM * INW;
    conv_w(c, w_in, INW, 1024, 1024, Wb + W_IN, 0, 0, 0);
    conv_w(c, w_in, INW, 1024, 512, Wb + W_IN + (size_t)1024 * 1024, 0, 1536, 16);
    conv_w(c, w_in, INW, 1024, 512, Wb + W_IN + (size_t)1536 * 1024, 0, 2560, 80);
    conv_w(c, w_in, INW, 1024, 1024, Wb + W_IN + (size_t)2048 * 1024, 0, 3072, 144);
    conv_w(c, w_in, INW, 1024, 1536, Wb + W_IN + (size_t)3072 * 1024, 0, 4608, 0);
    conv_w(c, w_in, INW, 1024, 4096, Wb + W_G, 0, 6152, 0);
    conv_w(c, w_in, INW, 1024, 512, (bf16*)(c.ws + WS_WVT), 0, 1024, 64);
    conv_w(c, w_in, INW, 1024, 512, (bf16*)(c.ws + WS_WVT) + (size_t)512 * 1024, 0, 4096, 192);
    conv_w(c, w_in, INW, 1024, 512, (bf16*)(c.ws + WS_WVT) + (size_t)1024 * 1024, 0, 2048, 128);
    for (int i = 0; i < 4; ++i) conv_w(c, A->in[13] + ((size_t)l * 4 + i) * 512 * 1024, 1024, 512, 1024, Wb + W_B + (size_t)i * 1024 * 512, 0, 0, 32 * i);
    conv_w(c, A->in[14] + (size_t)l * 1024 * 1024, 1024, 1024, 1024, Wb + W_MO, 0, 0, 128);
    conv_w(c, A->in[17] + (size_t)l * 1024 * 512, 512, 1024, 512, Wb + W_XQ, 0, 0, 0);
    conv_w(c, A->in[18] + (size_t)l * 1024 * 1024, 1024, 1024, 1024, Wb + W_XKV, 0, 0, 128);
    conv_w(c, A->in[19] + (size_t)l * 512 * 1024, 1024, 512, 1024, Wb + W_XO, 0, 0, 0);
    conv_w(c, A->in[21] + (size_t)l * 1024 * 5632, 5632, 1024, 5632, Wb + W_FI, 1, 0, 128);
    conv_w(c, A->in[22] + (size_t)l * FFH * 1024, 1024, FFH, 1024, Wb + W_FO, 0, 0, 0);
}

__device__ __forceinline__ void norm_rows(const Ctx& c, const float* X, const float* g, bf16* out, int nrows, const float* Wdt, float* dt_out) {
    const int gw = c.wg * 8 + c.wave, ngw = c.nwg * 8, lane = c.lane;
    f32x4 gv[4];
#pragma unroll
    for (int j = 0; j < 4; ++j) gv[j] = *((const f32x4*)g + lane + 64 * j);
    for (int row = gw; row < nrows; row += ngw) {
        const f32x4* xr = (const f32x4*)(X + (size_t)row * DM) + lane;
        f32x4 v[4]; float s = 0.f;
#pragma unroll
        for (int j = 0; j < 4; ++j) { v[j] = xr[64 * j]; s += (v[j].x * v[j].x + v[j].y * v[j].y) + (v[j].z * v[j].z + v[j].w * v[j].w); }
        const float rs = rsqrtf(wave_sum(s) * (1.f / DM) + EPSN);
        unsigned long long* o8 = (unsigned long long*)(out + (size_t)row * DM) + lane;
#pragma unroll
        for (int j = 0; j < 4; ++j) { v[j] = v[j] * rs * gv[j]; o8[64 * j] = (unsigned long long)pk2(v[j].x, v[j].y) | ((unsigned long long)pk2(v[j].z, v[j].w) << 32); }
        if (Wdt) {
            f32x4 a0 = (f32x4){0.f, 0.f, 0.f, 0.f}, a1 = a0;
#pragma unroll
            for (int j = 0; j < 4; ++j)
#pragma unroll
                for (int e = 0; e < 4; ++e) { const int k = 4 * lane + 256 * j + e; const float* wp = Wdt + (size_t)k * INW + 6144;
                    const f32x4 w0 = *(const f32x4*)wp, w1 = *(const f32x4*)(wp + 4); a0 += w0 * v[j][e]; a1 += w1 * v[j][e]; }
#pragma unroll
            for (int e = 0; e < 4; ++e) { a0[e] = wave_sum(a0[e]); a1[e] = wave_sum(a1[e]); }
            if (lane == 0) { *(f32x4*)(dt_out + (size_t)row * 8) = a0; *(f32x4*)(dt_out + (size_t)row * 8 + 4) = a1; }
        }
    }
}
__device__ __forceinline__ void final_norm(const Ctx& c, float* X, const float* g) {
    const int gw = c.wg * 8 + c.wave, ngw = c.nwg * 8, lane = c.lane;
    for (int row = gw; row < NT; row += ngw) {
        f32x4* xr = (f32x4*)(X + (size_t)row * DM) + lane;
        f32x4 v[4]; float s = 0.f;
#pragma unroll
        for (int j = 0; j < 4; ++j) { v[j] = xr[64 * j]; s += (v[j].x * v[j].x + v[j].y * v[j].y) + (v[j].z * v[j].z + v[j].w * v[j].w); }
        const float rs = rsqrtf(wave_sum(s) * (1.f / DM) + EPSN);
#pragma unroll
        for (int j = 0; j < 4; ++j) xr[64 * j] = v[j] * rs * *((const f32x4*)g + lane + 64 * j);
    }
}

#define OSM_UPDATE(sc, NV, vexpr) do { float _p; if ((sc) > mrun) { const float _r = __expf(mrun - (sc)); lrun *= _r; _Pragma("unroll") for (int _i = 0; _i < NV; ++_i) o[_i] *= _r; mrun = (sc); _p = 1.f; } \
    else _p = __expf((sc) - mrun); lrun += _p; _Pragma("unroll") for (int _i = 0; _i < NV; ++_i) o[_i] += _p * (vexpr); } while (0)

typedef short bf16x8_t __attribute__((ext_vector_type(8)));
typedef short s16x4_t __attribute__((ext_vector_type(4)));
typedef float f32x2_t __attribute__((ext_vector_type(2)));
typedef __bf16 bf16x2_t __attribute__((ext_vector_type(2)));
#define MFMA16(a, b, c) __builtin_amdgcn_mfma_f32_16x16x32_bf16((a), (b), (c), 0, 0, 0)
__device__ __forceinline__ unsigned cvtpk(float lo, float hi) { f32x2_t v = {lo, hi}; bf16x2_t b = __builtin_convertvector(v, bf16x2_t); return __builtin_bit_cast(unsigned, b); }
__device__ __forceinline__ bf16x8_t pack8(const float* p) { u32x4 w; w.x = cvtpk(p[0], p[1]); w.y = cvtpk(p[2], p[3]); w.z = cvtpk(p[4], p[5]); w.w = cvtpk(p[6], p[7]); return __builtin_bit_cast(bf16x8_t, w); }
__device__ __forceinline__ float ex2(float x) { return __builtin_amdgcn_exp2f(x); }

__device__ __forceinline__ void mixer_c_mfma(const Ctx& c, ArgP A, unsigned char* lds_raw, int l, int dry, unsigned* cnt) {
    bf16* P = (bf16*)(c.ws + WS_PROJ); const bf16* VT = (const bf16*)(c.ws + WS_VT) + (size_t)VT_C * NT;
    unsigned char* sK = lds_raw;
    unsigned char* sV = lds_raw + 64 * 272;
    const float* lp = A->in[5] + (size_t)l * 256;
    float d0 = 0.f, d1 = 0.f;
    for (int i = 0; i < 64; ++i) { d0 += lp[i] * lp[64 + i]; d1 += lp[128 + i] * lp[192 + i]; }
    const float lam_init = 0.8f - 0.6f * expf(-0.3f * (float)l);
    const float lam = expf(d0) - expf(d1) + lam_init;
    const float* sg = A->in[6] + (size_t)l * 128;
    const int tid = c.tid, lane = c.lane, wave = c.wave, fr = lane & 15, fq = lane >> 4;
    constexpr float C2 = 0.125f * 1.4426950408889634f;
    volatile int* sIdx = (volatile int*)(lds_raw + 36864);
    for (;;) {
        __syncthreads();
        if (tid == 0) *sIdx = (int)atomicAdd(cnt, 1u);
        __syncthreads();
        const int u0 = *sIdx; if (u0 >= 512) break;
        const int bh = u0 & 15, qblk = 31 - (u0 >> 4);
        const int b = bh >> 2, h = bh & 3;
        const int qs = qblk * 128 + wave * 16 + fr;
        bf16* qp = P + ((size_t)b * SEQL + qs) * PW + C_CQ + h * 128;
        bf16x8_t qf[2][2];
#pragma unroll
        for (int c2 = 0; c2 < 2; ++c2)
#pragma unroll
            for (int ks = 0; ks < 2; ++ks) qf[c2][ks] = *(const bf16x8_t*)(qp + c2 * 64 + ks * 32 + fq * 8);
        f32x4 oacc[2][8];
#pragma unroll
        for (int c2 = 0; c2 < 2; ++c2)
#pragma unroll
            for (int eb = 0; eb < 8; ++eb) oacc[c2][eb] = (f32x4){0.f, 0.f, 0.f, 0.f};
        float mrun[2] = {-1e30f, -1e30f}, lrun[2] = {0.f, 0.f};
        const int qmax_w = qblk * 128 + wave * 16 + 15;
        const int ntile = 2 * (qblk + 1);
        for (int kt = 0; kt < ntile; ++kt) {
            __syncthreads();
            {
                const size_t rowb = (size_t)b * SEQL + kt * 64;
#pragma unroll
                for (int i = 0; i < 2; ++i) { const int ch = tid + 512 * i;
                    { const int rr = ch >> 4, cc = ch & 15; *(u32x4*)(sK + rr * 272 + cc * 16) = *(const u32x4*)(P + (rowb + rr) * PW + C_CK + h * 128 + cc * 8); }
                    { const int e = ch >> 3, cc = ch & 7; *(u32x4*)(sV + e * 144 + cc * 16) = *(const u32x4*)(VT + (size_t)(h * 128 + e) * NT + rowb + cc * 8); } }
            }
            __syncthreads();
#pragma unroll
            for (int kb2 = 0; kb2 < 2; ++kb2) {
                const int k0 = kt * 64 + kb2 * 32;
                if (k0 > qmax_w) continue;
                bf16x8_t vf[8];
#pragma unroll
                for (int eb = 0; eb < 8; ++eb) { const unsigned char* vp = sV + (eb * 16 + fr) * 144 + (kb2 * 32 + 4 * fq) * 2;
                    const s16x4_t lo = *(const s16x4_t*)vp, hi = *(const s16x4_t*)(vp + 32); vf[eb] = __builtin_shufflevector(lo, hi, 0, 1, 2, 3, 4, 5, 6, 7); }
#pragma unroll
                for (int c2 = 0; c2 < 2; ++c2) {
                    f32x4 s0 = (f32x4){0.f, 0.f, 0.f, 0.f}, s1 = s0;
#pragma unroll
                    for (int ks = 0; ks < 2; ++ks) { const unsigned char* kp = sK + (kb2 * 32 + fr) * 272 + (c2 * 64 + ks * 32 + fq * 8) * 2;
                        const bf16x8_t ka = *(const bf16x8_t*)kp, kb = *(const bf16x8_t*)(kp + 16 * 272);
                        s0 = MFMA16(ka, qf[c2][ks], s0); s1 = MFMA16(kb, qf[c2][ks], s1); }
                    float sc[8]; bool vis[8];
#pragma unroll
                    for (int j = 0; j < 4; ++j) { const int kp0 = k0 + 4 * fq + j; vis[j] = kp0 <= qs; vis[4 + j] = (kp0 + 16) <= qs;
                        sc[j] = vis[j] ? s0[j] * C2 : -1e30f; sc[4 + j] = vis[4 + j] ? s1[j] * C2 : -1e30f; }
                    float mx = fmaxf(fmaxf(fmaxf(sc[0], sc[1]), fmaxf(sc[2], sc[3])), fmaxf(fmaxf(sc[4], sc[5]), fmaxf(sc[6], sc[7])));
                    mx = fmaxf(mx, __shfl_xor(mx, 16)); mx = fmaxf(mx, __shfl_xor(mx, 32));
                    const float mnew = fmaxf(mrun[c2], mx); const float alpha = ex2(mrun[c2] - mnew); mrun[c2] = mnew;
                    float p[8], ps = 0.f;
#pragma unroll
                    for (int i = 0; i < 8; ++i) { p[i] = vis[i] ? ex2(sc[i] - mnew) : 0.f; ps += p[i]; }
                    lrun[c2] = lrun[c2] * alpha + ps;
                    const bf16x8_t pf = pack8(p);
#pragma unroll
                    for (int eb = 0; eb < 8; ++eb) { oacc[c2][eb] = oacc[c2][eb] * alpha; oacc[c2][eb] = MFMA16(vf[eb], pf, oacc[c2][eb]); }
                }
            }
        }
        float linv[2];
#pragma unroll
        for (int c2 = 0; c2 < 2; ++c2) { float lt = lrun[c2]; lt += __shfl_xor(lt, 16); lt += __shfl_xor(lt, 32); linv[c2] = 1.f / lt; }
        float ss = 0.f;
#pragma unroll
        for (int eb = 0; eb < 8; ++eb) { oacc[0][eb] = oacc[0][eb] * linv[0] - oacc[1][eb] * (lam * linv[1]);
            ss += (oacc[0][eb][0] * oacc[0][eb][0] + oacc[0][eb][1] * oacc[0][eb][1]) + (oacc[0][eb][2] * oacc[0][eb][2] + oacc[0][eb][3] * oacc[0][eb][3]); }
        ss += __shfl_xor(ss, 16); ss += __shfl_xor(ss, 32);
        const float rs = rsqrtf(ss * (1.f / 128.f) + EPSN) * (1.f - lam_init);
#pragma unroll
        for (int eb = 0; eb < 8; ++eb) { const int e0 = eb * 16 + 4 * fq; const f32x4 g4 = *(const f32x4*)(sg + e0);
            const unsigned lo = cvtpk(oacc[0][eb][0] * rs * g4[0], oacc[0][eb][1] * rs * g4[1]), hi = cvtpk(oacc[0][eb][2] * rs * g4[2], oacc[0][eb][3] * rs * g4[3]);
            if (!dry) *(unsigned long long*)(qp + e0) = (unsigned long long)lo | ((unsigned long long)hi << 32); }
    }
    __syncthreads();
}

__device__ __forceinline__ void mixer_a_mfma(const Ctx& c, int dry, unsigned* cnt) {
    bf16* P = (bf16*)(c.ws + WS_PROJ); const bf16* VTa = (const bf16*)(c.ws + WS_VT) + (size_t)VT_A * NT;
    const int lane = c.lane, fr = lane & 15, fq = lane >> 4;
    constexpr float C2 = 0.125f * 1.4426950408889634f;
    const int gw = c.wg * 8 + c.wave, ngw = c.nwg * 8;
    (void)gw; (void)ngw;
    for (;;) {
        int g = 0; if (lane == 0) g = (int)atomicAdd(cnt, 1u); g = __shfl(g, 0); if (g >= 8192) break;
        const int r16 = g & 15, h = (g >> 4) & 7, blk = (g >> 7) & 15, b = g >> 11;
        const int sbase = blk * 256 + r16, qs = sbase + 16 * fr;
        const size_t tb = (size_t)b * SEQL;
        bf16* qp = P + (tb + qs) * PW + C_AQ + h * 64;
        bf16x8_t qf[2];
#pragma unroll
        for (int ks = 0; ks < 2; ++ks) qf[ks] = *(const bf16x8_t*)(qp + ks * 32 + fq * 8);
        f32x4 oacc[4];
#pragma unroll
        for (int eb = 0; eb < 4; ++eb) oacc[eb] = (f32x4){0.f, 0.f, 0.f, 0.f};
        float mrun = -1e30f, lrun = 0.f;
        for (int p = 0; p < 3; ++p) {
            const int sh = 2 * p, d = 1 << sh, qm = (16 * fr) >> sh, mhi = 240 >> sh;
            for (int m0 = -128; m0 <= mhi; m0 += 32) {
                if (sbase + d * (m0 + 31) < 0) continue;
                int tk0 = sbase + d * (m0 + fr), tk1 = tk0 + 16 * d;
                tk0 = min(max(tk0, 0), SEQL - 1); tk1 = min(max(tk1, 0), SEQL - 1);
                const bf16* k0p = P + (tb + tk0) * PW + C_AK + h * 64 + fq * 8; const bf16* k1p = P + (tb + tk1) * PW + C_AK + h * 64 + fq * 8;
                f32x4 s0 = (f32x4){0.f, 0.f, 0.f, 0.f}, s1 = s0;
#pragma unroll
                for (int ks = 0; ks < 2; ++ks) { const bf16x8_t ka = *(const bf16x8_t*)(k0p + ks * 32), kb = *(const bf16x8_t*)(k1p + ks * 32);
                    s0 = MFMA16(ka, qf[ks], s0); s1 = MFMA16(kb, qf[ks], s1); }
                float sc[8]; bool vis[8]; int tokv[8];
#pragma unroll
                for (int j = 0; j < 4; ++j) { const int m = m0 + 4 * fq + j; const int dj0 = qm - m, dj1 = dj0 - 16; const int t0 = sbase + d * m, t1 = t0 + 16 * d;
                    vis[j] = (dj0 >= 0) && (dj0 <= 128) && (t0 >= 0); vis[4 + j] = (dj1 >= 0) && (dj1 <= 128) && (t1 >= 0);
                    tokv[j] = min(max(t0, 0), SEQL - 1); tokv[4 + j] = min(max(t1, 0), SEQL - 1);
                    sc[j] = vis[j] ? s0[j] * C2 : -1e30f; sc[4 + j] = vis[4 + j] ? s1[j] * C2 : -1e30f; }
                float mx = fmaxf(fmaxf(fmaxf(sc[0], sc[1]), fmaxf(sc[2], sc[3])), fmaxf(fmaxf(sc[4], sc[5]), fmaxf(sc[6], sc[7])));
                mx = fmaxf(mx, __shfl_xor(mx, 16)); mx = fmaxf(mx, __shfl_xor(mx, 32));
                const float mnew = fmaxf(mrun, mx); const float alpha = ex2(mrun - mnew); mrun = mnew;
                float pr[8], ps = 0.f;
#pragma unroll
                for (int i = 0; i < 8; ++i) { pr[i] = vis[i] ? ex2(sc[i] - mnew) : 0.f; ps += pr[i]; }
                lrun = lrun * alpha + ps;
                const bf16x8_t pf = pack8(pr);
                const bf16* vb = VTa + (size_t)(h * 64 + fr) * NT + tb;
#pragma unroll
                for (int eb = 0; eb < 4; ++eb) { bf16x8_t vf;
#pragma unroll
                    for (int j = 0; j < 8; ++j) vf[j] = (short)vb[(size_t)eb * 16 * NT + tokv[j]];
                    oacc[eb] = oacc[eb] * alpha; oacc[eb] = MFMA16(vf, pf, oacc[eb]); }
            }
        }
        float lt = lrun; lt += __shfl_xor(lt, 16); lt += __shfl_xor(lt, 32); const float linv = 1.f / lt;
#pragma unroll
        for (int eb = 0; eb < 4; ++eb) { const unsigned lo = cvtpk(oacc[eb][0] * linv, oacc[eb][1] * linv), hi = cvtpk(oacc[eb][2] * linv, oacc[eb][3] * linv);
            if (!dry) *(unsigned long long*)(qp + eb * 16 + 4 * fq) = (unsigned long long)lo | ((unsigned long long)hi << 32); }
    }
}

#define WG_BARRIER() asm volatile("s_waitcnt lgkmcnt(0)\n\ts_barrier" ::: "memory")
struct BLoad { u32x4 x0, x1; f32x4 rp[4]; bf16x8_t vf[2]; s16x4_t vl[2], vh[2]; u32x2 gt[4]; };
__device__ __forceinline__ void b_issue(BLoad& L, const bf16* P, const float* rope, const bf16* vrow, int b, int h, int ch, int tid, int w, int fr, int fq) {
    const int s0 = ch * 64; const size_t t0 = (size_t)b * SEQL + s0;
    const int which = tid >> 8, tk = (tid >> 2) & 63, c4 = tid & 3;
    const bf16* src = P + (t0 + tk) * PW + (which ? C_BK : C_BQ) + h * 64 + 8 * c4;
    L.x0 = *(const u32x4*)src; L.x1 = *(const u32x4*)(src + 32);
    const float* rp = rope + ((size_t)(s0 + tk) * 32 + 8 * c4) * 2;
#pragma unroll
    for (int q = 0; q < 4; ++q) L.rp[q] = *(const f32x4*)(rp + 4 * q);
#pragma unroll
    for (int ks = 0; ks < 2; ++ks) { L.vf[ks] = *(const bf16x8_t*)(vrow + s0 + ks * 32 + fq * 8); L.vl[ks] = *(const s16x4_t*)(vrow + s0 + ks * 32 + 4 * fq); L.vh[ks] = *(const s16x4_t*)(vrow + s0 + ks * 32 + 16 + 4 * fq); }
#pragma unroll
    for (int qb = 0; qb < 4; ++qb) L.gt[qb] = *(const u32x2*)(P + (t0 + qb * 16 + fr) * PW + C_BG + h * 128 + 16 * w + 4 * fq);
}
__device__ __forceinline__ void mixer_b_mfma(const Ctx& c, ArgP A, unsigned char* lds_raw, int l, int unit, int dry) {
    bf16* P = (bf16*)(c.ws + WS_PROJ); const bf16* VTb = (const bf16*)(c.ws + WS_VT) + (size_t)VT_B * NT;
    const float* rope = (const float*)(c.ws + WS_MISC + MS_ROPE);
    unsigned char* sQ = lds_raw;
    unsigned char* sK = lds_raw + 9216;
    unsigned char* sKT = lds_raw + 18432;
    unsigned char* sP = lds_raw + 27648;
    float* sSt = (float*)(lds_raw + 35840);
    const int b = unit >> 2, h = unit & 3, tid = c.tid, lane = c.lane, w = c.wave, fr = lane & 15, fq = lane >> 4;
    const float lg = log2f(1.f - exp2f(-5.f - (float)h));
    const float* gn = A->in[4] + (size_t)l * 512 + h * 128;
    f32x4 R[4];
#pragma unroll
    for (int i = 0; i < 4; ++i) R[i] = (f32x4){0.f, 0.f, 0.f, 0.f};
    const bf16* vrow = VTb + (size_t)(h * 128 + 16 * w + fr) * NT + (size_t)b * SEQL;
    const int which = tid >> 8, tk_s = (tid >> 2) & 63, c4 = tid & 3;
    BLoad nx; b_issue(nx, P, rope, vrow, b, h, 0, tid, w, fr, fq);
    for (int ch = 0; ch < 64; ++ch) {
        const int s0 = ch * 64; const size_t t0 = (size_t)b * SEQL + s0;
        const BLoad cu = nx;
        {
            float xa[8], xb[8], r1[8], r2[8]; unpack8(cu.x0, xa); unpack8(cu.x1, xb);
#pragma unroll
            for (int e = 0; e < 8; ++e) { const float cs = cu.rp[e >> 1][(e & 1) * 2], sn = cu.rp[e >> 1][(e & 1) * 2 + 1]; r1[e] = xa[e] * cs - xb[e] * sn; r2[e] = xa[e] * sn + xb[e] * cs; }
            if (which == 0) { *(bf16x8_t*)(sQ + tk_s * 144 + c4 * 16) = pack8(r1); *(bf16x8_t*)(sQ + tk_s * 144 + 64 + c4 * 16) = pack8(r2); }
            else {
#pragma unroll
                for (int e = 0; e < 8; ++e) { r1[e] *= 0.125f; r2[e] *= 0.125f; }
                *(bf16x8_t*)(sK + tk_s * 144 + c4 * 16) = pack8(r1); *(bf16x8_t*)(sK + tk_s * 144 + 64 + c4 * 16) = pack8(r2);
                const float dk = ex2((float)(63 - tk_s) * lg);
#pragma unroll
                for (int e = 0; e < 8; ++e) { *(bf16*)(sKT + (8 * c4 + e) * 144 + tk_s * 2) = (bf16)f2bf(r1[e] * dk); *(bf16*)(sKT + (32 + 8 * c4 + e) * 144 + tk_s * 2) = (bf16)f2bf(r2[e] * dk); } }
        }
        if (ch + 1 < 64) b_issue(nx, P, rope, vrow, b, h, ch + 1, tid, w, fr, fq);
        WG_BARRIER();
        if (w < 6) {
            const int qb = (w == 0) ? 0 : (w == 1) ? 1 : (w < 4) ? 2 : 3, kp = (w == 3 || w == 5) ? 1 : 0;
            f32x4 sa = (f32x4){0.f, 0.f, 0.f, 0.f}, sb = sa;
            const bool two = (2 * kp + 1) <= qb;
#pragma unroll
            for (int ks = 0; ks < 2; ++ks) { const bf16x8_t qf = *(const bf16x8_t*)(sQ + (qb * 16 + fr) * 144 + (ks * 32 + fq * 8) * 2);
                const bf16x8_t ka = *(const bf16x8_t*)(sK + (kp * 32 + fr) * 144 + (ks * 32 + fq * 8) * 2);
                sa = MFMA16(ka, qf, sa);
                if (two) { const bf16x8_t kb = *(const bf16x8_t*)(sK + (kp * 32 + 16 + fr) * 144 + (ks * 32 + fq * 8) * 2); sb = MFMA16(kb, qf, sb); } }
            float p[8]; const int qi = qb * 16 + fr;
#pragma unroll
            for (int j = 0; j < 4; ++j) { const int k0 = kp * 32 + 4 * fq + j, k1 = k0 + 16;
                p[j] = (k0 <= qi) ? sa[j] * ex2((float)(qi - k0) * lg) : 0.f; p[4 + j] = (k1 <= qi) ? sb[j] * ex2((float)(qi - k1) * lg) : 0.f; }
            *(bf16x8_t*)(sP + (qb * 2 + kp) * 1024 + lane * 16) = pack8(p);
        }
        f32x4 acc[4];
        {
            bf16x8_t Rop[2];
#pragma unroll
            for (int ks = 0; ks < 2; ++ks) { float t8[8];
#pragma unroll
                for (int j = 0; j < 4; ++j) { t8[j] = R[2 * ks][j]; t8[4 + j] = R[2 * ks + 1][j]; }
                Rop[ks] = pack8(t8); }
#pragma unroll
            for (int qb = 0; qb < 4; ++qb) { acc[qb] = (f32x4){0.f, 0.f, 0.f, 0.f};
#pragma unroll
                for (int ks = 0; ks < 2; ++ks) { const unsigned char* qp = sQ + (qb * 16 + fr) * 144 + (ks * 32 + 4 * fq) * 2;
                    const s16x4_t lo = *(const s16x4_t*)qp, hi = *(const s16x4_t*)(qp + 32);
                    acc[qb] = MFMA16(Rop[ks], __builtin_shufflevector(lo, hi, 0, 1, 2, 3, 4, 5, 6, 7), acc[qb]); }
                acc[qb] = acc[qb] * ex2((float)(qb * 16 + fr + 1) * lg); }
            f32x4 kvn[4];
#pragma unroll
            for (int db = 0; db < 4; ++db) kvn[db] = (f32x4){0.f, 0.f, 0.f, 0.f};
#pragma unroll
            for (int ks = 0; ks < 2; ++ks) {
#pragma unroll
                for (int db = 0; db < 4; ++db) { const bf16x8_t kt = *(const bf16x8_t*)(sKT + (db * 16 + fr) * 144 + (ks * 32 + fq * 8) * 2); kvn[db] = MFMA16(kt, cu.vf[ks], kvn[db]); } }
            const float g64 = ex2(64.f * lg);
#pragma unroll
            for (int db = 0; db < 4; ++db) R[db] = R[db] * g64 + kvn[db];
        }
        WG_BARRIER();
#pragma unroll
        for (int qb = 0; qb < 4; ++qb)
#pragma unroll
            for (int kp = 0; kp < 2; ++kp) { if (2 * kp > qb) continue;
                const bf16x8_t pf = *(const bf16x8_t*)(sP + (qb * 2 + kp) * 1024 + lane * 16);
                acc[qb] = MFMA16(__builtin_shufflevector(cu.vl[kp], cu.vh[kp], 0, 1, 2, 3, 4, 5, 6, 7), pf, acc[qb]); }
#pragma unroll
        for (int qb = 0; qb < 4; ++qb) { float s1 = (acc[qb][0] + acc[qb][1]) + (acc[qb][2] + acc[qb][3]);
            float s2 = (acc[qb][0] * acc[qb][0] + acc[qb][1] * acc[qb][1]) + (acc[qb][2] * acc[qb][2] + acc[qb][3] * acc[qb][3]);
            s1 += __shfl_xor(s1, 16); s1 += __shfl_xor(s1, 32); s2 += __shfl_xor(s2, 16); s2 += __shfl_xor(s2, 32);
            if (fq == 0) { sSt[((qb * 16 + fr) * 8 + w) * 2] = s1; sSt[((qb * 16 + fr) * 8 + w) * 2 + 1] = s2; } }
        WG_BARRIER();
#pragma unroll
        for (int qb = 0; qb < 4; ++qb) { const int tk = qb * 16 + fr; float s1 = 0.f, s2 = 0.f;
#pragma unroll
            for (int ww = 0; ww < 8; ww += 2) { const f32x4 v = *(const f32x4*)(sSt + (tk * 8 + ww) * 2); s1 += v[0] + v[2]; s2 += v[1] + v[3]; }
            const float mu = s1 * (1.f / 128.f); const float var = fmaxf(s2 * (1.f / 128.f) - mu * mu, 0.f); const float rstd = rsqrtf(var + EPSN);
            const int e0 = 16 * w + 4 * fq; bf16* gp = P + (t0 + tk) * PW + C_BG + h * 128 + e0;
            const u32x2 gw = cu.gt[qb]; const f32x4 g4 = *(const f32x4*)(gn + e0);
            const float y0 = siluf_(bflo(gw.x)) * (acc[qb][0] - mu) * rstd * g4[0], y1 = siluf_(bfhi(gw.x)) * (acc[qb][1] - mu) * rstd * g4[1];
            const float y2 = siluf_(bflo(gw.y)) * (acc[qb][2] - mu) * rstd * g4[2], y3 = siluf_(bfhi(gw.y)) * (acc[qb][3] - mu) * rstd * g4[3];
            u32x2 o; o.x = cvtpk(y0, y1); o.y = cvtpk(y2, y3); if (!dry) *(u32x2*)gp = o; }
    }
    __syncthreads();
}

#define XB_TMO      128
#define XB_XCNT(j)  (256  + 64 * (j))
#define XB_XSUB(j)  (1280 + 64 * (j))
#define XB_XGEN(j)  (2304 + 64 * (j))
#define XB_TOP      3328
#define XB_TOPGEN   3392
#define XCD_BAR_WORDS 3456
#define XB_SPIN_CAP (1u << 23)

__device__ __forceinline__ unsigned xb_ld(unsigned* p)              { return __hip_atomic_load(p, __ATOMIC_RELAXED, __HIP_MEMORY_SCOPE_AGENT); }
__device__ __forceinline__ unsigned xb_add(unsigned* p, unsigned v) { return __hip_atomic_fetch_add(p, v, __ATOMIC_RELAXED, __HIP_MEMORY_SCOPE_AGENT); }
__device__ __forceinline__ unsigned xb_xcc_id() { return (unsigned)__builtin_amdgcn_s_getreg((3 << 11) | 20) & 0xFu; }
#define XB_SPIN(cond, bar) do { unsigned _sp = 0; while (cond) { __builtin_amdgcn_s_sleep(1); \
    if ((++_sp & 255u) == 0u) { if (xb_ld(&(bar)[XB_TMO])) break; if (_sp > XB_SPIN_CAP) { atomicAdd(&(bar)[XB_TMO], 1u); break; } } } } while (0)

struct XcdBarrier {
    unsigned* bar; unsigned x;
    volatile LAS unsigned* st;
};

__device__ __forceinline__ XcdBarrier xcd_barrier_post(unsigned* bar, volatile LAS unsigned* st) {
    XcdBarrier b; b.bar = bar; b.x = xb_xcc_id(); b.st = st;
    if (threadIdx.x == 0) (void)xb_add(&bar[XB_XCNT(b.x)], 1u);
    return b;
}
__device__ __forceinline__ void xcd_barrier_complete(unsigned* bar, unsigned x, unsigned& nloc, unsigned& nx) {
    const unsigned G = gridDim.x * gridDim.y * gridDim.z;
    unsigned sum, cnt, mine, sp = 0u;
    for (;;) {
        sum = 0u; cnt = 0u; mine = 0u;
#pragma unroll
        for (unsigned j = 0; j < 16; ++j) { const unsigned c = xb_ld(&bar[XB_XCNT(j)]); sum += c; cnt += (c > 0u) ? 1u : 0u; mine = (j == x) ? c : mine; }
        if (sum == G) break;
        __builtin_amdgcn_s_sleep(1);
        if ((++sp & 255u) == 0u) { if (xb_ld(&bar[XB_TMO])) break; if (sp > XB_SPIN_CAP) { atomicAdd(&bar[XB_TMO], 1u); break; } }
    }
    nloc = mine > 0u ? mine : 1u; nx = cnt > 0u ? cnt : 1u;
}

__device__ __forceinline__ void xcd_barrier(const XcdBarrier& b) {
    asm volatile("s_waitcnt vmcnt(0)" ::: "memory");
    __syncthreads();
    if (threadIdx.x == 0) {
        unsigned* bar = b.bar;
        __builtin_amdgcn_s_waitcnt(0);
        unsigned nloc = b.st[0], nx = b.st[1];
        if (nloc == 0u) { xcd_barrier_complete(bar, b.x, nloc, nx); b.st[0] = nloc; b.st[1] = nx; }
        const unsigned old = xb_add(&bar[XB_XSUB(b.x)], 1u);
        const unsigned gen = old / nloc;
        if (old + 1u == (gen + 1u) * nloc) {
            __builtin_amdgcn_fence(__ATOMIC_RELEASE, "agent");
            asm volatile("s_waitcnt vmcnt(0)" ::: "memory");
            const unsigned og = xb_add(&bar[XB_TOP], 1u);
            const unsigned tg = og / nx;
            if (og + 1u == (tg + 1u) * nx) xb_add(&bar[XB_TOPGEN], 1u);
            else XB_SPIN(xb_ld(&bar[XB_TOPGEN]) == tg, bar);
            __builtin_amdgcn_fence(__ATOMIC_ACQUIRE, "agent");
            xb_add(&bar[XB_XGEN(b.x)], 1u);
            asm volatile("s_waitcnt vmcnt(0)" ::: "memory");
        } else {
            XB_SPIN(xb_ld(&bar[XB_XGEN(b.x)]) == gen, bar);
            __builtin_amdgcn_fence(__ATOMIC_ACQUIRE, "agent");
            asm volatile("s_waitcnt vmcnt(0)" ::: "memory");
        }
    }
    __syncthreads();
}

#define CONV_GRID_BAR() do { XcdBarrier xb_; xb_.bar = (unsigned*)(ws + WS_MISC + MS_BAR); xb_.x = xb_xcc_id(); xb_.st = (volatile LAS unsigned*)((LAS unsigned char*)lds + 131072 + 64); xcd_barrier(xb_); } while (0)
__device__ __forceinline__ void conv_prepass(const Ctx& c, ArgP A, int l, unsigned char* ws, unsigned char* lds) {
    bf16* P = (bf16*)(c.ws + WS_PROJ); bf16* XCT = (bf16*)(c.ws + WS_XCT);
    const int item = c.wg * 512 + c.tid; const bool act = item < 131072;
    const int cg8 = item & 127, run = (item >> 7) & 1023, ch0 = cg8 * 8;
    const size_t tok0 = (size_t)run * 16; const int s_in = (int)(tok0 & (SEQL - 1));
    unsigned outp[16][4];
    if (act) {
        const float* cw = A->in[7] + (size_t)l * 4 * 1024 + ch0; const float* cb = A->in[8] + (size_t)l * 1024 + ch0;
        float wt[4][8], bias[8];
#pragma unroll
        for (int k = 0; k < 8; ++k) { bias[k] = cb[k];
#pragma unroll
            for (int w = 0; w < 4; ++w) wt[w][k] = cw[w * 1024 + k]; }
        float win[3][8];
#pragma unroll
        for (int r = 0; r < 3; ++r) {
            if (s_in == 0) {
#pragma unroll
                for (int k = 0; k < 8; ++k) win[r][k] = 0.f; }
            else unpack8(*(const u32x4*)(P + (tok0 - 3 + r) * PW + C_DX + ch0), win[r]); }
#pragma unroll
        for (int tk = 0; tk < 16; ++tk) { float cur[8]; unpack8(*(const u32x4*)(P + (tok0 + tk) * PW + C_DX + ch0), cur); float o[8];
#pragma unroll
            for (int k = 0; k < 8; ++k) { const float a = bias[k] + wt[0][k] * win[0][k] + wt[1][k] * win[1][k] + wt[2][k] * win[2][k] + wt[3][k] * cur[k]; o[k] = siluf_(a);
                win[0][k] = win[1][k]; win[1][k] = win[2][k]; win[2][k] = cur[k]; }
#pragma unroll
            for (int q = 0; q < 4; ++q) outp[tk][q] = cvtpk(o[2 * q], o[2 * q + 1]); }
        if (cg8 < 96) {
#pragma unroll
            for (int q = 0; q < 4; ++q) { u32x4 lo0, lo1, hi0, hi1;
#pragma unroll
                for (int m = 0; m < 4; ++m) { const unsigned a0 = outp[2 * m][q], a1 = outp[2 * m + 1][q], b0 = outp[8 + 2 * m][q], b1 = outp[8 + 2 * m + 1][q];
                    lo0[m] = (a0 & 0xffffu) | (a1 << 16); hi0[m] = (a0 >> 16) | (a1 & 0xffff0000u); lo1[m] = (b0 & 0xffffu) | (b1 << 16); hi1[m] = (b0 >> 16) | (b1 & 0xffff0000u); }
                bf16* r0 = XCT + (size_t)(ch0 + 2 * q) * NT + tok0; bf16* r1 = r0 + NT;
                *(u32x4*)r0 = lo0; *(u32x4*)(r0 + 8) = lo1; *(u32x4*)r1 = hi0; *(u32x4*)(r1 + 8) = hi1; } }
    }
    CONV_GRID_BAR();
    if (act) {
#pragma unroll
        for (int tk = 0; tk < 16; ++tk) { u32x4 o; o.x = outp[tk][0]; o.y = outp[tk][1]; o.z = outp[tk][2]; o.w = outp[tk][3]; *(u32x4*)(P + (tok0 + tk) * PW + C_DX + ch0) = o; }
    }
}

struct DLoad { u32x4 bc[4]; u32x4 bt[2]; float dtr; u32x4 xf[2]; s16x4_t xl[2], xh[2]; };
__device__ __forceinline__ void d_issue(DLoad& L, const bf16* P, const bf16* XCT, const float* dtr, const bf16* xrow, int b, int g, int head, int head_s, int pb, int ch, int tid, int lane, int w, int fr, int fq) {
    const int s0 = ch * 64; const size_t t0 = (size_t)b * SEQL + s0;
#pragma unroll
    for (int r = 0; r < 4; ++r) { const int cn = tid + 512 * r, which = cn >> 10, tk = (cn >> 4) & 63, cc = cn & 15;
        L.bc[r] = *(const u32x4*)(P + (t0 + tk) * PW + C_DX + 512 + which * 256 + g * 128 + cc * 8); }
#pragma unroll
    for (int r = 0; r < 2; ++r) { const int cn = tid + 512 * r, n = cn >> 3, cc = cn & 7; L.bt[r] = *(const u32x4*)(XCT + (size_t)(512 + g * 128 + n) * NT + t0 + cc * 8); }
    L.dtr = (w < 2) ? dtr[(t0 + lane) * 8 + head_s] : 0.f;
#pragma unroll
    for (int ks = 0; ks < 2; ++ks) { L.xf[ks] = *(const u32x4*)(xrow + s0 + ks * 32 + fq * 8); L.xl[ks] = *(const s16x4_t*)(xrow + s0 + ks * 32 + 4 * fq); L.xh[ks] = *(const s16x4_t*)(xrow + s0 + ks * 32 + 16 + 4 * fq); }
}
__device__ __forceinline__ void mixer_d_mfma(const Ctx& c, ArgP A, unsigned char* lds_raw, int l, int unit, int dry) {
    bf16* P = (bf16*)(c.ws + WS_PROJ); const bf16* XCT = (const bf16*)(c.ws + WS_XCT);
    unsigned char* sB = lds_raw;
    unsigned char* sC = lds_raw + 17408;
    unsigned char* sBT = lds_raw + 34816;
    unsigned char* sS = lds_raw + 53248;
    float* sDt = (float*)(lds_raw + 63488);
    float* sAc = sDt + 256;
    const int b = unit >> 2, pair = unit & 3, g = pair >> 1;
    const int tid = c.tid, lane = c.lane, w = c.wave, fr = lane & 15, fq = lane >> 4, hh = w >> 2, pb = w & 3, head = pair * 2 + hh;
    constexpr float L2E = 1.4426950408889634f;
    const int head_s = pair * 2 + (w & 1);
    const float dtb_s = A->in[9][l * 8 + head_s], An_s = -expf(A->in[10][l * 8 + head_s]);
    const float Dsk = A->in[11][l * 8 + head];
    const f32x4 g4 = *(const f32x4*)(A->in[12] + (size_t)l * 512 + head * 64 + pb * 16 + 4 * fq);
    const float* dtr = (const float*)(c.ws + WS_MISC + MS_DT); float* ssq = (float*)(c.ws + WS_SSQ32);
    f32x4 H[8];
#pragma unroll
    for (int i = 0; i < 8; ++i) H[i] = (f32x4){0.f, 0.f, 0.f, 0.f};
    const bf16* xrow = XCT + (size_t)(head * 64 + pb * 16 + fr) * NT + (size_t)b * SEQL;
    DLoad nx; d_issue(nx, P, XCT, dtr, xrow, b, g, head, head_s, pb, 0, tid, lane, w, fr, fq);
    for (int ch = 0; ch < 64; ++ch) {
        const int s0 = ch * 64, par = ch & 1; const size_t t0 = (size_t)b * SEQL + s0;
        const DLoad cu = nx;
#pragma unroll
        for (int r = 0; r < 4; ++r) { const int cn = tid + 512 * r, which = cn >> 10, tk = (cn >> 4) & 63, cc = cn & 15; *(u32x4*)((which ? sC : sB) + tk * 272 + cc * 16) = cu.bc[r]; }
#pragma unroll
        for (int r = 0; r < 2; ++r) { const int cn = tid + 512 * r, n = cn >> 3, cc = cn & 7; *(u32x4*)(sBT + n * 144 + cc * 16) = cu.bt[r]; }
        if (w < 2) { const float x = cu.dtr + dtb_s; const float dt = fmaxf(x, 0.f) + log1pf(__expf(-fabsf(x)));
            float a = dt * An_s * L2E;
#pragma unroll
            for (int off = 1; off < 64; off <<= 1) { const float v = __shfl_up(a, off); if (lane >= off) a += v; }
            sDt[(par * 2 + w) * 64 + lane] = dt; sAc[(par * 2 + w) * 64 + lane] = a; }
        if (ch + 1 < 64) d_issue(nx, P, XCT, dtr, xrow, b, g, head, head_s, pb, ch + 1, tid, lane, w, fr, fq);
        u32x2 xr[4], zr[4];
#pragma unroll
        for (int qb = 0; qb < 4; ++qb) { const size_t t = t0 + qb * 16 + fr; const int p0 = head * 64 + pb * 16 + 4 * fq;
            xr[qb] = *(const u32x2*)(P + t * PW + C_DX + p0); zr[qb] = *(const u32x2*)(P + t * PW + C_DZ + p0); }
        WG_BARRIER();
        const float* dtv = sDt + (par * 2 + hh) * 64; const float* acv = sAc + (par * 2 + hh) * 64;
        for (int ti = w; ti < 10; ti += 8) { const int qb = (ti >= 6) ? 3 : (ti >= 3) ? 2 : (ti >= 1) ? 1 : 0, kb = ti - qb * (qb + 1) / 2;
            f32x4 sacc = (f32x4){0.f, 0.f, 0.f, 0.f};
#pragma unroll
            for (int ks = 0; ks < 4; ++ks) { const bf16x8_t bfv = *(const bf16x8_t*)(sB + (kb * 16 + fr) * 272 + (ks * 32 + fq * 8) * 2), cfv = *(const bf16x8_t*)(sC + (qb * 16 + fr) * 272 + (ks * 32 + fq * 8) * 2);
                sacc = MFMA16(bfv, cfv, sacc); }
            *(f32x4*)(sS + ti * 1024 + lane * 16) = sacc; }
        f32x4 acc[4];
        {
            bf16x8_t Hop[4];
#pragma unroll
            for (int ks = 0; ks < 4; ++ks) { float t8[8];
#pragma unroll
                for (int j = 0; j < 4; ++j) { t8[j] = H[2 * ks][j]; t8[4 + j] = H[2 * ks + 1][j]; }
                Hop[ks] = pack8(t8); }
#pragma unroll
            for (int qb = 0; qb < 4; ++qb) { acc[qb] = (f32x4){0.f, 0.f, 0.f, 0.f};
#pragma unroll
                for (int ks = 0; ks < 4; ++ks) { const unsigned char* cp = sC + (qb * 16 + fr) * 272 + (ks * 32 + 4 * fq) * 2;
                    const s16x4_t lo = *(const s16x4_t*)cp, hi = *(const s16x4_t*)(cp + 32);
                    acc[qb] = MFMA16(Hop[ks], __builtin_shufflevector(lo, hi, 0, 1, 2, 3, 4, 5, 6, 7), acc[qb]); }
                acc[qb] = acc[qb] * ex2(acv[qb * 16 + fr]); }
        }
        {
            const float aend = acv[63];
            bf16x8_t xw[2];
#pragma unroll
            for (int ks = 0; ks < 2; ++ks) { float xv[8]; unpack8(cu.xf[ks], xv);
                const f32x4 d0 = *(const f32x4*)(dtv + ks * 32 + fq * 8), d1 = *(const f32x4*)(dtv + ks * 32 + fq * 8 + 4), a0 = *(const f32x4*)(acv + ks * 32 + fq * 8), a1 = *(const f32x4*)(acv + ks * 32 + fq * 8 + 4);
#pragma unroll
                for (int j = 0; j < 4; ++j) { xv[j] *= d0[j] * ex2(aend - a0[j]); xv[4 + j] *= d1[j] * ex2(aend - a1[j]); }
                xw[ks] = pack8(xv); }
            const float ge = ex2(aend);
#pragma unroll
            for (int nh = 0; nh < 2; ++nh) {
                f32x4 kvn[4];
#pragma unroll
                for (int nb = 0; nb < 4; ++nb) kvn[nb] = (f32x4){0.f, 0.f, 0.f, 0.f};
#pragma unroll
                for (int ks = 0; ks < 2; ++ks)
#pragma unroll
                    for (int nb = 0; nb < 4; ++nb) { const bf16x8_t bt = *(const bf16x8_t*)(sBT + ((nh * 4 + nb) * 16 + fr) * 144 + (ks * 32 + fq * 8) * 2); kvn[nb] = MFMA16(bt, xw[ks], kvn[nb]); }
#pragma unroll
                for (int nb = 0; nb < 4; ++nb) H[nh * 4 + nb] = H[nh * 4 + nb] * ge + kvn[nb];
            }
        }
        WG_BARRIER();
#pragma unroll
        for (int qb = 0; qb < 4; ++qb) { const int qi = qb * 16 + fr; const float aq = acv[qi];
#pragma unroll
            for (int kp = 0; kp < 2; ++kp) { if (2 * kp > qb) continue;
                const int ti = qb * (qb + 1) / 2 + 2 * kp; const bool two = (2 * kp + 1) <= qb;
                const f32x4 sa = *(const f32x4*)(sS + ti * 1024 + lane * 16); f32x4 sb = (f32x4){0.f, 0.f, 0.f, 0.f}; if (two) sb = *(const f32x4*)(sS + (ti + 1) * 1024 + lane * 16);
                const int k0 = kp * 32 + 4 * fq;
                const f32x4 da = *(const f32x4*)(dtv + k0), db = *(const f32x4*)(dtv + k0 + 16), aa = *(const f32x4*)(acv + k0), ab = *(const f32x4*)(acv + k0 + 16);
                float p[8];
#pragma unroll
                for (int j = 0; j < 4; ++j) { p[j] = (k0 + j <= qi) ? sa[j] * da[j] * ex2(aq - aa[j]) : 0.f; p[4 + j] = (k0 + 16 + j <= qi) ? sb[j] * db[j] * ex2(aq - ab[j]) : 0.f; }
                acc[qb] = MFMA16(__builtin_shufflevector(cu.xl[kp], cu.xh[kp], 0, 1, 2, 3, 4, 5, 6, 7), pack8(p), acc[qb]); } }
#pragma unroll
        for (int qb = 0; qb < 4; ++qb) { const size_t t = t0 + qb * 16 + fr; const int p0 = head * 64 + pb * 16 + 4 * fq;
            const u32x2 xw = xr[qb]; bf16* zp = P + t * PW + C_DZ + p0; const u32x2 zw = zr[qb];
            const float y0 = (acc[qb][0] + Dsk * bflo(xw.x)) * siluf_(bflo(zw.x)), y1 = (acc[qb][1] + Dsk * bfhi(xw.x)) * siluf_(bfhi(zw.x));
            const float y2 = (acc[qb][2] + Dsk * bflo(xw.y)) * siluf_(bflo(zw.y)), y3 = (acc[qb][3] + Dsk * bfhi(xw.y)) * siluf_(bfhi(zw.y));
            float sq = (y0 * y0 + y1 * y1) + (y2 * y2 + y3 * y3); sq += __shfl_xor(sq, 16); sq += __shfl_xor(sq, 32);
            if (fq == 0 && !dry) ssq[t * 32 + head * 4 + pb] = sq;
            u32x2 o; o.x = cvtpk(y0 * g4[0], y1 * g4[1]); o.y = cvtpk(y2 * g4[2], y3 * g4[3]); if (!dry) *(u32x2*)zp = o; }
    }
    __syncthreads();
}

__device__ __forceinline__ void xattn_mfma(const Ctx& c) {
    const bf16* XQ = (const bf16*)(c.ws + WS_PROJ); bf16* AO = (bf16*)(c.ws + WS_PROJ + 16 * MiB);
    const bf16* KX = (const bf16*)(c.ws + WS_MISC + MS_KV);
    const bf16* VTX = (const bf16*)(c.ws + WS_MISC + MS_VTX);
    const int lane = c.lane, fr = lane & 15, fq = lane >> 4;
    constexpr float C2 = 0.08838834764831845f * 1.4426950408889634f;
    const int gw = c.wg * 8 + c.wave, ngw = c.nwg * 8;
    for (int g = gw; g < 4096; g += ngw) {
        const int h = (g >> 3) & 3, tb = ((g >> 5) << 3) | (g & 7), b = tb >> 8;
        const size_t t = (size_t)tb * 16 + fr;
        bf16x8_t qf[4];
#pragma unroll
        for (int ks = 0; ks < 4; ++ks) qf[ks] = *(const bf16x8_t*)(XQ + t * 512 + h * 128 + ks * 32 + fq * 8);
        f32x4 oacc[8];
#pragma unroll
        for (int eb = 0; eb < 8; ++eb) oacc[eb] = (f32x4){0.f, 0.f, 0.f, 0.f};
        float mrun = -1e30f, lrun = 0.f;
        for (int kp = 0; kp < 8; ++kp) {
            const bf16* k0p = KX + (size_t)(b * 256 + kp * 32 + fr) * 512 + h * 128 + fq * 8;
            f32x4 s0 = (f32x4){0.f, 0.f, 0.f, 0.f}, s1 = s0;
#pragma unroll
            for (int ks = 0; ks < 4; ++ks) { const bf16x8_t ka = *(const bf16x8_t*)(k0p + ks * 32), kb = *(const bf16x8_t*)(k0p + 16 * 512 + ks * 32);
                s0 = MFMA16(ka, qf[ks], s0); s1 = MFMA16(kb, qf[ks], s1); }
            float sc[8];
#pragma unroll
            for (int j = 0; j < 4; ++j) { sc[j] = s0[j] * C2; sc[4 + j] = s1[j] * C2; }
            float mx = fmaxf(fmaxf(fmaxf(sc[0], sc[1]), fmaxf(sc[2], sc[3])), fmaxf(fmaxf(sc[4], sc[5]), fmaxf(sc[6], sc[7])));
            mx = fmaxf(mx, __shfl_xor(mx, 16)); mx = fmaxf(mx, __shfl_xor(mx, 32));
            const float mnew = fmaxf(mrun, mx); const float alpha = ex2(mrun - mnew); mrun = mnew;
            float pr[8], ps = 0.f;
#pragma unroll
            for (int i = 0; i < 8; ++i) { pr[i] = ex2(sc[i] - mnew); ps += pr[i]; }
            lrun = lrun * alpha + ps;
            const bf16x8_t pf = pack8(pr);
#pragma unroll
            for (int eb = 0; eb < 8; ++eb) { const bf16* vp = VTX + (size_t)(h * 128 + eb * 16 + fr) * 1024 + b * 256 + kp * 32 + 4 * fq;
                const s16x4_t lo = *(const s16x4_t*)vp, hi = *(const s16x4_t*)(vp + 16);
                oacc[eb] = oacc[eb] * alpha; oacc[eb] = MFMA16(__builtin_shufflevector(lo, hi, 0, 1, 2, 3, 4, 5, 6, 7), pf, oacc[eb]); }
        }
        float lt = lrun; lt += __shfl_xor(lt, 16); lt += __shfl_xor(lt, 32); const float linv = 1.f / lt;
        bf16* op = AO + t * 512 + h * 128 + 4 * fq;
#pragma unroll
        for (int eb = 0; eb < 8; ++eb) { u32x2 o; o.x = cvtpk(oacc[eb][0] * linv, oacc[eb][1] * linv); o.y = cvtpk(oacc[eb][2] * linv, oacc[eb][3] * linv); *(u32x2*)(op + eb * 16) = o; }
    }
}

__device__ __forceinline__ void mixer_b_naive(const Ctx& c, ArgP A, unsigned char* lds_raw, int l, int unit) {
    bf16* P = (bf16*)(c.ws + WS_PROJ); const bf16* VTb = (const bf16*)(c.ws + WS_VT) + (size_t)VT_B * NT;
    float* sQ = (float*)lds_raw;
    float* sKk = sQ + 32 * 64;
    float* sVv = sKk + 32 * 64;
    float* sP = sVv + 32 * 128;
    const int b = unit >> 2, h = unit & 3, tid = c.tid, e = tid & 127, dg = tid >> 7;
    const float gamma = 1.f - exp2f(-5.f - (float)h);
    const float* gn = A->in[4] + (size_t)l * 512 + h * 128;
    float S[16];
#pragma unroll
    for (int i = 0; i < 16; ++i) S[i] = 0.f;
    for (int s0 = 0; s0 < SEQL; s0 += 32) {
        const size_t t0 = (size_t)b * SEQL + s0;
#pragma unroll
        for (int r = 0; r < 4; ++r) { const int it = tid + 512 * r, which = it >> 10, st = (it >> 5) & 31, i = it & 31;
            const bf16* src = P + (t0 + st) * PW + (which ? C_BK : C_BQ) + h * 64;
            const float t1 = bf2f(src[i]), t2 = bf2f(src[i + 32]);
            const float invf = powf(10000.f, -(float)i / 32.f); const float ang = (float)(s0 + st) * invf;
            float sn, cs; sincosf(ang, &sn, &cs);
            const float sc = which ? 0.125f : 1.f; float* dst = (which ? sKk : sQ) + st * 64;
            dst[i] = (t1 * cs - t2 * sn) * sc; dst[i + 32] = (t1 * sn + t2 * cs) * sc; }
#pragma unroll
        for (int r = 0; r < 8; ++r) { const int it = tid + 512 * r, st = it >> 7, ee = it & 127; sVv[st * 128 + ee] = bf2f(VTb[(size_t)(h * 128 + ee) * NT + t0 + st]); }
        __syncthreads();
        for (int st = 0; st < 32; ++st) {
            const float vv = sVv[st * 128 + e]; float po = 0.f;
#pragma unroll
            for (int i4 = 0; i4 < 4; ++i4) { const f32x4 kk = *(const f32x4*)(sKk + st * 64 + dg * 16 + 4 * i4), qq = *(const f32x4*)(sQ + st * 64 + dg * 16 + 4 * i4);
#pragma unroll
                for (int j = 0; j < 4; ++j) { S[4 * i4 + j] = gamma * S[4 * i4 + j] + kk[j] * vv; po += qq[j] * S[4 * i4 + j]; } }
            sP[(st * 4 + dg) * 128 + e] = po;
        }
        __syncthreads();
#pragma unroll
        for (int r = 0; r < 4; ++r) { const int st = c.wave * 4 + r, lane = c.lane;
            float o0 = 0.f, o1 = 0.f;
#pragma unroll
            for (int g = 0; g < 4; ++g) { o0 += sP[(st * 4 + g) * 128 + lane]; o1 += sP[(st * 4 + g) * 128 + lane + 64]; }
            const float mu = wave_sum(o0 + o1) * (1.f / 128.f); const float a0 = o0 - mu, a1 = o1 - mu;
            const float var = wave_sum(a0 * a0 + a1 * a1) * (1.f / 128.f); const float rstd = rsqrtf(var + EPSN);
            bf16* gp = P + (t0 + st) * PW + C_BG + h * 128;
            const float g0 = bf2f(gp[lane]), g1 = bf2f(gp[lane + 64]);
            gp[lane] = (bf16)f2bf(siluf_(g0) * a0 * rstd * gn[lane]); gp[lane + 64] = (bf16)f2bf(siluf_(g1) * a1 * rstd * gn[lane + 64]); }
    }
    __syncthreads();
}

__device__ __forceinline__ void mixer_d_naive(const Ctx& c, ArgP A, unsigned char* lds_raw, int l, int unit) {
    bf16* P = (bf16*)(c.ws + WS_PROJ);
    float* sXs = (float*)lds_raw;
    float* sB = sXs + 32 * 64;
    float* sC = sB + 32 * 128;
    float* sDt = sC + 32 * 128;
    float* sA = sDt + 32;
    float* sP = sA + 32;
    const int b = unit >> 3, hd = unit & 7, g = hd >> 2, tid = c.tid, p = tid & 63, ng = tid >> 6;
    const float* cw = A->in[7] + (size_t)l * 4 * 1024; const float* cb = A->in[8] + (size_t)l * 1024;
    const float dtb = A->in[9][l * 8 + hd], Aneg = -expf(A->in[10][l * 8 + hd]), Dsk = A->in[11][l * 8 + hd];
    const float* ng_ = A->in[12] + (size_t)l * 512 + hd * 64;
    const float* dtr = (const float*)(c.ws + WS_MISC + MS_DT); float* ssq = (float*)(c.ws + WS_MISC + MS_SSQ);
    float S[16];
#pragma unroll
    for (int i = 0; i < 16; ++i) S[i] = 0.f;
    for (int s0 = 0; s0 < SEQL; s0 += 32) {
        const size_t t0 = (size_t)b * SEQL + s0;
        for (int it = tid; it < 32 * 320; it += 512) { const int st = it / 320, ch = it % 320;
            int cc; float* dst;
            if (ch < 64) { cc = hd * 64 + ch; dst = sXs + st * 64 + ch; } else if (ch < 192) { cc = 512 + g * 128 + (ch - 64); dst = sB + st * 128 + (ch - 64); } else { cc = 768 + g * 128 + (ch - 192); dst = sC + st * 128 + (ch - 192); }
            float a = cb[cc];
#pragma unroll
            for (int w = 0; w < 4; ++w) { const int sp = s0 + st - 3 + w; if (sp >= 0) a += cw[w * 1024 + cc] * bf2f(P[((size_t)b * SEQL + sp) * PW + C_DX + cc]); }
            *dst = siluf_(a); }
        if (tid < 32) { const float x = dtr[(t0 + tid) * 8 + hd] + dtb; const float dt = fmaxf(x, 0.f) + log1pf(__expf(-fabsf(x))); sDt[tid] = dt; sA[tid] = __expf(dt * Aneg); }
        __syncthreads();
        for (int st = 0; st < 32; ++st) {
            const float a = sA[st], xdt = sDt[st] * sXs[st * 64 + p]; float po = 0.f;
#pragma unroll
            for (int i4 = 0; i4 < 4; ++i4) { const f32x4 bb = *(const f32x4*)(sB + st * 128 + ng * 16 + 4 * i4), cc4 = *(const f32x4*)(sC + st * 128 + ng * 16 + 4 * i4);
#pragma unroll
                for (int j = 0; j < 4; ++j) { S[4 * i4 + j] = a * S[4 * i4 + j] + bb[j] * xdt; po += cc4[j] * S[4 * i4 + j]; } }
            sP[(st * 8 + ng) * 64 + p] = po;
        }
        __syncthreads();
#pragma unroll
        for (int r = 0; r < 4; ++r) { const int st = c.wave * 4 + r, lane = c.lane;
            float y = 0.f;
#pragma unroll
            for (int q = 0; q < 8; ++q) y += sP[(st * 8 + q) * 64 + lane];
            y += Dsk * sXs[st * 64 + lane];
            bf16* zp = P + (t0 + st) * PW + C_DZ + hd * 64;
            const float yz = y * siluf_(bf2f(zp[lane]));
            const float sq = wave_sum(yz * yz);
            if (lane == 0) ssq[(t0 + st) * 8 + hd] = sq;
            zp[lane] = (bf16)f2bf(yz * ng_[lane]); }
    }
    __syncthreads();
}

__device__ __forceinline__ void xattn_naive(const Ctx& c) {
    const bf16* XQ = (const bf16*)(c.ws + WS_PROJ); bf16* AO = (bf16*)(c.ws + WS_PROJ + 16 * MiB);
    const bf16* KV = (const bf16*)(c.ws + WS_MISC + MS_KV);
    for (int item = c.wg * 512 + c.tid; item < NT * 8; item += c.nwg * 512) {
        const int w = item >> 6, h = w & 3, t = (w >> 2) * 32 + ((item & 63) >> 1), half = item & 1, b = t >> 12;
        const bf16* qp = XQ + (size_t)t * 512 + h * 128 + half * 64;
        float q[64], o[64];
#pragma unroll
        for (int i = 0; i < 8; ++i) { float f[8]; unpack8(*(const u32x4*)(qp + 8 * i), f);
#pragma unroll
            for (int j = 0; j < 8; ++j) { q[8 * i + j] = f[j] * 0.08838834764831845f; o[8 * i + j] = 0.f; } }
        float mrun = -1e30f, lrun = 0.f;
        for (int m = 0; m < 256; ++m) {
            const bf16* kr = KV + (size_t)(b * 256 + m) * 1024 + h * 128 + half * 64; const bf16* vr = kr + 512;
            float sc = 0.f;
#pragma unroll
            for (int i = 0; i < 8; ++i) { float f[8]; unpack8(*(const u32x4*)(kr + 8 * i), f);
#pragma unroll
                for (int jj = 0; jj < 8; ++jj) sc += q[8 * i + jj] * f[jj]; }
            sc += __shfl_xor(sc, 1);
            float p_; if (sc > mrun) { const float r = __expf(mrun - sc); lrun *= r;
#pragma unroll
                for (int i = 0; i < 64; ++i) o[i] *= r;
                mrun = sc; p_ = 1.f; } else p_ = __expf(sc - mrun);
            lrun += p_;
#pragma unroll
            for (int i = 0; i < 8; ++i) { float f[8]; unpack8(*(const u32x4*)(vr + 8 * i), f);
#pragma unroll
                for (int jj = 0; jj < 8; ++jj) o[8 * i + jj] += p_ * f[jj]; }
        }
        const float inv = 1.f / lrun;
        bf16* op = AO + (size_t)t * 512 + h * 128 + half * 64;
#pragma unroll
        for (int i = 0; i < 8; ++i) { u32x4 wv; wv.x = pk2(o[8 * i] * inv, o[8 * i + 1] * inv); wv.y = pk2(o[8 * i + 2] * inv, o[8 * i + 3] * inv);
            wv.z = pk2(o[8 * i + 4] * inv, o[8 * i + 5] * inv); wv.w = pk2(o[8 * i + 6] * inv, o[8 * i + 7] * inv); *(u32x4*)(op + 8 * i) = wv; }
    }
}


#define GEMM_PHASE(EPI_T, Aptr, LDA, Bptr, MM, NN, KK, ...) do { \
    pg8::Gemm g_{(const pg8::bf16_t*)(Aptr), (const pg8::bf16_t*)(Bptr), (MM), (NN), (KK), (LDA)}; pg8::StaticOrder S_; S_.init((MM), (NN), c.nwg, c.wg); \
    EPI_T E_{__VA_ARGS__}; pg8::gemm_phase<EPI_T, pg8::StaticOrder, true, true>((PG8_LAS unsigned char*)lds, g_, S_, E_); } while (0)

__global__ void __launch_bounds__(512, 2) mega_fwd(Args args) {
    extern __shared__ __attribute__((aligned(16))) unsigned char lds[];
    cg::grid_group grid = cg::this_grid();
    {
        volatile LAS unsigned* st0 = (volatile LAS unsigned*)((LAS unsigned char*)lds + 131072 + 64);
        if (threadIdx.x == 0) { st0[0] = 0u; st0[1] = 0u; }
        __syncthreads();
        (void)xcd_barrier_post((unsigned*)(args.ws + WS_MISC + MS_BAR), st0);
    }
#define GRID_BAR() do { XcdBarrier xb_; xb_.bar = (unsigned*)(ws + WS_MISC + MS_BAR); xb_.x = xb_xcc_id(); xb_.st = (volatile LAS unsigned*)((LAS unsigned char*)lds + 131072 + 64); xcd_barrier(xb_); } while (0)
#if XSYNC
    for (int i_ = 0; i_ < XSYNC; ++i_) { asm volatile("" : "+s"(i_)); grid.sync(); }
#endif
    int ph = 0;
    const int lo = args.ph_lo, hi = args.ph_hi;
#define PHASE_BEGIN if (ph >= lo && ph < hi) { ArgP ap = (ArgP)__builtin_amdgcn_kernarg_segment_ptr(); asm volatile("" : "+s"(ap)); unsigned char* ws = ap->ws; Ctx c; c.ws = ws; \
    { int t_ = threadIdx.x, g_ = blockIdx.x, n_ = gridDim.x; asm volatile("" : "+v"(t_), "+s"(g_), "+s"(n_)); c.tid = t_; c.lane = t_ & 63; c.wave = __builtin_amdgcn_readfirstlane(t_ >> 6); c.wg = g_; c.nwg = n_; } \
    bf16* Wb = (bf16*)(ws + WS_W); bf16* XN = (bf16*)(ws + WS_XN); bf16* PJ = (bf16*)(ws + WS_PROJ); float* X = ap->out; (void)Wb; (void)XN; (void)PJ; (void)X;
#define PHASE_END   if (ph + 1 < hi) { if (ph == 0) grid.sync(); else GRID_BAR(); } } ++ph;

    for (int l = 0; l < 2; ++l) {
        asm volatile("" : "+s"(l));
        PHASE_BEGIN if ((PHMASK >> 0) & 1) for (int rep_ = 0; rep_ <= ((REPMASK >> 0) & 1); ++rep_) {
            convert_layer(c, ap, l);
            if (c.wg == 0 && c.tid < 2) ((unsigned*)(ws + WS_MISC + MS_CNT))[l * 2 + c.tid] = 0u;
            if (l == 0) { float* rope = (float*)(ws + WS_MISC + MS_ROPE);
                for (int it = c.wg * 512 + c.tid; it < SEQL * 32; it += c.nwg * 512) { const int i = it & 31; const float ang = (float)(it >> 5) * powf(10000.f, -(float)i / 32.f); float sn, cs; sincosf(ang, &sn, &cs); rope[2 * it] = cs; rope[2 * it + 1] = sn; } }
            norm_rows(c, (l == 0) ? ap->in[0] : X, ap->in[2] + (size_t)l * DM, XN, NT, ap->in[3] + (size_t)l * DM * INW, (float*)(ws + WS_MISC + MS_DT));
        } PHASE_END
        PHASE_BEGIN if ((PHMASK >> 1) & 1) for (int rep_ = 0; rep_ <= ((REPMASK >> 1) & 1); ++rep_) {
            GEMM_PHASE(pg8::EpiStore<0>, XN, 1024, Wb + W_IN, NT, 4608, 1024, PJ, PW);
            GEMM_PHASE(pg8::EpiStore<0>, (bf16*)(ws + WS_WVT), 1024, XN, 1536, NT, 1024, (bf16*)(ws + WS_VT), NT);
        } PHASE_END
        PHASE_BEGIN if ((PHMASK >> 2) & 1) for (int rep_ = 0; rep_ <= ((REPMASK >> 2) & 1); ++rep_) {
            conv_prepass(c, ap, l, ws, lds);
            GRID_BAR();
            int dry0 = 0; asm volatile("" : "+s"(dry0));
            unsigned* cnt = (unsigned*)(ws + WS_MISC + MS_CNT) + l * 2;
            if (c.wg < 16) mixer_b_mfma(c, ap, lds, l, c.wg, dry0);
            else if (c.wg < 32) mixer_d_mfma(c, ap, lds, l, c.wg - 16, dry0);
            mixer_c_mfma(c, ap, lds, l, dry0, cnt);
            mixer_a_mfma(c, dry0, cnt + 1);
        } PHASE_END
        PHASE_BEGIN if ((PHMASK >> 3) & 1) for (int rep_ = 0; rep_ <= ((REPMASK >> 3) & 1); ++rep_) {
            for (int i = 0; i < 4; ++i) {
                asm volatile("" : "+s"(i));
                const int acol = (i == 0) ? C_AQ : (i == 1) ? C_BG : (i == 2) ? C_CQ : C_DZ;
                GEMM_PHASE(pg8::EpiStore<1>, XN, 1024, Wb + W_G + (size_t)i * 1024 * 1024, NT, 1024, 1024, PJ + C_GS, PW);
                GEMM_PHASE(pg8::EpiGateAcc, PJ + acol, PW, Wb + W_B + (size_t)i * 1024 * 512, NT, 1024, 512, PJ + C_GS, PJ + C_MG, PW, i == 0 ? 1 : 0, i == 3 ? (const float*)(ws + WS_SSQ32) : nullptr);
            }
        } PHASE_END
        PHASE_BEGIN if ((PHMASK >> 4) & 1) for (int rep_ = 0; rep_ <= ((REPMASK >> 4) & 1); ++rep_) {
            GEMM_PHASE(pg8::EpiResid, PJ + C_MG, PW, Wb + W_MO, NT, 1024, 1024, (l == 0) ? ap->in[0] : X, X);
        } PHASE_END
        PHASE_BEGIN if ((PHMASK >> 5) & 1) for (int rep_ = 0; rep_ <= ((REPMASK >> 5) & 1); ++rep_) {
            norm_rows(c, X, ap->in[15] + (size_t)l * DM, XN, NT, nullptr, nullptr);
            norm_rows(c, ap->in[1], ap->in[16] + (size_t)l * DM, (bf16*)(ws + WS_MISC + MS_MN), 1024, nullptr, nullptr);
        } PHASE_END
        PHASE_BEGIN if ((PHMASK >> 6) & 1) for (int rep_ = 0; rep_ <= ((REPMASK >> 6) & 1); ++rep_) {
            GEMM_PHASE(pg8::EpiStore<0>, XN, 1024, Wb + W_XQ, NT, 512, 1024, PJ, 512);
            GEMM_PHASE(pg8::EpiStore<0>, (bf16*)(ws + WS_MISC + MS_MN), 1024, Wb + W_XKV, 1024, 512, 1024, (bf16*)(ws + WS_MISC + MS_KV), 512);
            GEMM_PHASE(pg8::EpiStore<0>, Wb + W_XKV + (size_t)512 * 1024, 1024, (bf16*)(ws + WS_MISC + MS_MN), 512, 1024, 1024, (bf16*)(ws + WS_MISC + MS_VTX), 1024);
        } PHASE_END
        PHASE_BEGIN if ((PHMASK >> 7) & 1) for (int rep_ = 0; rep_ <= ((REPMASK >> 7) & 1); ++rep_) {
            xattn_mfma(c);
        } PHASE_END
        PHASE_BEGIN if ((PHMASK >> 8) & 1) for (int rep_ = 0; rep_ <= ((REPMASK >> 8) & 1); ++rep_) {
            GEMM_PHASE(pg8::EpiResid, (bf16*)(ws + WS_PROJ + 16 * MiB), 512, Wb + W_XO, NT, 1024, 512, X, X);
        } PHASE_END
        PHASE_BEGIN if ((PHMASK >> 9) & 1) for (int rep_ = 0; rep_ <= ((REPMASK >> 9) & 1); ++rep_) {
            norm_rows(c, X, ap->in[20] + (size_t)l * DM, XN, NT, nullptr, nullptr);
        } PHASE_END
        PHASE_BEGIN if ((PHMASK >> 10) & 1) for (int rep_ = 0; rep_ <= ((REPMASK >> 10) & 1); ++rep_) {
            GEMM_PHASE(pg8::EpiSwiglu, XN, 1024, Wb + W_FI, NT, 5632, 1024, PJ, FFH);
        } PHASE_END
        PHASE_BEGIN if ((PHMASK >> 11) & 1) for (int rep_ = 0; rep_ <= ((REPMASK >> 11) & 1); ++rep_) {
            GEMM_PHASE(pg8::EpiResid, PJ, FFH, Wb + W_FO, NT, 1024, FFH, X, X);
        } PHASE_END
    }
    PHASE_BEGIN if ((PHMASK >> 12) & 1) for (int rep_ = 0; rep_ <= ((REPMASK >> 12) & 1); ++rep_) {
        final_norm(c, X, ap->in[23]);
    } PHASE_END
}

extern "C" void kernel_launch(void* const* d_in, const int* in_sizes, int n_in, void* d_out, int out_size, void* d_ws, size_t ws_size, hipStream_t stream) {
    static int grid_blocks = 0;
    if (grid_blocks == 0) {
        if (n_in != 24 || out_size != NT * DM || ws_size < WS_END) { fprintf(stderr, "kernel_launch: unexpected shapes (n_in %d out %d ws %zu)\n", n_in, out_size, ws_size); grid_blocks = -1; return; }
        int dev = 0, cus = 0, per_cu = 0;
        hipGetDevice(&dev);
        hipDeviceGetAttribute(&cus, hipDeviceAttributeMultiprocessorCount, dev);
        if (hipFuncSetAttribute((const void*)mega_fwd, hipFuncAttributeMaxDynamicSharedMemorySize, LDS_BYTES) != hipSuccess) { fprintf(stderr, "kernel_launch: hipFuncSetAttribute failed\n"); grid_blocks = -1; return; }
        if (hipOccupancyMaxActiveBlocksPerMultiprocessor(&per_cu, (const void*)mega_fwd, 512, LDS_BYTES) != hipSuccess || per_cu < 1) { fprintf(stderr, "kernel_launch: occupancy query says %d\n", per_cu); per_cu = 1; }
        (void)hipGetLastError();
        grid_blocks = cus * 1;
        fprintf(stderr, "kernel_launch: grid %d (cus %d, per_cu %d)\n", grid_blocks, cus, per_cu);
    }
    if (grid_blocks < 0) return;
    if (hipMemsetAsync((char*)d_ws + WS_MISC + MS_BAR, 0, XCD_BAR_WORDS * 4, stream) != hipSuccess) { fprintf(stderr, "kernel_launch: memset failed\n"); return; }
    Args a{};
    for (int i = 0; i < 24; ++i) a.in[i] = (const float*)d_in[i];
    a.out = (float*)d_out; a.ws = (unsigned char*)d_ws; a.ph_lo = 0; a.ph_hi = 1000;
    void* kargs[] = {&a};
    hipError_t e = hipLaunchCooperativeKernel((const void*)mega_fwd, dim3(grid_blocks), dim3(512), kargs, LDS_BYTES, stream);
    if (e != hipSuccess) fprintf(stderr, "kernel_launch: cooperative launch failed: %s (grid %d)\n", hipGetErrorString(e), grid_blocks);
}
```

```cpp
#include <hip/hip_runtime.h>
#include <hip/hip_cooperative_groups.h>
#include <cstdio>
#include <cstdint>
namespace cg = cooperative_groups;
namespace pg8 {
#define PG8_LAS __attribute__((address_space(3)))
typedef unsigned short bf16_t;
typedef short bf16x8 __attribute__((ext_vector_type(8)));
typedef float f32x4 __attribute__((ext_vector_type(4)));
typedef unsigned u32x4 __attribute__((ext_vector_type(4)));
constexpr int BM = 256, BK = 64, HALF = 128, HTB = HALF * BK * 2  , STAGE_BYTES = 8 * HTB, NXCD = 8, WGM = 8;

__host__ __device__ __forceinline__ int lds_byte(int r, int c) { const int st = (r >> 4) * 2 + (c >> 5), rr = r & 15, cc = c & 31, ob = rr * 64 + cc * 2; return st * 1024 + (ob ^ (((ob >> 9) & 1) << 5)); }
__host__ __device__ __forceinline__ void stage_rc(int b, int& R, int& C) { const int st = b / 1024, sb = b % 1024, swz = sb ^ (((sb >> 9) & 1) << 5); R = (st >> 1) * 16 + swz / 64; C = (st & 1) * 32 + (swz % 64) / 2; }
__host__ __device__ __forceinline__ int perm32(int rho) { const int n = rho >> 4, i = rho & 15; return 8 * (i >> 2) + 4 * n + (i & 3); }

struct Unit { int pm, pn; };
struct Gemm { const bf16_t* A; const bf16_t* Bt; int M, N, K, lda; };

struct StaticOrder {
    int nM, nN, nwg, G, c;
    __host__ __device__ void init(int M, int N, int G_, int c_) { nM = M / BM; nN = N / BM; nwg = nM * nN; G = G_; c = c_; }
    __host__ __device__ bool next(int i, Unit& u) const {
        const long L = (long)i * G + c; if (L >= nwg) return false;
        int wgid = (int)L; { const int q = nwg / NXCD, r = nwg % NXCD, xcd = wgid % NXCD, off = wgid / NXCD; wgid = (xcd < r ? xcd * (q + 1) : r * (q + 1) + (xcd - r) * q) + off; }
        const int nig = WGM * nN, gid = wgid / nig, fm = gid * WGM, gsz = (nM - fm) < WGM ? (nM - fm) : WGM;
        u.pm = fm + ((wgid % nig) % gsz); u.pn = (wgid % nig) / gsz; return true;
    }
    __device__ __forceinline__ void a_ready(const Unit&) const {}
    __device__ __forceinline__ void done(const Unit&) const {}
};

__device__ __forceinline__ unsigned cvt_pk_bf16(float lo, float hi) { unsigned r; asm volatile("v_cvt_pk_bf16_f32 %0, %1, %2" : "=v"(r) : "v"(lo), "v"(hi)); return r; }

template <class Epi, class Sched, bool ALIGN_EPI = false, bool SP2 = false>
__device__ __forceinline__ void gemm_phase(PG8_LAS unsigned char* lds, const Gemm g, const Sched& S, const Epi& E) {
    int tid_l = threadIdx.x; asm volatile("" : "+v"(tid_l));
    const int tid = tid_l, wid = __builtin_amdgcn_readfirstlane(tid >> 6), lane = tid & 63, wr = wid >> 2, wc = wid & 3, fr = lane & 15, fq = lane >> 4;
    const int K = g.K, nt = K / BK;
    unsigned voffA[2], voffB[2];
#pragma unroll
    for (int i = 0; i < 2; ++i) { int R, C; stage_rc(tid * 16 + i * 8192, R, C); const int Rb = Epi::PERM ? ((R & ~31) + perm32(R & 31)) : R;
        voffA[i] = (unsigned)(R * g.lda + C) * 2u; voffB[i] = (unsigned)(Rb * K + C) * 2u; }
    const size_t kstep = (size_t)(BK * 2);
    const size_t hstepA = (size_t)HALF * g.lda * 2, hstepB = (size_t)HALF * K * 2;
    const size_t tstepA = 2 * hstepA, tstepB = 2 * hstepB;
    const unsigned ldsw = (unsigned)wid * 1024u;
    const int aoff = lds_byte(wr * 64 + fr, fq * 8), boff = lds_byte(wc * 32 + fr, fq * 8);
#define PG8_SA(b, h) (((b) * 2 + (h)) * HTB)
#define PG8_SB(b, h) ((4 + (b) * 2 + (h)) * HTB)
#define PG8_STAGE(bufoff, gbase, voff) do { _Pragma("unroll") for (int _i = 0; _i < 2; ++_i) \
        __builtin_amdgcn_global_load_lds((const unsigned*)((const char*)(gbase) + (voff)[_i]), (PG8_LAS unsigned*)(lds + (bufoff) + ldsw + _i * 8192), 16, 0, 0); } while (0)
#define PG8_LDA(dst, b, h) do { _Pragma("unroll") for (int m = 0; m < 4; ++m) _Pragma("unroll") for (int k = 0; k < 2; ++k) dst[m][k] = *(const PG8_LAS bf16x8*)(lds + PG8_SA(b, h) + aoff + m * 2048 + k * 1024); } while (0)
#define PG8_LDB(dst, b, h) do { _Pragma("unroll") for (int n = 0; n < 2; ++n) _Pragma("unroll") for (int k = 0; k < 2; ++k) dst[n][k] = *(const PG8_LAS bf16x8*)(lds + PG8_SB(b, h) + boff + n * 2048 + k * 1024); } while (0)
#define PG8_MMA(ai, bj, At, Bt) do { __builtin_amdgcn_s_setprio(1); _Pragma("unroll") for (int m = 0; m < 4; ++m) _Pragma("unroll") for (int n = 0; n < 2; ++n) _Pragma("unroll") for (int k = 0; k < 2; ++k) \
        acc[ai][bj][m][n] = __builtin_amdgcn_mfma_f32_16x16x32_bf16(Bt[n][k], At[m][k], acc[ai][bj][m][n], 0, 0, 0); __builtin_amdgcn_s_setprio(0); } while (0)
#define PG8_WAIT_V(n) asm volatile("s_waitcnt vmcnt(" #n ")" ::: "memory")
#define PG8_WAIT_L(n) asm volatile("s_waitcnt lgkmcnt(" #n ")" ::: "memory")
#define PG8_BAR __builtin_amdgcn_s_barrier()
#define PG8_SCHED __builtin_amdgcn_sched_barrier(0)
    Unit cur, nxt; int ui = 0;
    if (!S.next(0, cur)) return;
    f32x4 acc[2][2][4][2];
#pragma unroll
    for (int a = 0; a < 2; ++a)
#pragma unroll
        for (int b = 0; b < 2; ++b)
#pragma unroll
            for (int m = 0; m < 4; ++m)
#pragma unroll
                for (int n = 0; n < 2; ++n) acc[a][b][m][n] = (f32x4){0.f, 0.f, 0.f, 0.f};
    bf16x8 At[4][2], B0[2][2], B1[2][2];
    const char* cA = (const char*)g.A + (size_t)cur.pm * tstepA; const char* cB = (const char*)g.Bt + (size_t)cur.pn * tstepB;
    S.a_ready(cur);
    if constexpr (SP2) {
        PG8_STAGE(PG8_SB(0, 0), cB, voffB); PG8_STAGE(PG8_SB(0, 1), cB + hstepB, voffB); PG8_STAGE(PG8_SA(0, 0), cA, voffA); PG8_STAGE(PG8_SA(0, 1), cA + hstepA, voffA);
        if (wr == 1) PG8_BAR;
        PG8_WAIT_V(2); PG8_BAR;
        PG8_STAGE(PG8_SB(1, 0), cB + kstep, voffB); PG8_STAGE(PG8_SA(1, 0), cA + kstep, voffA); PG8_STAGE(PG8_SB(1, 1), cB + hstepB + kstep, voffB);
        PG8_WAIT_V(6); PG8_BAR;
    } else {
        PG8_STAGE(PG8_SB(0, 0), cB, voffB); PG8_STAGE(PG8_SA(0, 0), cA, voffA); PG8_STAGE(PG8_SB(0, 1), cB + hstepB, voffB); PG8_STAGE(PG8_SA(0, 1), cA + hstepA, voffA);
        if (wr == 1) PG8_BAR;
        PG8_WAIT_V(4); PG8_BAR;
        PG8_STAGE(PG8_SB(1, 0), cB + kstep, voffB); PG8_STAGE(PG8_SA(1, 0), cA + kstep, voffA); PG8_STAGE(PG8_SB(1, 1), cB + hstepB + kstep, voffB);
        PG8_WAIT_V(6); PG8_BAR;
    }
    for (;;) {
        const bool has_next = S.next(ui + 1, nxt);
        const char* nA = has_next ? (const char*)g.A + (size_t)nxt.pm * tstepA : cA; const char* nB = has_next ? (const char*)g.Bt + (size_t)nxt.pn * tstepB : cB;
        for (int t = 0; t < nt; t += 2) {
            const bool last = (t == nt - 2);
            const char* a1 = cA + (size_t)(t + 1) * kstep;
            const char* a2 = last ? nA : cA + (size_t)(t + 2) * kstep; const char* b2 = last ? nB : cB + (size_t)(t + 2) * kstep;
            const char* a3 = a2 + kstep; const char* b3 = b2 + kstep;
            if (last && has_next) S.a_ready(nxt);
            if constexpr (SP2) {
            PG8_LDB(B0, 0, 0); PG8_LDB(B1, 0, 1); PG8_SCHED; PG8_LDA(At, 0, 0); PG8_STAGE(PG8_SA(1, 1), a1 + hstepA, voffA);
            PG8_WAIT_V(8); PG8_WAIT_L(0); PG8_BAR; PG8_MMA(0, 0, At, B0); PG8_MMA(0, 1, At, B1); PG8_BAR; PG8_SCHED;
            PG8_LDA(At, 0, 1); PG8_STAGE(PG8_SB(0, 0), b2, voffB); PG8_STAGE(PG8_SB(0, 1), b2 + hstepB, voffB); PG8_STAGE(PG8_SA(0, 0), a2, voffA);
            PG8_WAIT_V(8); PG8_WAIT_L(0); PG8_BAR; PG8_MMA(1, 0, At, B0); PG8_MMA(1, 1, At, B1); PG8_BAR; PG8_SCHED;
            PG8_LDB(B0, 1, 0); PG8_LDB(B1, 1, 1); PG8_SCHED; PG8_LDA(At, 1, 0); PG8_STAGE(PG8_SA(0, 1), a2 + hstepA, voffA);
            PG8_WAIT_V(8); PG8_WAIT_L(0); PG8_BAR; PG8_MMA(0, 0, At, B0); PG8_MMA(0, 1, At, B1); PG8_BAR; PG8_SCHED;
            PG8_LDA(At, 1, 1); PG8_STAGE(PG8_SB(1, 0), b3, voffB); PG8_STAGE(PG8_SB(1, 1), b3 + hstepB, voffB); PG8_STAGE(PG8_SA(1, 0), a3, voffA);
            PG8_WAIT_V(8); PG8_WAIT_L(0); PG8_BAR; PG8_MMA(1, 0, At, B0); PG8_MMA(1, 1, At, B1); PG8_BAR; PG8_SCHED;
            } else {
            PG8_LDB(B0, 0, 0); PG8_SCHED; PG8_LDA(At, 0, 0); PG8_STAGE(PG8_SA(1, 1), a1 + hstepA, voffA);
            PG8_WAIT_L(8); PG8_BAR; PG8_WAIT_L(0); PG8_MMA(0, 0, At, B0); PG8_BAR; PG8_SCHED;
            PG8_LDB(B1, 0, 1); PG8_STAGE(PG8_SB(0, 0), b2, voffB);
            PG8_BAR; PG8_WAIT_L(0); PG8_MMA(0, 1, At, B1); PG8_BAR;
            PG8_LDA(At, 0, 1); PG8_STAGE(PG8_SA(0, 0), a2, voffA);
            PG8_BAR; PG8_WAIT_L(0); PG8_MMA(1, 0, At, B0); PG8_BAR; PG8_SCHED;
            PG8_STAGE(PG8_SB(0, 1), b2 + hstepB, voffB);
            PG8_WAIT_V(6); PG8_BAR; PG8_MMA(1, 1, At, B1); PG8_BAR;
            PG8_LDB(B0, 1, 0); PG8_SCHED; PG8_LDA(At, 1, 0); PG8_STAGE(PG8_SA(0, 1), a2 + hstepA, voffA);
            PG8_WAIT_L(8); PG8_BAR; PG8_WAIT_L(0); PG8_MMA(0, 0, At, B0); PG8_BAR; PG8_SCHED;
            PG8_LDB(B1, 1, 1); PG8_STAGE(PG8_SB(1, 0), b3, voffB);
            PG8_BAR; PG8_WAIT_L(0); PG8_MMA(0, 1, At, B1); PG8_BAR;
            PG8_LDA(At, 1, 1); PG8_STAGE(PG8_SA(1, 0), a3, voffA);
            PG8_BAR; PG8_WAIT_L(0); PG8_MMA(1, 0, At, B0); PG8_BAR; PG8_SCHED;
            PG8_STAGE(PG8_SB(1, 1), b3 + hstepB, voffB);
            PG8_WAIT_V(6); PG8_BAR; PG8_MMA(1, 1, At, B1); PG8_BAR;
            }
        }
        if constexpr (ALIGN_EPI) { if (wr == 0) PG8_BAR; }
        if constexpr (!Epi::AFTER_DRAIN) { E(acc, cur, wr, wc, fr, fq); S.done(cur); }
        if (!has_next) break;
#pragma unroll
        for (int a = 0; a < 2; ++a)
#pragma unroll
            for (int b = 0; b < 2; ++b)
#pragma unroll
                for (int m = 0; m < 4; ++m)
#pragma unroll
                    for (int n = 0; n < 2; ++n) acc[a][b][m][n] = (f32x4){0.f, 0.f, 0.f, 0.f};
        cur = nxt; cA = nA; cB = nB; ++ui;
        if constexpr (ALIGN_EPI) { if (wr == 1) PG8_BAR; }
    }
    PG8_WAIT_V(0);
    if constexpr (!ALIGN_EPI) { if (wr == 0) PG8_BAR; }
    PG8_BAR;
    if constexpr (Epi::AFTER_DRAIN) { E.fused(acc, cur, wr, wc, fr, fq, lds, wid, lane); S.done(cur); }
#undef PG8_SA
#undef PG8_SB
#undef PG8_STAGE
#undef PG8_LDA
#undef PG8_LDB
#undef PG8_MMA
#undef PG8_WAIT_V
#undef PG8_WAIT_L
#undef PG8_BAR
#undef PG8_SCHED
}
}

namespace pg8 {
__device__ __forceinline__ float bfu_lo(unsigned w) { return __builtin_bit_cast(float, w << 16); }
__device__ __forceinline__ float bfu_hi(unsigned w) { return __builtin_bit_cast(float, w & 0xffff0000u); }
__device__ __forceinline__ float sigmoidf_(float x) { return 1.f / (1.f + __expf(-x)); }

template <int ACT  > struct EpiStore {
    static constexpr bool PERM = true, AFTER_DRAIN = false;
    bf16_t* O; int ldc; const float* rss;
    __device__ __forceinline__ void operator()(const f32x4 (&acc)[2][2][4][2], const Unit& u, int wr, int wc, int fr, int fq) const {
        const int row0 = u.pm * BM + wr * 64 + fr, col0 = u.pn * BM + wc * 32 + 8 * fq;
#pragma unroll
        for (int ai = 0; ai < 2; ++ai)
#pragma unroll
            for (int m = 0; m < 4; ++m) { bf16_t* rowp = O + (size_t)(row0 + ai * HALF + m * 16) * ldc + col0;
                float rs = 1.f; if (rss) rs = rsqrtf(rss[row0 + ai * HALF + m * 16] * (1.f / 1024.f) + 1e-6f);
#pragma unroll
                for (int bj = 0; bj < 2; ++bj) { f32x4 v0 = acc[ai][bj][m][0] * rs, v1 = acc[ai][bj][m][1] * rs;
                    if (ACT == 1) {
#pragma unroll
                        for (int j = 0; j < 4; ++j) { v0[j] = sigmoidf_(v0[j]); v1[j] = sigmoidf_(v1[j]); } }
                    u32x4 w; w.x = cvt_pk_bf16(v0[0], v0[1]); w.y = cvt_pk_bf16(v0[2], v0[3]); w.z = cvt_pk_bf16(v1[0], v1[1]); w.w = cvt_pk_bf16(v1[2], v1[3]);
                    *(u32x4*)(rowp + bj * HALF) = w; } }
    }
};

struct EpiGateAcc {
    static constexpr bool PERM = true, AFTER_DRAIN = false;
    const bf16_t* GS; bf16_t* MG; int ld; int first; const float* ssq;
    __device__ __forceinline__ void operator()(const f32x4 (&acc)[2][2][4][2], const Unit& u, int wr, int wc, int fr, int fq) const {
        const int row0 = u.pm * BM + wr * 64 + fr, col0 = u.pn * BM + wc * 32 + 8 * fq;
#pragma unroll
        for (int ai = 0; ai < 2; ++ai)
#pragma unroll
            for (int m = 0; m < 4; ++m) { const int row = row0 + ai * HALF + m * 16; const size_t ro = (size_t)row * ld + col0;
                float rs = 1.f;
                if (ssq) { float s = 0.f;
#pragma unroll
                    for (int q = 0; q < 8; ++q) { const f32x4 v = *(const f32x4*)(ssq + (size_t)row * 32 + 4 * q); s += (v[0] + v[1]) + (v[2] + v[3]); }
                    rs = rsqrtf(s * (1.f / 512.f) + 1e-6f); }
#pragma unroll
                for (int bj = 0; bj < 2; ++bj) { const f32x4 a0 = acc[ai][bj][m][0], a1 = acc[ai][bj][m][1];
                    const u32x4 g = *(const u32x4*)(GS + ro + bj * HALF);
                    u32x4 o = (u32x4){0u, 0u, 0u, 0u}; if (!first) o = *(const u32x4*)(MG + ro + bj * HALF);
                    float r[8];
                    r[0] = bfu_lo(o.x) + bfu_lo(g.x) * a0[0] * rs; r[1] = bfu_hi(o.x) + bfu_hi(g.x) * a0[1] * rs;
                    r[2] = bfu_lo(o.y) + bfu_lo(g.y) * a0[2] * rs; r[3] = bfu_hi(o.y) + bfu_hi(g.y) * a0[3] * rs;
                    r[4] = bfu_lo(o.z) + bfu_lo(g.z) * a1[0] * rs; r[5] = bfu_hi(o.z) + bfu_hi(g.z) * a1[1] * rs;
                    r[6] = bfu_lo(o.w) + bfu_lo(g.w) * a1[2] * rs; r[7] = bfu_hi(o.w) + bfu_hi(g.w) * a1[3] * rs;
                    u32x4 w; w.x = cvt_pk_bf16(r[0], r[1]); w.y = cvt_pk_bf16(r[2], r[3]); w.z = cvt_pk_bf16(r[4], r[5]); w.w = cvt_pk_bf16(r[6], r[7]);
                    *(u32x4*)(MG + ro + bj * HALF) = w; } }
    }
};

struct EpiResid {
    static constexpr bool PERM = true, AFTER_DRAIN = false;
    const float* XI; float* XO; bf16_t* XB; float* rowss;
    __device__ __forceinline__ void operator()(const f32x4 (&acc)[2][2][4][2], const Unit& u, int wr, int wc, int fr, int fq) const {
        const int row0 = u.pm * BM + wr * 64 + fr, col0 = u.pn * BM + wc * 32 + 8 * fq;
#pragma unroll
        for (int ai = 0; ai < 2; ++ai)
#pragma unroll
            for (int m = 0; m < 4; ++m) { const int row = row0 + ai * HALF + m * 16; const size_t ro = (size_t)row * 1024 + col0; float sq = 0.f;
#pragma unroll
                for (int bj = 0; bj < 2; ++bj) {
                    const f32x4 y0 = *(const f32x4*)(XI + ro + bj * HALF) + acc[ai][bj][m][0], y1 = *(const f32x4*)(XI + ro + bj * HALF + 4) + acc[ai][bj][m][1];
                    *(f32x4*)(XO + ro + bj * HALF) = y0; *(f32x4*)(XO + ro + bj * HALF + 4) = y1;
                    if (XB) { u32x4 w; w.x = cvt_pk_bf16(y0[0], y0[1]); w.y = cvt_pk_bf16(y0[2], y0[3]); w.z = cvt_pk_bf16(y1[0], y1[1]); w.w = cvt_pk_bf16(y1[2], y1[3]); *(u32x4*)(XB + ro + bj * HALF) = w;
                        sq += ((y0[0] * y0[0] + y0[1] * y0[1]) + (y0[2] * y0[2] + y0[3] * y0[3])) + ((y1[0] * y1[0] + y1[1] * y1[1]) + (y1[2] * y1[2] + y1[3] * y1[3])); } }
                if (XB) { sq += __shfl_xor(sq, 16); sq += __shfl_xor(sq, 32); if (fq == 0) atomicAdd(rowss + row, sq); } }
    }
};

struct EpiSwiglu {
    static constexpr bool PERM = true, AFTER_DRAIN = false;
    bf16_t* H; int ldc; const float* rss;
    __device__ __forceinline__ void operator()(const f32x4 (&acc)[2][2][4][2], const Unit& u, int wr, int wc, int fr, int fq) const {
        const int row0 = u.pm * BM + wr * 64 + fr, col0 = u.pn * 128 + wc * 16 + 4 * fq;
#pragma unroll
        for (int ai = 0; ai < 2; ++ai)
#pragma unroll
            for (int m = 0; m < 4; ++m) { bf16_t* rowp = H + (size_t)(row0 + ai * HALF + m * 16) * ldc + col0;
                float rs = 1.f; if (rss) rs = rsqrtf(rss[row0 + ai * HALF + m * 16] * (1.f / 1024.f) + 1e-6f);
#pragma unroll
                for (int bj = 0; bj < 2; ++bj) { const f32x4 a = acc[ai][bj][m][0] * rs, b = acc[ai][bj][m][1] * rs; float r[4];
#pragma unroll
                    for (int j = 0; j < 4; ++j) r[j] = a[j] * sigmoidf_(a[j]) * b[j];
                    unsigned long long w = (unsigned long long)cvt_pk_bf16(r[0], r[1]) | ((unsigned long long)cvt_pk_bf16(r[2], r[3]) << 32);
                    *(unsigned long long*)(rowp + bj * 64) = w; } }
    }
};
}

typedef unsigned short bf16;
typedef float f32x4 __attribute__((ext_vector_type(4)));
typedef unsigned u32x4 __attribute__((ext_vector_type(4)));
typedef unsigned u32x2 __attribute__((ext_vector_type(2)));
#define LAS __attribute__((address_space(3)))
constexpr int NT = 16384, SEQL = 4096, DM = 1024, PW = 5120, INW = 10248, FFH = 2816;
constexpr float EPSN = 1e-6f;
constexpr size_t MiB = 1u << 20;
constexpr size_t WS_W = 0, WS_XN = 48 * MiB, WS_PROJ = 80 * MiB, WS_MISC = 240 * MiB, WS_VT = 248 * MiB, WS_WVT = 280 * MiB, WS_XCT = 284 * MiB, WS_SSQ32 = 308 * MiB, WS_END = 310 * MiB;
constexpr size_t W_IN = 0, W_G = W_IN + (size_t)5120 * 1024, W_B = W_G + (size_t)4096 * 1024, W_MO = W_B + (size_t)4 * 1024 * 512, W_XQ = W_MO + (size_t)1024 * 1024,
                 W_XKV = W_XQ + (size_t)512 * 1024, W_XO = W_XKV + (size_t)1024 * 1024, W_FI = W_XO + (size_t)1024 * 512, W_FO = W_FI + (size_t)5632 * 1024, W_TOT = W_FO + (size_t)1024 * 2816;
static_assert(W_TOT * 2 <= 48 * MiB, "weights fit");
constexpr size_t MS_DT = 0, MS_SSQ = 512 * 1024, MS_MN = 1 * MiB, MS_KV = 3 * MiB, MS_BAR = 4 * MiB, MS_VTX = 5 * MiB, MS_ROPE = 6 * MiB, MS_CNT = 7 * MiB;
constexpr int C_AQ = 0, C_AK = 512, C_AV = 1024, C_BQ = 1536, C_BK = 1792, C_BG = 2048, C_CQ = 2560, C_CK = 3072, C_DZ = 3584, C_DX = 4096;
constexpr int VT_C = 0, VT_B = 512;
constexpr int C_GS = 512, C_MG = 4096;
constexpr int LDS_BYTES = 147456;

__device__ __forceinline__ float bf2f(bf16 v) { return __builtin_bit_cast(float, (unsigned)v << 16); }
__device__ __forceinline__ float bflo(unsigned w) { return __builtin_bit_cast(float, w << 16); }
__device__ __forceinline__ float bfhi(unsigned w) { return __builtin_bit_cast(float, w & 0xffff0000u); }
__device__ __forceinline__ unsigned f2bf(float f) { unsigned u = __builtin_bit_cast(unsigned, f); return (u + 0x7fffu + ((u >> 16) & 1u)) >> 16; }
__device__ __forceinline__ unsigned pk2(float lo, float hi) { return f2bf(lo) | (f2bf(hi) << 16); }
__device__ __forceinline__ float wave_sum(float v) {
#pragma unroll
    for (int o = 1; o < 64; o <<= 1) v += __shfl_xor(v, o);
    return v;
}
__device__ __forceinline__ float siluf_(float x) { return x / (1.f + __expf(-x)); }
__device__ __forceinline__ void unpack8(const u32x4 w, float* f) { f[0] = bflo(w.x); f[1] = bfhi(w.x); f[2] = bflo(w.y); f[3] = bfhi(w.y); f[4] = bflo(w.z); f[5] = bfhi(w.z); f[6] = bflo(w.w); f[7] = bfhi(w.w); }

#ifndef PHMASK
#define PHMASK 0xFFFF
#endif
#ifndef DRYMASK
#define DRYMASK 0
#endif
#ifndef XSYNC
#define XSYNC 0
#endif
#ifndef REPMASK
#define REPMASK 0
#endif
struct Args { const float* in[24]; float* out; unsigned char* ws; int ph_lo, ph_hi; };
typedef const __attribute__((address_space(4))) Args* ArgP;
struct Ctx {
    unsigned char* ws;
    int tid, lane, wave, wg, nwg;
};

__device__ __forceinline__ void conv_w(const Ctx& c, unsigned char* lds_raw, const float* W, int srcN, int K, int Ndst, bf16* WT, int mode, int off, int rot, const float* gk = nullptr) {
    float* T = (float*)lds_raw;
    const int nb = Ndst / 64, kb = K / 64, tot = nb * kb, tid = c.tid;
    int start = c.wg - (rot % c.nwg); if (start < 0) start += c.nwg;
    for (int it = start; it < tot; it += c.nwg) {
        const int n0 = (it % nb) * 64, k0 = (it / nb) * 64;
        {   const int n4 = (tid & 15) * 4, n = n0 + n4;
            const int sc = mode == 0 ? off + n : (((n & 7) < 4) ? (n >> 3) * 4 : FFH + (n >> 3) * 4);
#pragma unroll
            for (int i = 0; i < 2; ++i) { const int kk = (tid >> 4) + 32 * i; f32x4 v = *(const f32x4*)(W + (size_t)(k0 + kk) * srcN + sc);
                if (gk) v = v * gk[k0 + kk];
                T[kk * 65 + n4] = v[0]; T[kk * 65 + n4 + 1] = v[1]; T[kk * 65 + n4 + 2] = v[2]; T[kk * 65 + n4 + 3] = v[3]; } }
        __syncthreads();
        {   const int n = tid >> 3, kc = (tid & 7) * 8; const float* tp = T + kc * 65 + n;
            u32x4 o; o.x = pk2(tp[0], tp[65]); o.y = pk2(tp[130], tp[195]); o.z = pk2(tp[260], tp[325]); o.w = pk2(tp[390], tp[455]);
            *(u32x4*)(WT + (size_t)(n0 + n) * K + k0 + kc) = o; }
        __syncthreads();
    }
}
__device__ __forceinline__ void convert_layer(const Ctx& c, ArgP A, unsigned char* lds_raw, int l) {
    bf16* Wb = (bf16*)(c.ws + WS_W);
    const float* w_in = A->in[3] + (size_t)l * DM * INW;
    conv_w(c, lds_raw, w_in, INW, 1024, 1536, Wb + W_IN, 0, 0, 0);
    conv_w(c, lds_raw, w_in, INW, 1024, 512, Wb + W_IN + (size_t)1536 * 1024, 0, 1536, 16);
    conv_w(c, lds_raw, w_in, INW, 1024, 512, Wb + W_IN + (size_t)2048 * 1024, 0, 2560, 80);
    conv_w(c, lds_raw, w_in, INW, 1024, 1024, Wb + W_IN + (size_t)2560 * 1024, 0, 3072, 144);
    conv_w(c, lds_raw, w_in, INW, 1024, 1536, Wb + W_IN + (size_t)3584 * 1024, 0, 4608, 0);
    conv_w(c, lds_raw, w_in, INW, 1024, 4096, Wb + W_G, 0, 6152, 0);
    conv_w(c, lds_raw, w_in, INW, 1024, 512, (bf16*)(c.ws + WS_WVT), 0, 4096, 192);
    conv_w(c, lds_raw, w_in, INW, 1024, 512, (bf16*)(c.ws + WS_WVT) + (size_t)512 * 1024, 0, 2048, 128);
    for (int i = 0; i < 4; ++i) conv_w(c, lds_raw, A->in[13] + ((size_t)l * 4 + i) * 512 * 1024, 1024, 512, 1024, Wb + W_B + (size_t)i * 1024 * 512, 0, 0, 32 * i);
    conv_w(c, lds_raw, A->in[14] + (size_t)l * 1024 * 1024, 1024, 1024, 1024, Wb + W_MO, 0, 0, 128);
    conv_w(c, lds_raw, A->in[17] + (size_t)l * 1024 * 512, 512, 1024, 512, Wb + W_XQ, 0, 0, 0, A->in[15] + (size_t)l * DM);
    conv_w(c, lds_raw, A->in[18] + (size_t)l * 1024 * 1024, 1024, 1024, 1024, Wb + W_XKV, 0, 0, 128);
    conv_w(c, lds_raw, A->in[19] + (size_t)l * 512 * 1024, 1024, 512, 1024, Wb + W_XO, 0, 0, 0);
    conv_w(c, lds_raw, A->in[21] + (size_t)l * 1024 * 5632, 5632, 1024, 5632, Wb + W_FI, 1, 0, 128, A->in[20] + (size_t)l * DM);
    conv_w(c, lds_raw, A->in[22] + (size_t)l * FFH * 1024, 1024, FFH, 1024, Wb + W_FO, 0, 0, 0);
}

__device__ __forceinline__ void norm_rows(const Ctx& c, const float* X, const float* g, bf16* out, int nrows, const float* Wdt, float* dt_out) {
    const int gw = c.wg * 8 + c.wave, ngw = c.nwg * 8, lane = c.lane;
    f32x4 gv[4];
#pragma unroll
    for (int j = 0; j < 4; ++j) gv[j] = *((const f32x4*)g + lane + 64 * j);
    for (int row = gw; row < nrows; row += ngw) {
        const f32x4* xr = (const f32x4*)(X + (size_t)row * DM) + lane;
        f32x4 v[4]; float s = 0.f;
#pragma unroll
        for (int j = 0; j < 4; ++j) { v[j] = xr[64 * j]; s += (v[j].x * v[j].x + v[j].y * v[j].y) + (v[j].z * v[j].z + v[j].w * v[j].w); }
        const float rs = rsqrtf(wave_sum(s) * (1.f / DM) + EPSN);
        unsigned long long* o8 = (unsigned long long*)(out + (size_t)row * DM) + lane;
#pragma unroll
        for (int j = 0; j < 4; ++j) { v[j] = v[j] * rs * gv[j]; o8[64 * j] = (unsigned long long)pk2(v[j].x, v[j].y) | ((unsigned long long)pk2(v[j].z, v[j].w) << 32); }
        if (Wdt) {
            f32x4 a0 = (f32x4){0.f, 0.f, 0.f, 0.f}, a1 = a0;
#pragma unroll
            for (int j = 0; j < 4; ++j)
#pragma unroll
                for (int e = 0; e < 4; ++e) { const int k = 4 * lane + 256 * j + e; const float* wp = Wdt + k * 8;
                    const f32x4 w0 = *(const f32x4*)wp, w1 = *(const f32x4*)(wp + 4); a0 += w0 * v[j][e]; a1 += w1 * v[j][e]; }
#pragma unroll
            for (int e = 0; e < 4; ++e) { a0[e] = wave_sum(a0[e]); a1[e] = wave_sum(a1[e]); }
            if (lane == 0) { *(f32x4*)(dt_out + (size_t)row * 8) = a0; *(f32x4*)(dt_out + (size_t)row * 8 + 4) = a1; }
        }
    }
}
__device__ __forceinline__ void final_norm(const Ctx& c, float* X, const float* g) {
    const int gw = c.wg * 8 + c.wave, ngw = c.nwg * 8, lane = c.lane;
    for (int row = gw; row < NT; row += ngw) {
        f32x4* xr = (f32x4*)(X + (size_t)row * DM) + lane;
        f32x4 v[4]; float s = 0.f;
#pragma unroll
        for (int j = 0; j < 4; ++j) { v[j] = xr[64 * j]; s += (v[j].x * v[j].x + v[j].y * v[j].y) + (v[j].z * v[j].z + v[j].w * v[j].w); }
        const float rs = rsqrtf(wave_sum(s) * (1.f / DM) + EPSN);
#pragma unroll
        for (int j = 0; j < 4; ++j) xr[64 * j] = v[j] * rs * *((const f32x4*)g + lane + 64 * j);
    }
}

#define OSM_UPDATE(sc, NV, vexpr) do { float _p; if ((sc) > mrun) { const float _r = __expf(mrun - (sc)); lrun *= _r; _Pragma("unroll") for (int _i = 0; _i < NV; ++_i) o[_i] *= _r; mrun = (sc); _p = 1.f; } \
    else _p = __expf((sc) - mrun); lrun += _p; _Pragma("unroll") for (int _i = 0; _i < NV; ++_i) o[_i] += _p * (vexpr); } while (0)

#define WG_BARRIER() asm volatile("s_waitcnt lgkmcnt(0)\n\ts_barrier" ::: "memory")
typedef short bf16x8_t __attribute__((ext_vector_type(8)));
typedef short s16x4_t __attribute__((ext_vector_type(4)));
typedef float f32x2_t __attribute__((ext_vector_type(2)));
typedef __bf16 bf16x2_t __attribute__((ext_vector_type(2)));
#define MFMA16(a, b, c) __builtin_amdgcn_mfma_f32_16x16x32_bf16((a), (b), (c), 0, 0, 0)
__device__ __forceinline__ unsigned cvtpk(float lo, float hi) { f32x2_t v = {lo, hi}; bf16x2_t b = __builtin_convertvector(v, bf16x2_t); return __builtin_bit_cast(unsigned, b); }
__device__ __forceinline__ bf16x8_t pack8(const float* p) { u32x4 w; w.x = cvtpk(p[0], p[1]); w.y = cvtpk(p[2], p[3]); w.z = cvtpk(p[4], p[5]); w.w = cvtpk(p[6], p[7]); return __builtin_bit_cast(bf16x8_t, w); }
__device__ __forceinline__ float ex2(float x) { return __builtin_amdgcn_exp2f(x); }

__device__ __forceinline__ void mixer_c_mfma(const Ctx& c, ArgP A, unsigned char* lds_raw, int l, int dry, unsigned* cnt) {
    bf16* P = (bf16*)(c.ws + WS_PROJ); const bf16* VT = (const bf16*)(c.ws + WS_VT) + (size_t)VT_C * NT;
    unsigned char* sK = lds_raw;
    unsigned char* sV = lds_raw + 64 * 272;
    const float* lp = A->in[5] + (size_t)l * 256;
    float d0 = 0.f, d1 = 0.f;
    for (int i = 0; i < 64; ++i) { d0 += lp[i] * lp[64 + i]; d1 += lp[128 + i] * lp[192 + i]; }
    const float lam_init = 0.8f - 0.6f * expf(-0.3f * (float)l);
    const float lam = expf(d0) - expf(d1) + lam_init;
    const float* sg = A->in[6] + (size_t)l * 128;
    const int tid = c.tid, lane = c.lane, wave = c.wave, fr = lane & 15, fq = lane >> 4;
    constexpr float C2 = 0.125f * 1.4426950408889634f;
    volatile int* sIdx = (volatile int*)(lds_raw + 73728);
    for (;;) {
        __syncthreads();
        if (tid == 0) *sIdx = (int)atomicAdd(cnt, 1u);
        __syncthreads();
        const int u0 = *sIdx; if (u0 >= 512) break;
        const int bh = u0 & 15, qblk = 31 - (u0 >> 4);
        const int b = bh >> 2, h = bh & 3;
        const int qs = qblk * 128 + wave * 16 + fr;
        bf16* qp = P + ((size_t)b * SEQL + qs) * PW + C_CQ + h * 128;
        bf16x8_t qf[2][2];
#pragma unroll
        for (int c2 = 0; c2 < 2; ++c2)
#pragma unroll
            for (int ks = 0; ks < 2; ++ks) qf[c2][ks] = *(const bf16x8_t*)(qp + c2 * 64 + ks * 32 + fq * 8);
        f32x4 oacc[2][8];
#pragma unroll
        for (int c2 = 0; c2 < 2; ++c2)
#pragma unroll
            for (int eb = 0; eb < 8; ++eb) oacc[c2][eb] = (f32x4){0.f, 0.f, 0.f, 0.f};
        float mrun[2] = {-1e30f, -1e30f}, lrun[2] = {0.f, 0.f};
        const int qmax_w = qblk * 128 + wave * 16 + 15;
        const int ntile = 2 * (qblk + 1);
        const size_t rowb0 = (size_t)b * SEQL;
        u32x4 pk[2], pv[2];
#pragma unroll
        for (int i = 0; i < 2; ++i) { const int ch = tid + 512 * i;
            pk[i] = *(const u32x4*)(P + (rowb0 + (ch >> 4)) * PW + C_CK + h * 128 + (ch & 15) * 8);
            pv[i] = *(const u32x4*)(VT + (size_t)(h * 128 + (ch >> 3)) * NT + rowb0 + (ch & 7) * 8); }
        for (int kt = 0; kt < ntile; ++kt) {
            unsigned char* bK = sK + (kt & 1) * 36864; unsigned char* bV = bK + 64 * 272;
#pragma unroll
            for (int i = 0; i < 2; ++i) { const int ch = tid + 512 * i;
                *(u32x4*)(bK + (ch >> 4) * 272 + (ch & 15) * 16) = pk[i]; *(u32x4*)(bV + (ch >> 3) * 144 + (ch & 7) * 16) = pv[i]; }
            if (kt + 1 < ntile) { const size_t rowb = rowb0 + (kt + 1) * 64;
#pragma unroll
                for (int i = 0; i < 2; ++i) { const int ch = tid + 512 * i;
                    pk[i] = *(const u32x4*)(P + (rowb + (ch >> 4)) * PW + C_CK + h * 128 + (ch & 15) * 8);
                    pv[i] = *(const u32x4*)(VT + (size_t)(h * 128 + (ch >> 3)) * NT + rowb + (ch & 7) * 8); } }
            WG_BARRIER();
#pragma unroll
            for (int kb2 = 0; kb2 < 2; ++kb2) {
                const int k0 = kt * 64 + kb2 * 32;
                if (k0 > qmax_w) continue;
                bf16x8_t vf[8];
#pragma unroll
                for (int eb = 0; eb < 8; ++eb) { const unsigned char* vp = bV + (eb * 16 + fr) * 144 + (kb2 * 32 + 4 * fq) * 2;
                    const s16x4_t lo = *(const s16x4_t*)vp, hi = *(const s16x4_t*)(vp + 32); vf[eb] = __builtin_shufflevector(lo, hi, 0, 1, 2, 3, 4, 5, 6, 7); }
#pragma unroll
                for (int c2 = 0; c2 < 2; ++c2) {
                    f32x4 s0 = (f32x4){0.f, 0.f, 0.f, 0.f}, s1 = s0;
#pragma unroll
                    for (int ks = 0; ks < 2; ++ks) { const unsigned char* kp = bK + (kb2 * 32 + fr) * 272 + (c2 * 64 + ks * 32 + fq * 8) * 2;
                        const bf16x8_t ka = *(const bf16x8_t*)kp, kb = *(const bf16x8_t*)(kp + 16 * 272);
                        s0 = MFMA16(ka, qf[c2][ks], s0); s1 = MFMA16(kb, qf[c2][ks], s1); }
                    float sc[8];
                    if (k0 + 31 <= qblk * 128 + wave * 16) {
#pragma unroll
                        for (int j = 0; j < 4; ++j) { sc[j] = s0[j] * C2; sc[4 + j] = s1[j] * C2; }
                    } else {
#pragma unroll
                        for (int j = 0; j < 4; ++j) { const int kp0 = k0 + 4 * fq + j; sc[j] = (kp0 <= qs) ? s0[j] * C2 : -1e30f; sc[4 + j] = (kp0 + 16 <= qs) ? s1[j] * C2 : -1e30f; }
                    }
                    float mx = fmaxf(fmaxf(fmaxf(sc[0], sc[1]), fmaxf(sc[2], sc[3])), fmaxf(fmaxf(sc[4], sc[5]), fmaxf(sc[6], sc[7])));
                    mx = fmaxf(mx, __shfl_xor(mx, 16)); mx = fmaxf(mx, __shfl_xor(mx, 32));
                    const float mnew = fmaxf(mrun[c2], mx); const float alpha = ex2(mrun[c2] - mnew); mrun[c2] = mnew;
                    float p[8], ps = 0.f;
#pragma unroll
                    for (int i = 0; i < 8; ++i) { p[i] = ex2(sc[i] - mnew); ps += p[i]; }
                    lrun[c2] = lrun[c2] * alpha + ps;
                    const bf16x8_t pf = pack8(p);
                    if (__any(alpha != 1.f)) {
#pragma unroll
                        for (int eb = 0; eb < 8; ++eb) oacc[c2][eb] = oacc[c2][eb] * alpha; }
#pragma unroll
                    for (int eb = 0; eb < 8; ++eb) oacc[c2][eb] = MFMA16(vf[eb], pf, oacc[c2][eb]);
                }
            }
        }
        float linv[2];
#pragma unroll
        for (int c2 = 0; c2 < 2; ++c2) { float lt = lrun[c2]; lt += __shfl_xor(lt, 16); lt += __shfl_xor(lt, 32); linv[c2] = 1.f / lt; }
        float ss = 0.f;
#pragma unroll
        for (int eb = 0; eb < 8; ++eb) { oacc[0][eb] = oacc[0][eb] * linv[0] - oacc[1][eb] * (lam * linv[1]);
            ss += (oacc[0][eb][0] * oacc[0][eb][0] + oacc[0][eb][1] * oacc[0][eb][1]) + (oacc[0][eb][2] * oacc[0][eb][2] + oacc[0][eb][3] * oacc[0][eb][3]); }
        ss += __shfl_xor(ss, 16); ss += __shfl_xor(ss, 32);
        const float rs = rsqrtf(ss * (1.f / 128.f) + EPSN) * (1.f - lam_init);
#pragma unroll
        for (int eb = 0; eb < 8; ++eb) { const int e0 = eb * 16 + 4 * fq; const f32x4 g4 = *(const f32x4*)(sg + e0);
            const unsigned lo = cvtpk(oacc[0][eb][0] * rs * g4[0], oacc[0][eb][1] * rs * g4[1]), hi = cvtpk(oacc[0][eb][2] * rs * g4[2], oacc[0][eb][3] * rs * g4[3]);
            if (!dry) *(unsigned long long*)(qp + e0) = (unsigned long long)lo | ((unsigned long long)hi << 32); }
    }
    __syncthreads();
}

typedef short v4i16_t __attribute__((ext_vector_type(4)));
__device__ __forceinline__ s16x4_t lds_tr16(const LAS unsigned char* p) { return __builtin_bit_cast(s16x4_t, __builtin_amdgcn_ds_read_tr16_b64_v4i16((LAS v4i16_t*)p)); }
__device__ __forceinline__ void mixer_a_mfma(const Ctx& c, unsigned char* lds_raw, int dry, unsigned* cnt) {
    bf16* P = (bf16*)(c.ws + WS_PROJ);
    const int lane = c.lane, fr = lane & 15, fq = lane >> 4;
    LAS unsigned char* wl = (LAS unsigned char*)lds_raw + c.wave * 4608;
    const LAS unsigned char* trp = wl + (4 * fq + (fr >> 2)) * 144 + (fr & 3) * 8;
    constexpr float C2 = 0.125f * 1.4426950408889634f;
    for (;;) {
        int g = 0; if (lane == 0) g = (int)atomicAdd(cnt, 1u); g = __shfl(g, 0); if (g >= 8192) break;
        const int r16 = g & 15, h = (g >> 4) & 7, blk = (g >> 7) & 15, b = g >> 11;
        const int sbase = blk * 256 + r16, qs = sbase + 16 * fr;
        const size_t tb = (size_t)b * SEQL;
        bf16* qp = P + (tb + qs) * PW + C_AQ + h * 64;
        bf16x8_t qf[2];
#pragma unroll
        for (int ks = 0; ks < 2; ++ks) qf[ks] = *(const bf16x8_t*)(qp + ks * 32 + fq * 8);
        f32x4 oacc[4];
#pragma unroll
        for (int eb = 0; eb < 4; ++eb) oacc[eb] = (f32x4){0.f, 0.f, 0.f, 0.f};
        float mrun = -1e30f, lrun = 0.f;
        for (int p = 0; p < 3; ++p) {
            const int sh = 2 * p, d = 1 << sh, qm = (16 * fr) >> sh, mhi = 240 >> sh;
            for (int m0 = -128; m0 <= mhi; m0 += 32) {
                if (sbase + d * (m0 + 31) < 0) continue;
                u32x4 vr[4];
#pragma unroll
                for (int i = 0; i < 4; ++i) { const int cch = lane + 64 * i, rr = cch >> 3, part = cch & 7; int tk = sbase + d * (m0 + rr); tk = min(max(tk, 0), SEQL - 1);
                    vr[i] = *(const u32x4*)(P + (tb + tk) * PW + C_AV + h * 64 + part * 8); }
                int tk0 = sbase + d * (m0 + fr), tk1 = tk0 + 16 * d;
                tk0 = min(max(tk0, 0), SEQL - 1); tk1 = min(max(tk1, 0), SEQL - 1);
                const bf16* k0p = P + (tb + tk0) * PW + C_AK + h * 64 + fq * 8; const bf16* k1p = P + (tb + tk1) * PW + C_AK + h * 64 + fq * 8;
                f32x4 s0 = (f32x4){0.f, 0.f, 0.f, 0.f}, s1 = s0;
#pragma unroll
                for (int ks = 0; ks < 2; ++ks) { const bf16x8_t ka = *(const bf16x8_t*)(k0p + ks * 32), kb = *(const bf16x8_t*)(k1p + ks * 32);
                    s0 = MFMA16(ka, qf[ks], s0); s1 = MFMA16(kb, qf[ks], s1); }
#pragma unroll
                for (int i = 0; i < 4; ++i) { const int cch = lane + 64 * i, rr = cch >> 3, part = cch & 7; *(LAS u32x4*)(wl + rr * 144 + part * 16) = vr[i]; }
                float sc[8]; bool vis[8];
#pragma unroll
                for (int j = 0; j < 4; ++j) { const int m = m0 + 4 * fq + j; const int dj0 = qm - m, dj1 = dj0 - 16; const int t0 = sbase + d * m, t1 = t0 + 16 * d;
                    vis[j] = (dj0 >= 0) && (dj0 <= 128) && (t0 >= 0); vis[4 + j] = (dj1 >= 0) && (dj1 <= 128) && (t1 >= 0);
                    sc[j] = vis[j] ? s0[j] * C2 : -1e30f; sc[4 + j] = vis[4 + j] ? s1[j] * C2 : -1e30f; }
                float mx = fmaxf(fmaxf(fmaxf(sc[0], sc[1]), fmaxf(sc[2], sc[3])), fmaxf(fmaxf(sc[4], sc[5]), fmaxf(sc[6], sc[7])));
                mx = fmaxf(mx, __shfl_xor(mx, 16)); mx = fmaxf(mx, __shfl_xor(mx, 32));
                const float mnew = fmaxf(mrun, mx); const float alpha = ex2(mrun - mnew); mrun = mnew;
                float pr[8], ps = 0.f;
#pragma unroll
                for (int i = 0; i < 8; ++i) { pr[i] = vis[i] ? ex2(sc[i] - mnew) : 0.f; ps += pr[i]; }
                lrun = lrun * alpha + ps;
                const bf16x8_t pf = pack8(pr);
#pragma unroll
                for (int eb = 0; eb < 4; ++eb) { const s16x4_t lo = lds_tr16(trp + eb * 32), hi = lds_tr16(trp + 16 * 144 + eb * 32);
                    oacc[eb] = oacc[eb] * alpha; oacc[eb] = MFMA16(__builtin_shufflevector(lo, hi, 0, 1, 2, 3, 4, 5, 6, 7), pf, oacc[eb]); }
            }
        }
        float lt = lrun; lt += __shfl_xor(lt, 16); lt += __shfl_xor(lt, 32); const float linv = 1.f / lt;
#pragma unroll
        for (int eb = 0; eb < 4; ++eb) { const unsigned lo = cvtpk(oacc[eb][0] * linv, oacc[eb][1] * linv), hi = cvtpk(oacc[eb][2] * linv, oacc[eb][3] * linv);
            if (!dry) *(unsigned long long*)(qp + eb * 16 + 4 * fq) = (unsigned long long)lo | ((unsigned long long)hi << 32); }
    }
}

struct BLoad { u32x4 x0, x1; f32x4 rp[4]; bf16x8_t vf[2]; s16x4_t vl[2], vh[2]; u32x2 gt[4]; };
__device__ __forceinline__ void b_issue(BLoad& L, const bf16* P, const float* rope, const bf16* vrow, int b, int h, int ch, int tid, int w, int fr, int fq) {
    const int s0 = ch * 64; const size_t t0 = (size_t)b * SEQL + s0;
    const int which = tid >> 8, tk = (tid >> 2) & 63, c4 = tid & 3;
    const bf16* src = P + (t0 + tk) * PW + (which ? C_BK : C_BQ) + h * 64 + 8 * c4;
    L.x0 = *(const u32x4*)src; L.x1 = *(const u32x4*)(src + 32);
    const float* rp = rope + ((size_t)(s0 + tk) * 32 + 8 * c4) * 2;
#pragma unroll
    for (int q = 0; q < 4; ++q) L.rp[q] = *(const f32x4*)(rp + 4 * q);
#pragma unroll
    for (int ks = 0; ks < 2; ++ks) { L.vf[ks] = *(const bf16x8_t*)(vrow + s0 + ks * 32 + fq * 8); L.vl[ks] = *(const s16x4_t*)(vrow + s0 + ks * 32 + 4 * fq); L.vh[ks] = *(const s16x4_t*)(vrow + s0 + ks * 32 + 16 + 4 * fq); }
#pragma unroll
    for (int qb = 0; qb < 4; ++qb) L.gt[qb] = *(const u32x2*)(P + (t0 + qb * 16 + fr) * PW + C_BG + h * 128 + 16 * w + 4 * fq);
}
__device__ __forceinline__ void mixer_b_mfma(const Ctx& c, ArgP A, unsigned char* lds_raw, int l, int unit, int dry) {
    bf16* P = (bf16*)(c.ws + WS_PROJ); const bf16* VTb = (const bf16*)(c.ws + WS_VT) + (size_t)VT_B * NT;
    const float* rope = (const float*)(c.ws + WS_MISC + MS_ROPE);
    unsigned char* sQ = lds_raw;
    unsigned char* sK = lds_raw + 9216;
    unsigned char* sKT = lds_raw + 18432;
    unsigned char* sP = lds_raw + 27648;
    float* sSt = (float*)(lds_raw + 35840);
    const int b = unit >> 2, h = unit & 3, tid = c.tid, lane = c.lane, w = c.wave, fr = lane & 15, fq = lane >> 4;
    const float lg = log2f(1.f - exp2f(-5.f - (float)h));
    const float* gn = A->in[4] + (size_t)l * 512 + h * 128;
    f32x4 R[4];
#pragma unroll
    for (int i = 0; i < 4; ++i) R[i] = (f32x4){0.f, 0.f, 0.f, 0.f};
    const bf16* vrow = VTb + (size_t)(h * 128 + 16 * w + fr) * NT + (size_t)b * SEQL;
    const int which = tid >> 8, tk_s = (tid >> 2) & 63, c4 = tid & 3;
    BLoad nx; b_issue(nx, P, rope, vrow, b, h, 0, tid, w, fr, fq);
    for (int ch = 0; ch < 64; ++ch) {
        const int s0 = ch * 64; const size_t t0 = (size_t)b * SEQL + s0;
        const BLoad cu = nx;
        {
            float xa[8], xb[8], r1[8], r2[8]; unpack8(cu.x0, xa); unpack8(cu.x1, xb);
#pragma unroll
            for (int e = 0; e < 8; ++e) { const float cs = cu.rp[e >> 1][(e & 1) * 2], sn = cu.rp[e >> 1][(e & 1) * 2 + 1]; r1[e] = xa[e] * cs - xb[e] * sn; r2[e] = xa[e] * sn + xb[e] * cs; }
            if (which == 0) { *(bf16x8_t*)(sQ + tk_s * 144 + c4 * 16) = pack8(r1); *(bf16x8_t*)(sQ + tk_s * 144 + 64 + c4 * 16) = pack8(r2); }
            else {
#pragma unroll
                for (int e = 0; e < 8; ++e) { r1[e] *= 0.125f; r2[e] *= 0.125f; }
                *(bf16x8_t*)(sK + tk_s * 144 + c4 * 16) = pack8(r1); *(bf16x8_t*)(sK + tk_s * 144 + 64 + c4 * 16) = pack8(r2);
                const float dk = ex2((float)(63 - tk_s) * lg);
#pragma unroll
                for (int e = 0; e < 8; ++e) { *(bf16*)(sKT + (8 * c4 + e) * 144 + tk_s * 2) = (bf16)f2bf(r1[e] * dk); *(bf16*)(sKT + (32 + 8 * c4 + e) * 144 + tk_s * 2) = (bf16)f2bf(r2[e] * dk); } }
        }
        if (ch + 1 < 64) b_issue(nx, P, rope, vrow, b, h, ch + 1, tid, w, fr, fq);
        WG_BARRIER();
        if (w < 6) {
            const int qb = (w == 0) ? 0 : (w == 1) ? 1 : (w < 4) ? 2 : 3, kp = (w == 3 || w == 5) ? 1 : 0;
            f32x4 sa = (f32x4){0.f, 0.f, 0.f, 0.f}, sb = sa;
            const bool two = (2 * kp + 1) <= qb;
#pragma unroll
            for (int ks = 0; ks < 2; ++ks) { const bf16x8_t qf = *(const bf16x8_t*)(sQ + (qb * 16 + fr) * 144 + (ks * 32 + fq * 8) * 2);
                const bf16x8_t ka = *(const bf16x8_t*)(sK + (kp * 32 + fr) * 144 + (ks * 32 + fq * 8) * 2);
                sa = MFMA16(ka, qf, sa);
                if (two) { const bf16x8_t kb = *(const bf16x8_t*)(sK + (kp * 32 + 16 + fr) * 144 + (ks * 32 + fq * 8) * 2); sb = MFMA16(kb, qf, sb); } }
            float p[8]; const int qi = qb * 16 + fr;
#pragma unroll
            for (int j = 0; j < 4; ++j) { const int k0 = kp * 32 + 4 * fq + j, k1 = k0 + 16;
                p[j] = (k0 <= qi) ? sa[j] * ex2((float)(qi - k0) * lg) : 0.f; p[4 + j] = (k1 <= qi) ? sb[j] * ex2((float)(qi - k1) * lg) : 0.f; }
            *(bf16x8_t*)(sP + (qb * 2 + kp) * 1024 + lane * 16) = pack8(p);
        }
        f32x4 acc[4];
        {
            bf16x8_t Rop[2];
#pragma unroll
            for (int ks = 0; ks < 2; ++ks) { float t8[8];
#pragma unroll
                for (int j = 0; j < 4; ++j) { t8[j] = R[2 * ks][j]; t8[4 + j] = R[2 * ks + 1][j]; }
                Rop[ks] = pack8(t8); }
#pragma unroll
            for (int qb = 0; qb < 4; ++qb) { acc[qb] = (f32x4){0.f, 0.f, 0.f, 0.f};
#pragma unroll
                for (int ks = 0; ks < 2; ++ks) { const unsigned char* qp = sQ + (qb * 16 + fr) * 144 + (ks * 32 + 4 * fq) * 2;
                    const s16x4_t lo = *(const s16x4_t*)qp, hi = *(const s16x4_t*)(qp + 32);
                    acc[qb] = MFMA16(Rop[ks], __builtin_shufflevector(lo, hi, 0, 1, 2, 3, 4, 5, 6, 7), acc[qb]); }
                acc[qb] = acc[qb] * ex2((float)(qb * 16 + fr + 1) * lg); }
            f32x4 kvn[4];
#pragma unroll
            for (int db = 0; db < 4; ++db) kvn[db] = (f32x4){0.f, 0.f, 0.f, 0.f};
#pragma unroll
            for (int ks = 0; ks < 2; ++ks) {
#pragma unroll
                for (int db = 0; db < 4; ++db) { const bf16x8_t kt = *(const bf16x8_t*)(sKT + (db * 16 + fr) * 144 + (ks * 32 + fq * 8) * 2); kvn[db] = MFMA16(kt, cu.vf[ks], kvn[db]); } }
            const float g64 = ex2(64.f * lg);
#pragma unroll
            for (int db = 0; db < 4; ++db) R[db] = R[db] * g64 + kvn[db];
        }
        WG_BARRIER();
#pragma unroll
        for (int qb = 0; qb < 4; ++qb)
#pragma unroll
            for (int kp = 0; kp < 2; ++kp) { if (2 * kp > qb) continue;
                const bf16x8_t pf = *(const bf16x8_t*)(sP + (qb * 2 + kp) * 1024 + lane * 16);
                acc[qb] = MFMA16(__builtin_shufflevector(cu.vl[kp], cu.vh[kp], 0, 1, 2, 3, 4, 5, 6, 7), pf, acc[qb]); }
#pragma unroll
        for (int qb = 0; qb < 4; ++qb) { float s1 = (acc[qb][0] + acc[qb][1]) + (acc[qb][2] + acc[qb][3]);
            float s2 = (acc[qb][0] * acc[qb][0] + acc[qb][1] * acc[qb][1]) + (acc[qb][2] * acc[qb][2] + acc[qb][3] * acc[qb][3]);
            s1 += __shfl_xor(s1, 16); s1 += __shfl_xor(s1, 32); s2 += __shfl_xor(s2, 16); s2 += __shfl_xor(s2, 32);
            if (fq == 0) { sSt[((qb * 16 + fr) * 8 + w) * 2] = s1; sSt[((qb * 16 + fr) * 8 + w) * 2 + 1] = s2; } }
        WG_BARRIER();
#pragma unroll
        for (int qb = 0; qb < 4; ++qb) { const int tk = qb * 16 + fr; float s1 = 0.f, s2 = 0.f;
#pragma unroll
            for (int ww = 0; ww < 8; ww += 2) { const f32x4 v = *(const f32x4*)(sSt + (tk * 8 + ww) * 2); s1 += v[0] + v[2]; s2 += v[1] + v[3]; }
            const float mu = s1 * (1.f / 128.f); const float var = fmaxf(s2 * (1.f / 128.f) - mu * mu, 0.f); const float rstd = rsqrtf(var + EPSN);
            const int e0 = 16 * w + 4 * fq; bf16* gp = P + (t0 + tk) * PW + C_BG + h * 128 + e0;
            const u32x2 gw = cu.gt[qb]; const f32x4 g4 = *(const f32x4*)(gn + e0);
            const float y0 = siluf_(bflo(gw.x)) * (acc[qb][0] - mu) * rstd * g4[0], y1 = siluf_(bfhi(gw.x)) * (acc[qb][1] - mu) * rstd * g4[1];
            const float y2 = siluf_(bflo(gw.y)) * (acc[qb][2] - mu) * rstd * g4[2], y3 = siluf_(bfhi(gw.y)) * (acc[qb][3] - mu) * rstd * g4[3];
            u32x2 o; o.x = cvtpk(y0, y1); o.y = cvtpk(y2, y3); if (!dry) *(u32x2*)gp = o; }
    }
    __syncthreads();
}

#define XB_TMO      128
#define XB_XCNT(j)  (256  + 64 * (j))
#define XB_XSUB(j)  (1280 + 64 * (j))
#define XB_XGEN(j)  (2304 + 64 * (j))
#define XB_TOP      3328
#define XB_TOPGEN   3392
#define XCD_BAR_WORDS 3456
#define XB_SPIN_CAP (1u << 23)

__device__ __forceinline__ unsigned xb_ld(unsigned* p)              { return __hip_atomic_load(p, __ATOMIC_RELAXED, __HIP_MEMORY_SCOPE_AGENT); }
__device__ __forceinline__ unsigned xb_add(unsigned* p, unsigned v) { return __hip_atomic_fetch_add(p, v, __ATOMIC_RELAXED, __HIP_MEMORY_SCOPE_AGENT); }
__device__ __forceinline__ unsigned xb_xcc_id() { return (unsigned)__builtin_amdgcn_s_getreg((3 << 11) | 20) & 0xFu; }
#define XB_SPIN(cond, bar) do { unsigned _sp = 0; while (cond) { __builtin_amdgcn_s_sleep(1); \
    if ((++_sp & 255u) == 0u) { if (xb_ld(&(bar)[XB_TMO])) break; if (_sp > XB_SPIN_CAP) { atomicAdd(&(bar)[XB_TMO], 1u); break; } } } } while (0)

struct XcdBarrier {
    unsigned* bar; unsigned x;
    volatile LAS unsigned* st;
};

__device__ __forceinline__ XcdBarrier xcd_barrier_post(unsigned* bar, volatile LAS unsigned* st) {
    XcdBarrier b; b.bar = bar; b.x = xb_xcc_id(); b.st = st;
    if (threadIdx.x == 0) (void)xb_add(&bar[XB_XCNT(b.x)], 1u);
    return b;
}
__device__ __forceinline__ void xcd_barrier_complete(unsigned* bar, unsigned x, unsigned& nloc, unsigned& nx) {
    const unsigned G = gridDim.x * gridDim.y * gridDim.z;
    unsigned sum, cnt, mine, sp = 0u;
    for (;;) {
        sum = 0u; cnt = 0u; mine = 0u;
#pragma unroll
        for (unsigned j = 0; j < 16; ++j) { const unsigned c = xb_ld(&bar[XB_XCNT(j)]); sum += c; cnt += (c > 0u) ? 1u : 0u; mine = (j == x) ? c : mine; }
        if (sum == G) break;
        __builtin_amdgcn_s_sleep(1);
        if ((++sp & 255u) == 0u) { if (xb_ld(&bar[XB_TMO])) break; if (sp > XB_SPIN_CAP) { atomicAdd(&bar[XB_TMO], 1u); break; } }
    }
    nloc = mine > 0u ? mine : 1u; nx = cnt > 0u ? cnt : 1u;
}

__device__ __forceinline__ void xcd_barrier(const XcdBarrier& b) {
    asm volatile("s_waitcnt vmcnt(0)" ::: "memory");
    __syncthreads();
    if (threadIdx.x == 0) {
        unsigned* bar = b.bar;
        __builtin_amdgcn_s_waitcnt(0);
        unsigned nloc = b.st[0], nx = b.st[1];
        if (nloc == 0u) { xcd_barrier_complete(bar, b.x, nloc, nx); b.st[0] = nloc; b.st[1] = nx; }
        const unsigned old = xb_add(&bar[XB_XSUB(b.x)], 1u);
        const unsigned gen = old / nloc;
        if (old + 1u == (gen + 1u) * nloc) {
            __builtin_amdgcn_fence(__ATOMIC_RELEASE, "agent");
            asm volatile("s_waitcnt vmcnt(0)" ::: "memory");
            const unsigned og = xb_add(&bar[XB_TOP], 1u);
            const unsigned tg = og / nx;
            if (og + 1u == (tg + 1u) * nx) xb_add(&bar[XB_TOPGEN], 1u);
            else XB_SPIN(xb_ld(&bar[XB_TOPGEN]) == tg, bar);
            __builtin_amdgcn_fence(__ATOMIC_ACQUIRE, "agent");
            xb_add(&bar[XB_XGEN(b.x)], 1u);
            asm volatile("s_waitcnt vmcnt(0)" ::: "memory");
        } else {
            XB_SPIN(xb_ld(&bar[XB_XGEN(b.x)]) == gen, bar);
            __builtin_amdgcn_fence(__ATOMIC_ACQUIRE, "agent");
            asm volatile("s_waitcnt vmcnt(0)" ::: "memory");
        }
    }
    __syncthreads();
}

#define CONV_GRID_BAR() do { XcdBarrier xb_; xb_.bar = (unsigned*)(ws + WS_MISC + MS_BAR); xb_.x = xb_xcc_id(); xb_.st = (volatile LAS unsigned*)((LAS unsigned char*)lds + 131072 + 64); xcd_barrier(xb_); } while (0)
__device__ __forceinline__ void conv_prepass(const Ctx& c, ArgP A, int l, unsigned char* ws, unsigned char* lds) {
    bf16* P = (bf16*)(c.ws + WS_PROJ); bf16* XCT = (bf16*)(c.ws + WS_XCT);
    const int item = c.wg * 512 + c.tid; const bool act = item < 131072;
    const int cg8 = item & 127, run = (item >> 7) & 1023, ch0 = cg8 * 8;
    const size_t tok0 = (size_t)run * 16; const int s_in = (int)(tok0 & (SEQL - 1));
    unsigned outp[16][4];
    if (act) {
        const float* cw = A->in[7] + (size_t)l * 4 * 1024 + ch0; const float* cb = A->in[8] + (size_t)l * 1024 + ch0;
        float wt[4][8], bias[8];
#pragma unroll
        for (int k = 0; k < 8; ++k) { bias[k] = cb[k];
#pragma unroll
            for (int w = 0; w < 4; ++w) wt[w][k] = cw[w * 1024 + k]; }
        float win[3][8];
#pragma unroll
        for (int r = 0; r < 3; ++r) {
            if (s_in == 0) {
#pragma unroll
                for (int k = 0; k < 8; ++k) win[r][k] = 0.f; }
            else unpack8(*(const u32x4*)(P + (tok0 - 3 + r) * PW + C_DX + ch0), win[r]); }
#pragma unroll
        for (int tk = 0; tk < 16; ++tk) { float cur[8]; unpack8(*(const u32x4*)(P + (tok0 + tk) * PW + C_DX + ch0), cur); float o[8];
#pragma unroll
            for (int k = 0; k < 8; ++k) { const float a = bias[k] + wt[0][k] * win[0][k] + wt[1][k] * win[1][k] + wt[2][k] * win[2][k] + wt[3][k] * cur[k]; o[k] = siluf_(a);
                win[0][k] = win[1][k]; win[1][k] = win[2][k]; win[2][k] = cur[k]; }
#pragma unroll
            for (int q = 0; q < 4; ++q) outp[tk][q] = cvtpk(o[2 * q], o[2 * q + 1]); }
        if (cg8 < 96) {
#pragma unroll
            for (int q = 0; q < 4; ++q) { u32x4 lo0, lo1, hi0, hi1;
#pragma unroll
                for (int m = 0; m < 4; ++m) { const unsigned a0 = outp[2 * m][q], a1 = outp[2 * m + 1][q], b0 = outp[8 + 2 * m][q], b1 = outp[8 + 2 * m + 1][q];
                    lo0[m] = (a0 & 0xffffu) | (a1 << 16); hi0[m] = (a0 >> 16) | (a1 & 0xffff0000u); lo1[m] = (b0 & 0xffffu) | (b1 << 16); hi1[m] = (b0 >> 16) | (b1 & 0xffff0000u); }
                bf16* r0 = XCT + (size_t)(ch0 + 2 * q) * NT + tok0; bf16* r1 = r0 + NT;
                *(u32x4*)r0 = lo0; *(u32x4*)(r0 + 8) = lo1; *(u32x4*)r1 = hi0; *(u32x4*)(r1 + 8) = hi1; } }
    }
    CONV_GRID_BAR();
    if (act) {
#pragma unroll
        for (int tk = 0; tk < 16; ++tk) { u32x4 o; o.x = outp[tk][0]; o.y = outp[tk][1]; o.z = outp[tk][2]; o.w = outp[tk][3]; *(u32x4*)(P + (tok0 + tk) * PW + C_DX + ch0) = o; }
    }
}

struct DLoad { u32x4 bc[4]; u32x4 bt[2]; float dtr; u32x4 xf[2]; s16x4_t xl[2], xh[2]; };
__device__ __forceinline__ void d_issue(DLoad& L, const bf16* P, const bf16* XCT, const float* dtr, unsigned xoff, int b, int g, int head, int head_s, int pb, int ch, int tid, int lane, int w, int fr, int fq) {
    const char* Pc = (const char*)P; const char* Xc = (const char*)XCT; const char* Dc = (const char*)dtr;
    const unsigned s0 = (unsigned)ch * 64u, t0 = (unsigned)b * SEQL + s0;
#pragma unroll
    for (int r = 0; r < 4; ++r) { const unsigned cn = tid + 512 * r, which = cn >> 10, tk = (cn >> 4) & 63, cc = cn & 15;
        L.bc[r] = *(const u32x4*)(Pc + ((t0 + tk) * PW + C_DX + 512 + which * 256 + g * 128 + cc * 8) * 2u); }
#pragma unroll
    for (int r = 0; r < 2; ++r) { const unsigned cn = tid + 512 * r, n = cn >> 3, cc = cn & 7; L.bt[r] = *(const u32x4*)(Xc + ((512u + g * 128 + n) * NT + t0 + cc * 8) * 2u); }
    L.dtr = (w < 2) ? *(const float*)(Dc + ((t0 + lane) * 8u + head_s) * 4u) : 0.f;
#pragma unroll
    for (int ks = 0; ks < 2; ++ks) { L.xf[ks] = *(const u32x4*)(Xc + xoff + (s0 + ks * 32 + fq * 8) * 2u); L.xl[ks] = *(const s16x4_t*)(Xc + xoff + (s0 + ks * 32 + 4 * fq) * 2u); L.xh[ks] = *(const s16x4_t*)(Xc + xoff + (s0 + ks * 32 + 16 + 4 * fq) * 2u); }
}
__device__ __forceinline__ void mixer_d_mfma(const Ctx& c, ArgP A, unsigned char* lds_raw, int l, int unit, int dry) {
    bf16* P = (bf16*)(c.ws + WS_PROJ); const bf16* XCT = (const bf16*)(c.ws + WS_XCT);
    unsigned char* sB = lds_raw;
    unsigned char* sC = lds_raw + 17408;
    unsigned char* sBT = lds_raw + 34816;
    unsigned char* sS = lds_raw + 53248;
    float* sDt = (float*)(lds_raw + 63488);
    float* sAc = sDt + 256;
    const int b = unit >> 2, pair = unit & 3, g = pair >> 1;
    const int tid = c.tid, lane = c.lane, w = c.wave, fr = lane & 15, fq = lane >> 4, hh = w >> 2, pb = w & 3, head = pair * 2 + hh;
    constexpr float L2E = 1.4426950408889634f;
    const int head_s = pair * 2 + (w & 1);
    const float* p_dtb = A->in[9] + l * 8 + head_s; const float* p_al = A->in[10] + l * 8 + head_s; const float* p_dsk = A->in[11] + l * 8 + head;
    const float* p_g4 = A->in[12] + (size_t)l * 512 + head * 64 + pb * 16 + 4 * fq;
    const float* dtr = (const float*)(c.ws + WS_MISC + MS_DT); float* ssq = (float*)(c.ws + WS_SSQ32);
    f32x4 H[8];
#pragma unroll
    for (int i = 0; i < 8; ++i) H[i] = (f32x4){0.f, 0.f, 0.f, 0.f};
    const unsigned xoff = ((unsigned)(head * 64 + pb * 16 + fr) * NT + (unsigned)b * SEQL) * 2u;
    DLoad nx; d_issue(nx, P, XCT, dtr, xoff, b, g, head, head_s, pb, 0, tid, lane, w, fr, fq);
    for (int ch = 0; ch < 64; ++ch) {
        const int s0 = ch * 64, par = ch & 1; const size_t t0 = (size_t)b * SEQL + s0;
        const DLoad cu = nx;
#pragma unroll
        for (int r = 0; r < 4; ++r) { const int cn = tid + 512 * r, which = cn >> 10, tk = (cn >> 4) & 63, cc = cn & 15; *(u32x4*)((which ? sC : sB) + tk * 272 + cc * 16) = cu.bc[r]; }
#pragma unroll
        for (int r = 0; r < 2; ++r) { const int cn = tid + 512 * r, n = cn >> 3, cc = cn & 7; *(u32x4*)(sBT + n * 144 + cc * 16) = cu.bt[r]; }
        if (w < 2) { const float x = cu.dtr + *p_dtb; const float dt = fmaxf(x, 0.f) + log1pf(__expf(-fabsf(x)));
            float a = dt * (-__expf(*p_al)) * L2E;
#pragma unroll
            for (int off = 1; off < 64; off <<= 1) { const float v = __shfl_up(a, off); if (lane >= off) a += v; }
            sDt[(par * 2 + w) * 64 + lane] = dt; sAc[(par * 2 + w) * 64 + lane] = a; }
        if (ch + 1 < 64) d_issue(nx, P, XCT, dtr, xoff, b, g, head, head_s, pb, ch + 1, tid, lane, w, fr, fq);
        WG_BARRIER();
        const float* dtv = sDt + (par * 2 + hh) * 64; const float* acv = sAc + (par * 2 + hh) * 64;
        for (int ti = w; ti < 10; ti += 8) { const int qb = (ti >= 6) ? 3 : (ti >= 3) ? 2 : (ti >= 1) ? 1 : 0, kb = ti - qb * (qb + 1) / 2;
            f32x4 sacc = (f32x4){0.f, 0.f, 0.f, 0.f};
#pragma unroll
            for (int ks = 0; ks < 4; ++ks) { const bf16x8_t bfv = *(const bf16x8_t*)(sB + (kb * 16 + fr) * 272 + (ks * 32 + fq * 8) * 2), cfv = *(const bf16x8_t*)(sC + (qb * 16 + fr) * 272 + (ks * 32 + fq * 8) * 2);
                sacc = MFMA16(bfv, cfv, sacc); }
            *(f32x4*)(sS + ti * 1024 + lane * 16) = sacc; }
        f32x4 acc[4];
        {
            bf16x8_t Hop[4];
#pragma unroll
            for (int ks = 0; ks < 4; ++ks) { float t8[8];
#pragma unroll
                for (int j = 0; j < 4; ++j) { t8[j] = H[2 * ks][j]; t8[4 + j] = H[2 * ks + 1][j]; }
                Hop[ks] = pack8(t8); }
#pragma unroll
            for (int qb = 0; qb < 4; ++qb) { acc[qb] = (f32x4){0.f, 0.f, 0.f, 0.f};
#pragma unroll
                for (int ks = 0; ks < 4; ++ks) { const unsigned char* cp = sC + (qb * 16 + fr) * 272 + (ks * 32 + 4 * fq) * 2;
                    const s16x4_t lo = *(const s16x4_t*)cp, hi = *(const s16x4_t*)(cp + 32);
                    acc[qb] = MFMA16(Hop[ks], __builtin_shufflevector(lo, hi, 0, 1, 2, 3, 4, 5, 6, 7), acc[qb]); }
                acc[qb] = acc[qb] * ex2(acv[qb * 16 + fr]); }
        }
        {
            const float aend = acv[63];
            bf16x8_t xw[2];
#pragma unroll
            for (int ks = 0; ks < 2; ++ks) { float xv[8]; unpack8(cu.xf[ks], xv);
                const f32x4 d0 = *(const f32x4*)(dtv + ks * 32 + fq * 8), d1 = *(const f32x4*)(dtv + ks * 32 + fq * 8 + 4), a0 = *(const f32x4*)(acv + ks * 32 + fq * 8), a1 = *(const f32x4*)(acv + ks * 32 + fq * 8 + 4);
#pragma unroll
                for (int j = 0; j < 4; ++j) { xv[j] *= d0[j] * ex2(aend - a0[j]); xv[4 + j] *= d1[j] * ex2(aend - a1[j]); }
                xw[ks] = pack8(xv); }
            const float ge = ex2(aend);
#pragma unroll
            for (int nh = 0; nh < 2; ++nh) {
                f32x4 kvn[4];
#pragma unroll
                for (int nb = 0; nb < 4; ++nb) kvn[nb] = (f32x4){0.f, 0.f, 0.f, 0.f};
#pragma unroll
                for (int ks = 0; ks < 2; ++ks)
#pragma unroll
                    for (int nb = 0; nb < 4; ++nb) { const bf16x8_t bt = *(const bf16x8_t*)(sBT + ((nh * 4 + nb) * 16 + fr) * 144 + (ks * 32 + fq * 8) * 2); kvn[nb] = MFMA16(bt, xw[ks], kvn[nb]); }
#pragma unroll
                for (int nb = 0; nb < 4; ++nb) H[nh * 4 + nb] = H[nh * 4 + nb] * ge + kvn[nb];
            }
        }
        WG_BARRIER();
        u32x2 xr[4], zr[4];
#pragma unroll
        for (int qb = 0; qb < 4; ++qb) { const unsigned t = (unsigned)t0 + qb * 16 + fr; const unsigned p0 = head * 64 + pb * 16 + 4 * fq;
            xr[qb] = *(const u32x2*)((const char*)P + (t * PW + C_DX + p0) * 2u); zr[qb] = *(const u32x2*)((const char*)P + (t * PW + C_DZ + p0) * 2u); }
#pragma unroll
        for (int qb = 0; qb < 4; ++qb) { const int qi = qb * 16 + fr; const float aq = acv[qi];
#pragma unroll
            for (int kp = 0; kp < 2; ++kp) { if (2 * kp > qb) continue;
                const int ti = qb * (qb + 1) / 2 + 2 * kp; const bool two = (2 * kp + 1) <= qb;
                const f32x4 sa = *(const f32x4*)(sS + ti * 1024 + lane * 16); f32x4 sb = (f32x4){0.f, 0.f, 0.f, 0.f}; if (two) sb = *(const f32x4*)(sS + (ti + 1) * 1024 + lane * 16);
                const int k0 = kp * 32 + 4 * fq;
                const f32x4 da = *(const f32x4*)(dtv + k0), db = *(const f32x4*)(dtv + k0 + 16), aa = *(const f32x4*)(acv + k0), ab = *(const f32x4*)(acv + k0 + 16);
                float p[8];
#pragma unroll
                for (int j = 0; j < 4; ++j) { p[j] = (k0 + j <= qi) ? sa[j] * da[j] * ex2(aq - aa[j]) : 0.f; p[4 + j] = (k0 + 16 + j <= qi) ? sb[j] * db[j] * ex2(aq - ab[j]) : 0.f; }
                acc[qb] = MFMA16(__builtin_shufflevector(cu.xl[kp], cu.xh[kp], 0, 1, 2, 3, 4, 5, 6, 7), pack8(p), acc[qb]); } }
        const float Dsk = *p_dsk; const f32x4 g4 = *(const f32x4*)p_g4;
#pragma unroll
        for (int qb = 0; qb < 4; ++qb) { const unsigned t = (unsigned)t0 + qb * 16 + fr; const unsigned p0 = head * 64 + pb * 16 + 4 * fq;
            const u32x2 xw = xr[qb]; bf16* zp = (bf16*)((char*)P + (t * PW + C_DZ + p0) * 2u); const u32x2 zw = zr[qb];
            const float y0 = (acc[qb][0] + Dsk * bflo(xw.x)) * siluf_(bflo(zw.x)), y1 = (acc[qb][1] + Dsk * bfhi(xw.x)) * siluf_(bfhi(zw.x));
            const float y2 = (acc[qb][2] + Dsk * bflo(xw.y)) * siluf_(bflo(zw.y)), y3 = (acc[qb][3] + Dsk * bfhi(xw.y)) * siluf_(bfhi(zw.y));
            float sq = (y0 * y0 + y1 * y1) + (y2 * y2 + y3 * y3); sq += __shfl_xor(sq, 16); sq += __shfl_xor(sq, 32);
            if (fq == 0 && !dry) ssq[t * 32 + head * 4 + pb] = sq;
            u32x2 o; o.x = cvtpk(y0 * g4[0], y1 * g4[1]); o.y = cvtpk(y2 * g4[2], y3 * g4[3]); if (!dry) *(u32x2*)zp = o; }
    }
    __syncthreads();
}

__device__ __forceinline__ void xattn_mfma(const Ctx& c) {
    const bf16* XQ = (const bf16*)(c.ws + WS_PROJ); bf16* AO = (bf16*)(c.ws + WS_PROJ + 16 * MiB);
    const bf16* KX = (const bf16*)(c.ws + WS_MISC + MS_KV);
    const bf16* VTX = (const bf16*)(c.ws + WS_MISC + MS_VTX);
    const int lane = c.lane, fr = lane & 15, fq = lane >> 4;
    constexpr float C2 = 0.08838834764831845f * 1.4426950408889634f;
    const int gw = c.wg * 8 + c.wave, ngw = c.nwg * 8;
    for (int g = gw; g < 4096; g += ngw) {
        const int h = (g >> 3) & 3, tb = ((g >> 5) << 3) | (g & 7), b = tb >> 8;
        const size_t t = (size_t)tb * 16 + fr;
        bf16x8_t qf[4];
#pragma unroll
        for (int ks = 0; ks < 4; ++ks) qf[ks] = *(const bf16x8_t*)(XQ + t * 512 + h * 128 + ks * 32 + fq * 8);
        f32x4 oacc[8];
#pragma unroll
        for (int eb = 0; eb < 8; ++eb) oacc[eb] = (f32x4){0.f, 0.f, 0.f, 0.f};
        float mrun = -1e30f, lrun = 0.f;
        for (int kp = 0; kp < 8; ++kp) {
            const bf16* k0p = KX + (size_t)(b * 256 + kp * 32 + fr) * 512 + h * 128 + fq * 8;
            f32x4 s0 = (f32x4){0.f, 0.f, 0.f, 0.f}, s1 = s0;
#pragma unroll
            for (int ks = 0; ks < 4; ++ks) { const bf16x8_t ka = *(const bf16x8_t*)(k0p + ks * 32), kb = *(const bf16x8_t*)(k0p + 16 * 512 + ks * 32);
                s0 = MFMA16(ka, qf[ks], s0); s1 = MFMA16(kb, qf[ks], s1); }
            float sc[8];
#pragma unroll
            for (int j = 0; j < 4; ++j) { sc[j] = s0[j] * C2; sc[4 + j] = s1[j] * C2; }
            float mx = fmaxf(fmaxf(fmaxf(sc[0], sc[1]), fmaxf(sc[2], sc[3])), fmaxf(fmaxf(sc[4], sc[5]), fmaxf(sc[6], sc[7])));
            mx = fmaxf(mx, __shfl_xor(mx, 16)); mx = fmaxf(mx, __shfl_xor(mx, 32));
            const float mnew = fmaxf(mrun, mx); const float alpha = ex2(mrun - mnew); mrun = mnew;
            float pr[8], ps = 0.f;
#pragma unroll
            for (int i = 0; i < 8; ++i) { pr[i] = ex2(sc[i] - mnew); ps += pr[i]; }
            lrun = lrun * alpha + ps;
            const bf16x8_t pf = pack8(pr);
#pragma unroll
            for (int eb = 0; eb < 8; ++eb) { const bf16* vp = VTX + (size_t)(h * 128 + eb * 16 + fr) * 1024 + b * 256 + kp * 32 + 4 * fq;
                const s16x4_t lo = *(const s16x4_t*)vp, hi = *(const s16x4_t*)(vp + 16);
                oacc[eb] = oacc[eb] * alpha; oacc[eb] = MFMA16(__builtin_shufflevector(lo, hi, 0, 1, 2, 3, 4, 5, 6, 7), pf, oacc[eb]); }
        }
        float lt = lrun; lt += __shfl_xor(lt, 16); lt += __shfl_xor(lt, 32); const float linv = 1.f / lt;
        bf16* op = AO + t * 512 + h * 128 + 4 * fq;
#pragma unroll
        for (int eb = 0; eb < 8; ++eb) { u32x2 o; o.x = cvtpk(oacc[eb][0] * linv, oacc[eb][1] * linv); o.y = cvtpk(oacc[eb][2] * linv, oacc[eb][3] * linv); *(u32x2*)(op + eb * 16) = o; }
    }
}

__device__ __forceinline__ void mixer_b_naive(const Ctx& c, ArgP A, unsigned char* lds_raw, int l, int unit) {
    bf16* P = (bf16*)(c.ws + WS_PROJ); const bf16* VTb = (const bf16*)(c.ws + WS_VT) + (size_t)VT_B * NT;
    float* sQ = (float*)lds_raw;
    float* sKk = sQ + 32 * 64;
    float* sVv = sKk + 32 * 64;
    float* sP = sVv + 32 * 128;
    const int b = unit >> 2, h = unit & 3, tid = c.tid, e = tid & 127, dg = tid >> 7;
    const float gamma = 1.f - exp2f(-5.f - (float)h);
    const float* gn = A->in[4] + (size_t)l * 512 + h * 128;
    float S[16];
#pragma unroll
    for (int i = 0; i < 16; ++i) S[i] = 0.f;
    for (int s0 = 0; s0 < SEQL; s0 += 32) {
        const size_t t0 = (size_t)b * SEQL + s0;
#pragma unroll
        for (int r = 0; r < 4; ++r) { const int it = tid + 512 * r, which = it >> 10, st = (it >> 5) & 31, i = it & 31;
            const bf16* src = P + (t0 + st) * PW + (which ? C_BK : C_BQ) + h * 64;
            const float t1 = bf2f(src[i]), t2 = bf2f(src[i + 32]);
            const float invf = powf(10000.f, -(float)i / 32.f); const float ang = (float)(s0 + st) * invf;
            float sn, cs; sincosf(ang, &sn, &cs);
            const float sc = which ? 0.125f : 1.f; float* dst = (which ? sKk : sQ) + st * 64;
            dst[i] = (t1 * cs - t2 * sn) * sc; dst[i + 32] = (t1 * sn + t2 * cs) * sc; }
#pragma unroll
        for (int r = 0; r < 8; ++r) { const int it = tid + 512 * r, st = it >> 7, ee = it & 127; sVv[st * 128 + ee] = bf2f(VTb[(size_t)(h * 128 + ee) * NT + t0 + st]); }
        __syncthreads();
        for (int st = 0; st < 32; ++st) {
            const float vv = sVv[st * 128 + e]; float po = 0.f;
#pragma unroll
            for (int i4 = 0; i4 < 4; ++i4) { const f32x4 kk = *(const f32x4*)(sKk + st * 64 + dg * 16 + 4 * i4), qq = *(const f32x4*)(sQ + st * 64 + dg * 16 + 4 * i4);
#pragma unroll
                for (int j = 0; j < 4; ++j) { S[4 * i4 + j] = gamma * S[4 * i4 + j] + kk[j] * vv; po += qq[j] * S[4 * i4 + j]; } }
            sP[(st * 4 + dg) * 128 + e] = po;
        }
        __syncthreads();
#pragma unroll
        for (int r = 0; r < 4; ++r) { const int st = c.wave * 4 + r, lane = c.lane;
            float o0 = 0.f, o1 = 0.f;
#pragma unroll
            for (int g = 0; g < 4; ++g) { o0 += sP[(st * 4 + g) * 128 + lane]; o1 += sP[(st * 4 + g) * 128 + lane + 64]; }
            const float mu = wave_sum(o0 + o1) * (1.f / 128.f); const float a0 = o0 - mu, a1 = o1 - mu;
            const float var = wave_sum(a0 * a0 + a1 * a1) * (1.f / 128.f); const float rstd = rsqrtf(var + EPSN);
            bf16* gp = P + (t0 + st) * PW + C_BG + h * 128;
            const float g0 = bf2f(gp[lane]), g1 = bf2f(gp[lane + 64]);
            gp[lane] = (bf16)f2bf(siluf_(g0) * a0 * rstd * gn[lane]); gp[lane + 64] = (bf16)f2bf(siluf_(g1) * a1 * rstd * gn[lane + 64]); }
    }
    __syncthreads();
}

__device__ __forceinline__ void mixer_d_naive(const Ctx& c, ArgP A, unsigned char* lds_raw, int l, int unit) {
    bf16* P = (bf16*)(c.ws + WS_PROJ);
    float* sXs = (float*)lds_raw;
    float* sB = sXs + 32 * 64;
    float* sC = sB + 32 * 128;
    float* sDt = sC + 32 * 128;
    float* sA = sDt + 32;
    float* sP = sA + 32;
    const int b = unit >> 3, hd = unit & 7, g = hd >> 2, tid = c.tid, p = tid & 63, ng = tid >> 6;
    const float* cw = A->in[7] + (size_t)l * 4 * 1024; const float* cb = A->in[8] + (size_t)l * 1024;
    const float dtb = A->in[9][l * 8 + hd], Aneg = -expf(A->in[10][l * 8 + hd]), Dsk = A->in[11][l * 8 + hd];
    const float* ng_ = A->in[12] + (size_t)l * 512 + hd * 64;
    const float* dtr = (const float*)(c.ws + WS_MISC + MS_DT); float* ssq = (float*)(c.ws + WS_MISC + MS_SSQ);
    float S[16];
#pragma unroll
    for (int i = 0; i < 16; ++i) S[i] = 0.f;
    for (int s0 = 0; s0 < SEQL; s0 += 32) {
        const size_t t0 = (size_t)b * SEQL + s0;
        for (int it = tid; it < 32 * 320; it += 512) { const int st = it / 320, ch = it % 320;
            int cc; float* dst;
            if (ch < 64) { cc = hd * 64 + ch; dst = sXs + st * 64 + ch; } else if (ch < 192) { cc = 512 + g * 128 + (ch - 64); dst = sB + st * 128 + (ch - 64); } else { cc = 768 + g * 128 + (ch - 192); dst = sC + st * 128 + (ch - 192); }
            float a = cb[cc];
#pragma unroll
            for (int w = 0; w < 4; ++w) { const int sp = s0 + st - 3 + w; if (sp >= 0) a += cw[w * 1024 + cc] * bf2f(P[((size_t)b * SEQL + sp) * PW + C_DX + cc]); }
            *dst = siluf_(a); }
        if (tid < 32) { const float x = dtr[(t0 + tid) * 8 + hd] + dtb; const float dt = fmaxf(x, 0.f) + log1pf(__expf(-fabsf(x))); sDt[tid] = dt; sA[tid] = __expf(dt * Aneg); }
        __syncthreads();
        for (int st = 0; st < 32; ++st) {
            const float a = sA[st], xdt = sDt[st] * sXs[st * 64 + p]; float po = 0.f;
#pragma unroll
            for (int i4 = 0; i4 < 4; ++i4) { const f32x4 bb = *(const f32x4*)(sB + st * 128 + ng * 16 + 4 * i4), cc4 = *(const f32x4*)(sC + st * 128 + ng * 16 + 4 * i4);
#pragma unroll
                for (int j = 0; j < 4; ++j) { S[4 * i4 + j] = a * S[4 * i4 + j] + bb[j] * xdt; po += cc4[j] * S[4 * i4 + j]; } }
            sP[(st * 8 + ng) * 64 + p] = po;
        }
        __syncthreads();
#pragma unroll
        for (int r = 0; r < 4; ++r) { const int st = c.wave * 4 + r, lane = c.lane;
            float y = 0.f;
#pragma unroll
            for (int q = 0; q < 8; ++q) y += sP[(st * 8 + q) * 64 + lane];
            y += Dsk * sXs[st * 64 + lane];
            bf16* zp = P + (t0 + st) * PW + C_DZ + hd * 64;
            const float yz = y * siluf_(bf2f(zp[lane]));
            const float sq = wave_sum(yz * yz);
            if (lane == 0) ssq[(t0 + st) * 8 + hd] = sq;
            zp[lane] = (bf16)f2bf(yz * ng_[lane]); }
    }
    __syncthreads();
}

__device__ __forceinline__ void xattn_naive(const Ctx& c) {
    const bf16* XQ = (const bf16*)(c.ws + WS_PROJ); bf16* AO = (bf16*)(c.ws + WS_PROJ + 16 * MiB);
    const bf16* KV = (const bf16*)(c.ws + WS_MISC + MS_KV);
    for (int item = c.wg * 512 + c.tid; item < NT * 8; item += c.nwg * 512) {
        const int w = item >> 6, h = w & 3, t = (w >> 2) * 32 + ((item & 63) >> 1), half = item & 1, b = t >> 12;
        const bf16* qp = XQ + (size_t)t * 512 + h * 128 + half * 64;
        float q[64], o[64];
#pragma unroll
        for (int i = 0; i < 8; ++i) { float f[8]; unpack8(*(const u32x4*)(qp + 8 * i), f);
#pragma unroll
            for (int j = 0; j < 8; ++j) { q[8 * i + j] = f[j] * 0.08838834764831845f; o[8 * i + j] = 0.f; } }
        float mrun = -1e30f, lrun = 0.f;
        for (int m = 0; m < 256; ++m) {
            const bf16* kr = KV + (size_t)(b * 256 + m) * 1024 + h * 128 + half * 64; const bf16* vr = kr + 512;
            float sc = 0.f;
#pragma unroll
            for (int i = 0; i < 8; ++i) { float f[8]; unpack8(*(const u32x4*)(kr + 8 * i), f);
#pragma unroll
                for (int jj = 0; jj < 8; ++jj) sc += q[8 * i + jj] * f[jj]; }
            sc += __shfl_xor(sc, 1);
            float p_; if (sc > mrun) { const float r = __expf(mrun - sc); lrun *= r;
#pragma unroll
                for (int i = 0; i < 64; ++i) o[i] *= r;
                mrun = sc; p_ = 1.f; } else p_ = __expf(sc - mrun);
            lrun += p_;
#pragma unroll
            for (int i = 0; i < 8; ++i) { float f[8]; unpack8(*(const u32x4*)(vr + 8 * i), f);
#pragma unroll
                for (int jj = 0; jj < 8; ++jj) o[8 * i + jj] += p_ * f[jj]; }
        }
        const float inv = 1.f / lrun;
        bf16* op = AO + (size_t)t * 512 + h * 128 + half * 64;
#pragma unroll
        for (int i = 0; i < 8; ++i) { u32x4 wv; wv.x = pk2(o[8 * i] * inv, o[8 * i + 1] * inv); wv.y = pk2(o[8 * i + 2] * inv, o[8 * i + 3] * inv);
            wv.z = pk2(o[8 * i + 4] * inv, o[8 * i + 5] * inv); wv.w = pk2(o[8 * i + 6] * inv, o[8 * i + 7] * inv); *(u32x4*)(op + 8 * i) = wv; }
    }
}


#define GEMM_PHASE(EPI_T, Aptr, LDA, Bptr, MM, NN, KK, ...) do { \
    pg8::Gemm g_{(const pg8::bf16_t*)(Aptr), (const pg8::bf16_t*)(Bptr), (MM), (NN), (KK), (LDA)}; pg8::StaticOrder S_; S_.init((MM), (NN), c.nwg, c.wg); \
    EPI_T E_{__VA_ARGS__}; pg8::gemm_phase<EPI_T, pg8::StaticOrder, true, true>((PG8_LAS unsigned char*)lds, g_, S_, E_); } while (0)
#define GEMM_PHASE_C(CIDX, EPI_T, Aptr, LDA, Bptr, MM, NN, KK, ...) do { \
    pg8::Gemm g_{(const pg8::bf16_t*)(Aptr), (const pg8::bf16_t*)(Bptr), (MM), (NN), (KK), (LDA)}; pg8::StaticOrder S_; S_.init((MM), (NN), c.nwg, (CIDX)); \
    EPI_T E_{__VA_ARGS__}; pg8::gemm_phase<EPI_T, pg8::StaticOrder, true, true>((PG8_LAS unsigned char*)lds, g_, S_, E_); } while (0)

__global__ void __launch_bounds__(512, 2) mega_fwd(Args args) {
    extern __shared__ __attribute__((aligned(16))) unsigned char lds[];
    cg::grid_group grid = cg::this_grid();
    {
        volatile LAS unsigned* st0 = (volatile LAS unsigned*)((LAS unsigned char*)lds + 131072 + 64);
        if (threadIdx.x == 0) { st0[0] = 0u; st0[1] = 0u; }
        __syncthreads();
        (void)xcd_barrier_post((unsigned*)(args.ws + WS_MISC + MS_BAR), st0);
    }
#define GRID_BAR() do { XcdBarrier xb_; xb_.bar = (unsigned*)(ws + WS_MISC + MS_BAR); xb_.x = xb_xcc_id(); xb_.st = (volatile LAS unsigned*)((LAS unsigned char*)lds + 131072 + 64); xcd_barrier(xb_); } while (0)
#if XSYNC
    { unsigned char* ws = args.ws; for (int i_ = 0; i_ < XSYNC; ++i_) { asm volatile("" : "+s"(i_)); GRID_BAR(); } }
#endif
    int ph = 0;
    const int lo = args.ph_lo, hi = args.ph_hi;
#define PHASE_BEGIN if (ph >= lo && ph < hi) { ArgP ap = (ArgP)__builtin_amdgcn_kernarg_segment_ptr(); asm volatile("" : "+s"(ap)); unsigned char* ws = ap->ws; Ctx c; c.ws = ws; \
    { int t_ = threadIdx.x, g_ = blockIdx.x, n_ = gridDim.x; asm volatile("" : "+v"(t_), "+s"(g_), "+s"(n_)); c.tid = t_; c.lane = t_ & 63; c.wave = __builtin_amdgcn_readfirstlane(t_ >> 6); c.wg = g_; c.nwg = n_; } \
    bf16* Wb = (bf16*)(ws + WS_W); bf16* XN = (bf16*)(ws + WS_XN); bf16* PJ = (bf16*)(ws + WS_PROJ); float* X = ap->out; (void)Wb; (void)XN; (void)PJ; (void)X;
#define PHASE_END   if (ph + 1 < hi) { if (ph == 0) grid.sync(); else GRID_BAR(); } } ++ph;

    for (int l = 0; l < 2; ++l) {
        asm volatile("" : "+s"(l));
        PHASE_BEGIN for (int rep_ = 0; rep_ <= ((REPMASK >> 0) & 1); ++rep_) {
            convert_layer(c, ap, lds, l);
            if (c.wg == 0 && c.tid < 4) ((unsigned*)(ws + WS_MISC + MS_CNT))[l * 4 + c.tid] = 0u;
            { float* rz = (float*)(ws + WS_MISC + MS_SSQ); for (int i = c.wg * 512 + c.tid; i < 2 * NT; i += c.nwg * 512) rz[i] = 0.f; }
            if (l == 0) { float* rope = (float*)(ws + WS_MISC + MS_ROPE);
                for (int it = c.wg * 512 + c.tid; it < SEQL * 32; it += c.nwg * 512) { const int i = it & 31; const float ang = (float)(it >> 5) * powf(10000.f, -(float)i / 32.f); float sn, cs; sincosf(ang, &sn, &cs); rope[2 * it] = cs; rope[2 * it + 1] = sn; } }
            { float* wdt = (float*)(lds + 32768); const float* wsrc = ap->in[3] + (size_t)l * DM * INW + 6144;
                __syncthreads();
                for (int i = c.tid; i < 2048; i += 512) *(f32x4*)(wdt + i * 4) = *(const f32x4*)(wsrc + (size_t)(i >> 1) * INW + (i & 1) * 4);
                __syncthreads();
                norm_rows(c, (l == 0) ? ap->in[0] : X, ap->in[2] + (size_t)l * DM, XN, NT, wdt, (float*)(ws + WS_MISC + MS_DT)); }
            norm_rows(c, ap->in[1], ap->in[16] + (size_t)l * DM, (bf16*)(ws + WS_MISC + MS_MN), 1024, nullptr, nullptr);
        } PHASE_END
        PHASE_BEGIN for (int rep_ = 0; rep_ <= ((REPMASK >> 1) & 1); ++rep_) {
            GEMM_PHASE(pg8::EpiStore<0>, XN, 1024, Wb + W_IN, NT, 5120, 1024, PJ, PW, nullptr);
            GEMM_PHASE(pg8::EpiStore<0>, (bf16*)(ws + WS_WVT), 1024, XN, 1024, NT, 1024, (bf16*)(ws + WS_VT), NT, nullptr);
        } PHASE_END
        PHASE_BEGIN for (int rep_ = 0; rep_ <= ((REPMASK >> 2) & 1); ++rep_) {
            conv_prepass(c, ap, l, ws, lds);
            GRID_BAR();
            int dry0 = 0; asm volatile("" : "+s"(dry0));
            unsigned* cnt = (unsigned*)(ws + WS_MISC + MS_CNT) + l * 4;
            if (c.wg < 16) mixer_b_mfma(c, ap, lds, l, c.wg, dry0);
            else if (c.wg < 32) mixer_d_mfma(c, ap, lds, l, c.wg - 16, dry0);
            mixer_c_mfma(c, ap, lds, l, dry0, cnt);
#if DRYMASK & 2
            { int dry1 = 1; asm volatile("" : "+s"(dry1)); mixer_a_mfma(c, lds, dry1, cnt + 2); __syncthreads(); }
#endif
            mixer_a_mfma(c, lds, dry0, cnt + 1);
        } PHASE_END
        PHASE_BEGIN for (int rep_ = 0; rep_ <= ((REPMASK >> 3) & 1); ++rep_) {
            for (int i = 0; i < 4; ++i) {
                asm volatile("" : "+s"(i));
                const int acol = (i == 0) ? C_AQ : (i == 1) ? C_BG : (i == 2) ? C_CQ : C_DZ;
                GEMM_PHASE(pg8::EpiStore<1>, XN, 1024, Wb + W_G + (size_t)i * 1024 * 1024, NT, 1024, 1024, PJ + C_GS, PW, nullptr);
                GEMM_PHASE(pg8::EpiGateAcc, PJ + acol, PW, Wb + W_B + (size_t)i * 1024 * 512, NT, 1024, 512, PJ + C_GS, PJ + C_MG, PW, i == 0 ? 1 : 0, i == 3 ? (const float*)(ws + WS_SSQ32) : nullptr);
            }
        } PHASE_END
        PHASE_BEGIN for (int rep_ = 0; rep_ <= ((REPMASK >> 4) & 1); ++rep_) {
            GEMM_PHASE(pg8::EpiResid, PJ + C_MG, PW, Wb + W_MO, NT, 1024, 1024, (l == 0) ? ap->in[0] : X, X, XN, (float*)(ws + WS_MISC + MS_SSQ));
        } PHASE_END
        PHASE_BEGIN for (int rep_ = 0; rep_ <= ((REPMASK >> 5) & 1); ++rep_) {
            GEMM_PHASE(pg8::EpiStore<0>, XN, 1024, Wb + W_XQ, NT, 512, 1024, PJ, 512, (const float*)(ws + WS_MISC + MS_SSQ));
            GEMM_PHASE_C((c.wg + c.nwg - 128) % c.nwg, pg8::EpiStore<0>, (bf16*)(ws + WS_MISC + MS_MN), 1024, Wb + W_XKV, 1024, 512, 1024, (bf16*)(ws + WS_MISC + MS_KV), 512, nullptr);
            GEMM_PHASE_C((c.wg + c.nwg - 144) % c.nwg, pg8::EpiStore<0>, Wb + W_XKV + (size_t)512 * 1024, 1024, (bf16*)(ws + WS_MISC + MS_MN), 512, 1024, 1024, (bf16*)(ws + WS_MISC + MS_VTX), 1024, nullptr);
        } PHASE_END
        PHASE_BEGIN for (int rep_ = 0; rep_ <= ((REPMASK >> 6) & 1); ++rep_) {
            xattn_mfma(c);
        } PHASE_END
        PHASE_BEGIN for (int rep_ = 0; rep_ <= ((REPMASK >> 7) & 1); ++rep_) {
            GEMM_PHASE(pg8::EpiResid, (bf16*)(ws + WS_PROJ + 16 * MiB), 512, Wb + W_XO, NT, 1024, 512, X, X, XN, (float*)(ws + WS_MISC + MS_SSQ) + NT);
        } PHASE_END
        PHASE_BEGIN for (int rep_ = 0; rep_ <= ((REPMASK >> 8) & 1); ++rep_) {
            GEMM_PHASE(pg8::EpiSwiglu, XN, 1024, Wb + W_FI, NT, 5632, 1024, PJ, FFH, (const float*)(ws + WS_MISC + MS_SSQ) + NT);
        } PHASE_END
        PHASE_BEGIN for (int rep_ = 0; rep_ <= ((REPMASK >> 9) & 1); ++rep_) {
            GEMM_PHASE(pg8::EpiResid, PJ, FFH, Wb + W_FO, NT, 1024, FFH, X, X, nullptr, nullptr);
        } PHASE_END
    }
    PHASE_BEGIN for (int rep_ = 0; rep_ <= ((REPMASK >> 10) & 1); ++rep_) {
        final_norm(c, X, ap->in[23]);
    } PHASE_END
}

extern "C" void kernel_launch(void* const* d_in, const int* in_sizes, int n_in, void* d_out, int out_size, void* d_ws, size_t ws_size, hipStream_t stream) {
    static int grid_blocks = 0;
    if (grid_blocks == 0) {
        if (n_in != 24 || out_size != NT * DM || ws_size < WS_END) { fprintf(stderr, "kernel_launch: unexpected shapes (n_in %d out %d ws %zu)\n", n_in, out_size, ws_size); grid_blocks = -1; return; }
        int dev = 0, cus = 0, per_cu = 0;
        hipGetDevice(&dev);
        hipDeviceGetAttribute(&cus, hipDeviceAttributeMultiprocessorCount, dev);
        if (hipFuncSetAttribute((const void*)mega_fwd, hipFuncAttributeMaxDynamicSharedMemorySize, LDS_BYTES) != hipSuccess) { fprintf(stderr, "kernel_launch: hipFuncSetAttribute failed\n"); grid_blocks = -1; return; }
        if (hipOccupancyMaxActiveBlocksPerMultiprocessor(&per_cu, (const void*)mega_fwd, 512, LDS_BYTES) != hipSuccess || per_cu < 1) { fprintf(stderr, "kernel_launch: occupancy query says %d\n", per_cu); per_cu = 1; }
        (void)hipGetLastError();
        grid_blocks = cus * 1;
        fprintf(stderr, "kernel_launch: grid %d (cus %d, per_cu %d)\n", grid_blocks, cus, per_cu);
    }
    if (grid_blocks < 0) return;
    if (hipMemsetAsync((char*)d_ws + WS_MISC + MS_BAR, 0, XCD_BAR_WORDS * 4, stream) != hipSuccess) { fprintf(stderr, "kernel_launch: memset failed\n"); return; }
    Args a{};
    for (int i = 0; i < 24; ++i) a.in[i] = (const float*)d_in[i];
    a.out = (float*)d_out; a.ws = (unsigned char*)d_ws; a.ph_lo = 0; a.ph_hi = 1000;
    void* kargs[] = {&a};
    hipError_t e = hipLaunchCooperativeKernel((const void*)mega_fwd, dim3(grid_blocks), dim3(512), kargs, LDS_BYTES, stream);
    if (e != hipSuccess) fprintf(stderr, "kernel_launch: cooperative launch failed: %s (grid %d)\n", hipGetErrorString(e), grid_blocks);
}
```

```cpp
#include <hip/hip_runtime.h>
#include <hip/hip_cooperative_groups.h>
#include <cstdio>
#include <cstdint>
namespace cg = cooperative_groups;
namespace pg8 {
#define PG8_LAS __attribute__((address_space(3)))
typedef unsigned short bf16_t;
typedef short bf16x8 __attribute__((ext_vector_type(8)));
typedef float f32x4 __attribute__((ext_vector_type(4)));
typedef unsigned u32x4 __attribute__((ext_vector_type(4)));
constexpr int BM = 256, BK = 64, HALF = 128, HTB = HALF * BK * 2  , STAGE_BYTES = 8 * HTB, NXCD = 8, WGM = 16;

__host__ __device__ __forceinline__ int lds_byte(int r, int c) { const int st = (r >> 4) * 2 + (c >> 5), rr = r & 15, cc = c & 31, ob = rr * 64 + cc * 2; return st * 1024 + (ob ^ (((ob >> 9) & 1) << 5)); }
__host__ __device__ __forceinline__ void stage_rc(int b, int& R, int& C) { const int st = b / 1024, sb = b % 1024, swz = sb ^ (((sb >> 9) & 1) << 5); R = (st >> 1) * 16 + swz / 64; C = (st & 1) * 32 + (swz % 64) / 2; }
__host__ __device__ __forceinline__ int perm32(int rho) { const int n = rho >> 4, i = rho & 15; return 8 * (i >> 2) + 4 * n + (i & 3); }

struct Unit { int pm, pn, z; };
struct Gemm { const bf16_t* A; const bf16_t* Bt; int M, N, K, lda; unsigned zA0, zA1, zA2, zA3; unsigned zB;
    __device__ __forceinline__ unsigned za(int z) const { return z == 0 ? zA0 : z == 1 ? zA1 : z == 2 ? zA2 : zA3; } };

struct StaticOrder {
    int nM, nN, nwg, G, c;
    __host__ __device__ void init(int M, int N, int G_, int c_) { nM = M / BM; nN = N / BM; nwg = nM * nN; G = G_; c = c_; }
    __host__ __device__ bool next(int i, Unit& u) const {
        const long L = (long)i * G + c; if (L >= nwg) return false;
        int wgid = (int)L; { const int q = nwg / NXCD, r = nwg % NXCD, xcd = wgid % NXCD, off = wgid / NXCD; wgid = (xcd < r ? xcd * (q + 1) : r * (q + 1) + (xcd - r) * q) + off; }
        const int nig = WGM * nN, gid = wgid / nig, fm = gid * WGM, gsz = (nM - fm) < WGM ? (nM - fm) : WGM;
        u.pm = fm + ((wgid % nig) % gsz); u.pn = (wgid % nig) / gsz; u.z = 0; return true;
    }
    __device__ __forceinline__ void a_ready(const Unit&) const {}
    __device__ __forceinline__ void done(const Unit&) const {}
};

struct BranchOrder {
    StaticOrder S; int nz;
    __host__ __device__ void init(int M, int N, int G_, int c_, int nz_) { S.init(M, N, G_, c_); nz = nz_; }
    __host__ __device__ bool next(int i, Unit& u) const { if (i >= nz) return false; if (!S.next(0, u)) return false; u.z = i; return true; }
    __device__ __forceinline__ void a_ready(const Unit&) const {}
    __device__ __forceinline__ void done(const Unit&) const {}
};

__device__ __forceinline__ unsigned cvt_pk_bf16(float lo, float hi) { unsigned r; asm volatile("v_cvt_pk_bf16_f32 %0, %1, %2" : "=v"(r) : "v"(lo), "v"(hi)); return r; }

template <class Epi, class Sched, bool ALIGN_EPI = false, bool SP2 = false>
__device__ __forceinline__ void gemm_phase(PG8_LAS unsigned char* lds, const Gemm g, const Sched& S, const Epi& E) {
    int tid_l = threadIdx.x; asm volatile("" : "+v"(tid_l));
    const int tid = tid_l, wid = __builtin_amdgcn_readfirstlane(tid >> 6), lane = tid & 63, wr = wid >> 2, wc = wid & 3, fr = lane & 15, fq = lane >> 4;
    const int K = g.K, nt = K / BK;
    unsigned voffA[2], voffB[2];
#pragma unroll
    for (int i = 0; i < 2; ++i) { int R, C; stage_rc(tid * 16 + i * 8192, R, C); const int Rb = Epi::PERM ? ((R & ~31) + perm32(R & 31)) : R;
        voffA[i] = (unsigned)(R * g.lda + C) * 2u; voffB[i] = (unsigned)(Rb * K + C) * 2u; }
    const size_t kstep = (size_t)(BK * 2);
    const size_t hstepA = (size_t)HALF * g.lda * 2, hstepB = (size_t)HALF * K * 2;
    const size_t tstepA = 2 * hstepA, tstepB = 2 * hstepB;
    const unsigned ldsw = (unsigned)wid * 1024u;
    const int aoff = lds_byte(wr * 64 + fr, fq * 8), boff = lds_byte(wc * 32 + fr, fq * 8);
#define PG8_SA(b, h) (((b) * 2 + (h)) * HTB)
#define PG8_SB(b, h) ((4 + (b) * 2 + (h)) * HTB)
#define PG8_STAGE(bufoff, gbase, voff) do { _Pragma("unroll") for (int _i = 0; _i < 2; ++_i) \
        __builtin_amdgcn_global_load_lds((const unsigned*)((const char*)(gbase) + (voff)[_i]), (PG8_LAS unsigned*)(lds + (bufoff) + ldsw + _i * 8192), 16, 0, 0); } while (0)
#define PG8_LDA(dst, b, h) do { _Pragma("unroll") for (int m = 0; m < 4; ++m) _Pragma("unroll") for (int k = 0; k < 2; ++k) dst[m][k] = *(const PG8_LAS bf16x8*)(lds + PG8_SA(b, h) + aoff + m * 2048 + k * 1024); } while (0)
#define PG8_LDB(dst, b, h) do { _Pragma("unroll") for (int n = 0; n < 2; ++n) _Pragma("unroll") for (int k = 0; k < 2; ++k) dst[n][k] = *(const PG8_LAS bf16x8*)(lds + PG8_SB(b, h) + boff + n * 2048 + k * 1024); } while (0)
#define PG8_MMA(ai, bj, At, Bt) do { __builtin_amdgcn_s_setprio(1); _Pragma("unroll") for (int m = 0; m < 4; ++m) _Pragma("unroll") for (int n = 0; n < 2; ++n) _Pragma("unroll") for (int k = 0; k < 2; ++k) \
        acc[ai][bj][m][n] = __builtin_amdgcn_mfma_f32_16x16x32_bf16(Bt[n][k], At[m][k], acc[ai][bj][m][n], 0, 0, 0); __builtin_amdgcn_s_setprio(0); } while (0)
#define PG8_WAIT_V(n) asm volatile("s_waitcnt vmcnt(" #n ")" ::: "memory")
#define PG8_WAIT_L(n) asm volatile("s_waitcnt lgkmcnt(" #n ")" ::: "memory")
#define PG8_BAR __builtin_amdgcn_s_barrier()
#define PG8_SCHED __builtin_amdgcn_sched_barrier(0)
    Unit cur, nxt; int ui = 0;
    if (!S.next(0, cur)) return;
    f32x4 acc[2][2][4][2];
#pragma unroll
    for (int a = 0; a < 2; ++a)
#pragma unroll
        for (int b = 0; b < 2; ++b)
#pragma unroll
            for (int m = 0; m < 4; ++m)
#pragma unroll
                for (int n = 0; n < 2; ++n) acc[a][b][m][n] = (f32x4){0.f, 0.f, 0.f, 0.f};
    bf16x8 At[4][2], B0[2][2], B1[2][2];
    const char* cA = (const char*)g.A + g.za(cur.z) + (size_t)cur.pm * tstepA; const char* cB = (const char*)g.Bt + (size_t)cur.z * g.zB + (size_t)cur.pn * tstepB;
    S.a_ready(cur);
    if constexpr (SP2) {
        PG8_STAGE(PG8_SB(0, 0), cB, voffB); PG8_STAGE(PG8_SB(0, 1), cB + hstepB, voffB); PG8_STAGE(PG8_SA(0, 0), cA, voffA); PG8_STAGE(PG8_SA(0, 1), cA + hstepA, voffA);
        if (wr == 1) PG8_BAR;
        PG8_WAIT_V(2); PG8_BAR;
        PG8_STAGE(PG8_SB(1, 0), cB + kstep, voffB); PG8_STAGE(PG8_SA(1, 0), cA + kstep, voffA); PG8_STAGE(PG8_SB(1, 1), cB + hstepB + kstep, voffB);
        PG8_WAIT_V(6); PG8_BAR;
    } else {
        PG8_STAGE(PG8_SB(0, 0), cB, voffB); PG8_STAGE(PG8_SA(0, 0), cA, voffA); PG8_STAGE(PG8_SB(0, 1), cB + hstepB, voffB); PG8_STAGE(PG8_SA(0, 1), cA + hstepA, voffA);
        if (wr == 1) PG8_BAR;
        PG8_WAIT_V(4); PG8_BAR;
        PG8_STAGE(PG8_SB(1, 0), cB + kstep, voffB); PG8_STAGE(PG8_SA(1, 0), cA + kstep, voffA); PG8_STAGE(PG8_SB(1, 1), cB + hstepB + kstep, voffB);
        PG8_WAIT_V(6); PG8_BAR;
    }
    for (;;) {
        const bool has_next = S.next(ui + 1, nxt);
        const char* nA = has_next ? (const char*)g.A + g.za(nxt.z) + (size_t)nxt.pm * tstepA : cA; const char* nB = has_next ? (const char*)g.Bt + (size_t)nxt.z * g.zB + (size_t)nxt.pn * tstepB : cB;
        for (int t = 0; t < nt; t += 2) {
            const bool last = (t == nt - 2);
            const char* a1 = cA + (size_t)(t + 1) * kstep;
            const char* a2 = last ? nA : cA + (size_t)(t + 2) * kstep; const char* b2 = last ? nB : cB + (size_t)(t + 2) * kstep;
            const char* a3 = a2 + kstep; const char* b3 = b2 + kstep;
            if (last && has_next) S.a_ready(nxt);
            if constexpr (SP2) {
            PG8_LDB(B0, 0, 0); PG8_LDB(B1, 0, 1); PG8_SCHED; PG8_LDA(At, 0, 0); PG8_STAGE(PG8_SA(1, 1), a1 + hstepA, voffA);
            PG8_WAIT_V(8); PG8_WAIT_L(0); PG8_BAR; PG8_MMA(0, 0, At, B0); PG8_MMA(0, 1, At, B1); PG8_BAR; PG8_SCHED;
            PG8_LDA(At, 0, 1); PG8_STAGE(PG8_SB(0, 0), b2, voffB); PG8_STAGE(PG8_SB(0, 1), b2 + hstepB, voffB); PG8_STAGE(PG8_SA(0, 0), a2, voffA);
            PG8_WAIT_V(8); PG8_WAIT_L(0); PG8_BAR; PG8_MMA(1, 0, At, B0); PG8_MMA(1, 1, At, B1); PG8_BAR; PG8_SCHED;
            PG8_LDB(B0, 1, 0); PG8_LDB(B1, 1, 1); PG8_SCHED; PG8_LDA(At, 1, 0); PG8_STAGE(PG8_SA(0, 1), a2 + hstepA, voffA);
            PG8_WAIT_V(8); PG8_WAIT_L(0); PG8_BAR; PG8_MMA(0, 0, At, B0); PG8_MMA(0, 1, At, B1); PG8_BAR; PG8_SCHED;
            PG8_LDA(At, 1, 1); PG8_STAGE(PG8_SB(1, 0), b3, voffB); PG8_STAGE(PG8_SB(1, 1), b3 + hstepB, voffB); PG8_STAGE(PG8_SA(1, 0), a3, voffA);
            PG8_WAIT_V(8); PG8_WAIT_L(0); PG8_BAR; PG8_MMA(1, 0, At, B0); PG8_MMA(1, 1, At, B1); PG8_BAR; PG8_SCHED;
            } else {
            PG8_LDB(B0, 0, 0); PG8_SCHED; PG8_LDA(At, 0, 0); PG8_STAGE(PG8_SA(1, 1), a1 + hstepA, voffA);
            PG8_WAIT_L(8); PG8_BAR; PG8_WAIT_L(0); PG8_MMA(0, 0, At, B0); PG8_BAR; PG8_SCHED;
            PG8_LDB(B1, 0, 1); PG8_STAGE(PG8_SB(0, 0), b2, voffB);
            PG8_BAR; PG8_WAIT_L(0); PG8_MMA(0, 1, At, B1); PG8_BAR;
            PG8_LDA(At, 0, 1); PG8_STAGE(PG8_SA(0, 0), a2, voffA);
            PG8_BAR; PG8_WAIT_L(0); PG8_MMA(1, 0, At, B0); PG8_BAR; PG8_SCHED;
            PG8_STAGE(PG8_SB(0, 1), b2 + hstepB, voffB);
            PG8_WAIT_V(6); PG8_BAR; PG8_MMA(1, 1, At, B1); PG8_BAR;
            PG8_LDB(B0, 1, 0); PG8_SCHED; PG8_LDA(At, 1, 0); PG8_STAGE(PG8_SA(0, 1), a2 + hstepA, voffA);
            PG8_WAIT_L(8); PG8_BAR; PG8_WAIT_L(0); PG8_MMA(0, 0, At, B0); PG8_BAR; PG8_SCHED;
            PG8_LDB(B1, 1, 1); PG8_STAGE(PG8_SB(1, 0), b3, voffB);
            PG8_BAR; PG8_WAIT_L(0); PG8_MMA(0, 1, At, B1); PG8_BAR;
            PG8_LDA(At, 1, 1); PG8_STAGE(PG8_SA(1, 0), a3, voffA);
            PG8_BAR; PG8_WAIT_L(0); PG8_MMA(1, 0, At, B0); PG8_BAR; PG8_SCHED;
            PG8_STAGE(PG8_SB(1, 1), b3 + hstepB, voffB);
            PG8_WAIT_V(6); PG8_BAR; PG8_MMA(1, 1, At, B1); PG8_BAR;
            }
        }
        if constexpr (ALIGN_EPI) { if (wr == 0) PG8_BAR; }
        if constexpr (!Epi::AFTER_DRAIN) { E(acc, cur, wr, wc, fr, fq); S.done(cur); }
        if (!has_next) break;
#pragma unroll
        for (int a = 0; a < 2; ++a)
#pragma unroll
            for (int b = 0; b < 2; ++b)
#pragma unroll
                for (int m = 0; m < 4; ++m)
#pragma unroll
                    for (int n = 0; n < 2; ++n) acc[a][b][m][n] = (f32x4){0.f, 0.f, 0.f, 0.f};
        cur = nxt; cA = nA; cB = nB; ++ui;
        if constexpr (ALIGN_EPI) { if (wr == 1) PG8_BAR; }
    }
    PG8_WAIT_V(0);
    if constexpr (!ALIGN_EPI) { if (wr == 0) PG8_BAR; }
    PG8_BAR;
    if constexpr (Epi::AFTER_DRAIN) { E.fused(acc, cur, wr, wc, fr, fq, lds, wid, lane); S.done(cur); }
#undef PG8_SA
#undef PG8_SB
#undef PG8_STAGE
#undef PG8_LDA
#undef PG8_LDB
#undef PG8_MMA
#undef PG8_WAIT_V
#undef PG8_WAIT_L
#undef PG8_BAR
#undef PG8_SCHED
}
}

namespace pg8 {
__device__ __forceinline__ float bfu_lo(unsigned w) { return __builtin_bit_cast(float, w << 16); }
__device__ __forceinline__ float bfu_hi(unsigned w) { return __builtin_bit_cast(float, w & 0xffff0000u); }
__device__ __forceinline__ float sigmoidf_(float x) { return __builtin_amdgcn_rcpf(1.f + __expf(-x)); }

template <int ACT  > struct EpiStore {
    static constexpr bool PERM = true, AFTER_DRAIN = false;
    bf16_t* O; int ldc; const float* rss;
    __device__ __forceinline__ void operator()(const f32x4 (&acc)[2][2][4][2], const Unit& u, int wr, int wc, int fr, int fq) const {
        const int row0 = u.pm * BM + wr * 64 + fr, col0 = u.pn * BM + wc * 32 + 8 * fq;
#pragma unroll
        for (int ai = 0; ai < 2; ++ai)
#pragma unroll
            for (int m = 0; m < 4; ++m) { bf16_t* rowp = O + (size_t)(row0 + ai * HALF + m * 16) * ldc + col0;
                float rs = 1.f; if (rss) rs = rsqrtf(rss[row0 + ai * HALF + m * 16] * (1.f / 1024.f) + 1e-6f);
#pragma unroll
                for (int bj = 0; bj < 2; ++bj) { f32x4 v0 = acc[ai][bj][m][0] * rs, v1 = acc[ai][bj][m][1] * rs;
                    if (ACT == 1) {
#pragma unroll
                        for (int j = 0; j < 4; ++j) { v0[j] = sigmoidf_(v0[j]); v1[j] = sigmoidf_(v1[j]); } }
                    u32x4 w; w.x = cvt_pk_bf16(v0[0], v0[1]); w.y = cvt_pk_bf16(v0[2], v0[3]); w.z = cvt_pk_bf16(v1[0], v1[1]); w.w = cvt_pk_bf16(v1[2], v1[3]);
                    *(u32x4*)(rowp + bj * HALF) = w; } }
    }
};

typedef unsigned u32x2 __attribute__((ext_vector_type(2)));
__device__ __forceinline__ int gs8_off(int z) { return z < 3 ? 1024 + z * 1024 : 6144; }
struct EpiGate8 {
    static constexpr bool PERM = true, AFTER_DRAIN = false;
    unsigned char* G8; int ldb;
    __device__ __forceinline__ void operator()(const f32x4 (&acc)[2][2][4][2], const Unit& u, int wr, int wc, int fr, int fq) const {
        const int row0 = u.pm * BM + wr * 64 + fr, col0 = gs8_off(u.z) + u.pn * BM + wc * 32 + 8 * fq;
#pragma unroll
        for (int ai = 0; ai < 2; ++ai)
#pragma unroll
            for (int m = 0; m < 4; ++m) { unsigned char* rowp = G8 + (size_t)(row0 + ai * HALF + m * 16) * ldb + col0;
#pragma unroll
                for (int bj = 0; bj < 2; ++bj) { unsigned q[8];
#pragma unroll
                    for (int j = 0; j < 4; ++j) { q[j] = (unsigned)(sigmoidf_(acc[ai][bj][m][0][j]) * 255.f + 0.5f); q[4 + j] = (unsigned)(sigmoidf_(acc[ai][bj][m][1][j]) * 255.f + 0.5f); }
                    u32x2 w; w.x = q[0] | (q[1] << 8) | (q[2] << 16) | (q[3] << 24); w.y = q[4] | (q[5] << 8) | (q[6] << 16) | (q[7] << 24);
                    *(u32x2*)(rowp + bj * HALF) = w; } }
    }
};
struct EpiGateAcc8 {
    static constexpr bool PERM = true, AFTER_DRAIN = false;
    const unsigned char* G8; int ldb; bf16_t* MG; int ld; const float* ssq;
    __device__ __forceinline__ void operator()(const f32x4 (&acc)[2][2][4][2], const Unit& u, int wr, int wc, int fr, int fq) const {
        const int row0 = u.pm * BM + wr * 64 + fr, col0 = u.pn * BM + wc * 32 + 8 * fq, goff = gs8_off(u.z) + col0; const bool first = (u.z == 0);
#pragma unroll
        for (int ai = 0; ai < 2; ++ai)
#pragma unroll
        for (int mh = 0; mh < 2; ++mh) {
            u32x2 gv[4][2]; u32x4 ov[4][2]; float rsv[4];
#pragma unroll
            for (int m = mh * 2; m < mh * 2 + 2; ++m) { const int row = row0 + ai * HALF + m * 16; const size_t ro = (size_t)row * ld + col0;
#pragma unroll
                for (int bj = 0; bj < 2; ++bj) { gv[m][bj] = *(const u32x2*)(G8 + (size_t)row * ldb + goff + bj * HALF); ov[m][bj] = (u32x4){0u, 0u, 0u, 0u}; if (!first) ov[m][bj] = *(const u32x4*)(MG + ro + bj * HALF); }
                rsv[m] = 1.f / 255.f;
                if (u.z == 3) { float sm = 0.f;
#pragma unroll
                    for (int q = 0; q < 8; ++q) { const f32x4 v = *(const f32x4*)(ssq + (size_t)row * 32 + 4 * q); sm += (v[0] + v[1]) + (v[2] + v[3]); }
                    rsv[m] = rsqrtf(sm * (1.f / 512.f) + 1e-6f) * (1.f / 255.f); } }
#pragma unroll
            for (int m = mh * 2; m < mh * 2 + 2; ++m) { const int row = row0 + ai * HALF + m * 16; const size_t ro = (size_t)row * ld + col0; const float rs = rsv[m];
#pragma unroll
                for (int bj = 0; bj < 2; ++bj) { const f32x4 a0 = acc[ai][bj][m][0], a1 = acc[ai][bj][m][1]; const u32x2 g = gv[m][bj]; const u32x4 o = ov[m][bj];
                    float r[8];
                    r[0] = bfu_lo(o.x) + (float)(g.x & 255u) * a0[0] * rs;         r[1] = bfu_hi(o.x) + (float)((g.x >> 8) & 255u) * a0[1] * rs;
                    r[2] = bfu_lo(o.y) + (float)((g.x >> 16) & 255u) * a0[2] * rs; r[3] = bfu_hi(o.y) + (float)(g.x >> 24) * a0[3] * rs;
                    r[4] = bfu_lo(o.z) + (float)(g.y & 255u) * a1[0] * rs;         r[5] = bfu_hi(o.z) + (float)((g.y >> 8) & 255u) * a1[1] * rs;
                    r[6] = bfu_lo(o.w) + (float)((g.y >> 16) & 255u) * a1[2] * rs; r[7] = bfu_hi(o.w) + (float)(g.y >> 24) * a1[3] * rs;
                    u32x4 w; w.x = cvt_pk_bf16(r[0], r[1]); w.y = cvt_pk_bf16(r[2], r[3]); w.z = cvt_pk_bf16(r[4], r[5]); w.w = cvt_pk_bf16(r[6], r[7]);
                    *(u32x4*)(MG + ro + bj * HALF) = w; } }
        }
    }
};

struct EpiGateAcc {
    static constexpr bool PERM = true, AFTER_DRAIN = false;
    const bf16_t* GS; bf16_t* MG; int ld; int first; const float* ssq;
    __device__ __forceinline__ void operator()(const f32x4 (&acc)[2][2][4][2], const Unit& u, int wr, int wc, int fr, int fq) const {
        const int row0 = u.pm * BM + wr * 64 + fr, col0 = u.pn * BM + wc * 32 + 8 * fq;
#pragma unroll
        for (int ai = 0; ai < 2; ++ai)
#pragma unroll
        for (int mh = 0; mh < 2; ++mh) {
            u32x4 gv[4][2], ov[4][2]; float rsv[4];
#pragma unroll
            for (int m = mh * 2; m < mh * 2 + 2; ++m) { const int row = row0 + ai * HALF + m * 16; const size_t ro = (size_t)row * ld + col0;
#pragma unroll
                for (int bj = 0; bj < 2; ++bj) { gv[m][bj] = *(const u32x4*)(GS + ro + bj * HALF); ov[m][bj] = (u32x4){0u, 0u, 0u, 0u}; if (!first) ov[m][bj] = *(const u32x4*)(MG + ro + bj * HALF); }
                rsv[m] = 1.f;
                if (ssq) { float sm = 0.f;
#pragma unroll
                    for (int q = 0; q < 8; ++q) { const f32x4 v = *(const f32x4*)(ssq + (size_t)row * 32 + 4 * q); sm += (v[0] + v[1]) + (v[2] + v[3]); }
                    rsv[m] = rsqrtf(sm * (1.f / 512.f) + 1e-6f); } }
#pragma unroll
            for (int m = mh * 2; m < mh * 2 + 2; ++m) { const int row = row0 + ai * HALF + m * 16; const size_t ro = (size_t)row * ld + col0; const float rs = rsv[m];
#pragma unroll
                for (int bj = 0; bj < 2; ++bj) { const f32x4 a0 = acc[ai][bj][m][0], a1 = acc[ai][bj][m][1]; const u32x4 g = gv[m][bj], o = ov[m][bj];
                    float r[8];
                    r[0] = bfu_lo(o.x) + bfu_lo(g.x) * a0[0] * rs; r[1] = bfu_hi(o.x) + bfu_hi(g.x) * a0[1] * rs;
                    r[2] = bfu_lo(o.y) + bfu_lo(g.y) * a0[2] * rs; r[3] = bfu_hi(o.y) + bfu_hi(g.y) * a0[3] * rs;
                    r[4] = bfu_lo(o.z) + bfu_lo(g.z) * a1[0] * rs; r[5] = bfu_hi(o.z) + bfu_hi(g.z) * a1[1] * rs;
                    r[6] = bfu_lo(o.w) + bfu_lo(g.w) * a1[2] * rs; r[7] = bfu_hi(o.w) + bfu_hi(g.w) * a1[3] * rs;
                    u32x4 w; w.x = cvt_pk_bf16(r[0], r[1]); w.y = cvt_pk_bf16(r[2], r[3]); w.z = cvt_pk_bf16(r[4], r[5]); w.w = cvt_pk_bf16(r[6], r[7]);
                    *(u32x4*)(MG + ro + bj * HALF) = w; } }
        }
    }
};

struct EpiResid {
    static constexpr bool PERM = true, AFTER_DRAIN = false;
    const float* XI; float* XO; bf16_t* XB; float* rowss; int dry;
    __device__ __forceinline__ void operator()(const f32x4 (&acc)[2][2][4][2], const Unit& u, int wr, int wc, int fr, int fq) const {
        const int row0 = u.pm * BM + wr * 64 + fr, col0 = u.pn * BM + wc * 32 + 8 * fq;
#pragma unroll
        for (int ai = 0; ai < 2; ++ai)
#pragma unroll
        for (int mh = 0; mh < 2; ++mh) {
            f32x4 xv[2][2][2];
#pragma unroll
            for (int mm = 0; mm < 2; ++mm) { const size_t ro = (size_t)(row0 + ai * HALF + (mh * 2 + mm) * 16) * 1024 + col0;
#pragma unroll
                for (int bj = 0; bj < 2; ++bj) { xv[mm][bj][0] = *(const f32x4*)(XI + ro + bj * HALF); xv[mm][bj][1] = *(const f32x4*)(XI + ro + bj * HALF + 4); } }
#pragma unroll
            for (int mm = 0; mm < 2; ++mm) { const int m = mh * 2 + mm; const int row = row0 + ai * HALF + m * 16; const size_t ro = (size_t)row * 1024 + col0; float sq = 0.f;
#pragma unroll
                for (int bj = 0; bj < 2; ++bj) {
                    const f32x4 y0 = xv[mm][bj][0] + acc[ai][bj][m][0], y1 = xv[mm][bj][1] + acc[ai][bj][m][1];
                    if (!dry) { *(f32x4*)(XO + ro + bj * HALF) = y0; *(f32x4*)(XO + ro + bj * HALF + 4) = y1; }
                    if (XB && !dry) { u32x4 w; w.x = cvt_pk_bf16(y0[0], y0[1]); w.y = cvt_pk_bf16(y0[2], y0[3]); w.z = cvt_pk_bf16(y1[0], y1[1]); w.w = cvt_pk_bf16(y1[2], y1[3]); *(u32x4*)(XB + ro + bj * HALF) = w;
                        sq += ((y0[0] * y0[0] + y0[1] * y0[1]) + (y0[2] * y0[2] + y0[3] * y0[3])) + ((y1[0] * y1[0] + y1[1] * y1[1]) + (y1[2] * y1[2] + y1[3] * y1[3])); } }
                if (XB && !dry) { sq += __shfl_xor(sq, 16); sq += __shfl_xor(sq, 32); if (fq == 0) atomicAdd(rowss + row, sq); } }
        }
    }
};

struct EpiSwiglu {
    static constexpr bool PERM = true, AFTER_DRAIN = false;
    bf16_t* H; int ldc; const float* rss;
    __device__ __forceinline__ void operator()(const f32x4 (&acc)[2][2][4][2], const Unit& u, int wr, int wc, int fr, int fq) const {
        const int row0 = u.pm * BM + wr * 64 + fr, col0 = u.pn * 128 + wc * 32 + 8 * fq;
#pragma unroll
        for (int ai = 0; ai < 2; ++ai)
#pragma unroll
            for (int m = 0; m < 4; ++m) { bf16_t* rowp = H + (size_t)(row0 + ai * HALF + m * 16) * ldc + col0;
                float rs = 1.f; if (rss) rs = rsqrtf(rss[row0 + ai * HALF + m * 16] * (1.f / 1024.f) + 1e-6f);
                float r[8];
#pragma unroll
                for (int n = 0; n < 2; ++n)
#pragma unroll
                    for (int j = 0; j < 4; ++j) { const float a = acc[ai][0][m][n][j] * rs, b = acc[ai][1][m][n][j] * rs; r[4 * n + j] = a * sigmoidf_(a) * b; }
                u32x4 w; w.x = cvt_pk_bf16(r[0], r[1]); w.y = cvt_pk_bf16(r[2], r[3]); w.z = cvt_pk_bf16(r[4], r[5]); w.w = cvt_pk_bf16(r[6], r[7]);
                *(u32x4*)rowp = w; }
    }
};
}

typedef unsigned short bf16;
typedef float f32x4 __attribute__((ext_vector_type(4)));
typedef unsigned u32x4 __attribute__((ext_vector_type(4)));
typedef unsigned u32x2 __attribute__((ext_vector_type(2)));
#define LAS __attribute__((address_space(3)))
constexpr int NT = 16384, SEQL = 4096, DM = 1024, PW = 5120, INW = 10248, FFH = 2816;
constexpr float EPSN = 1e-6f;
constexpr size_t MiB = 1u << 20;
constexpr size_t WS_W = 0, WS_XN = 48 * MiB, WS_PROJ = 80 * MiB, WS_MISC = 240 * MiB, WS_VT = 248 * MiB, WS_WVT = 280 * MiB, WS_XCT = 284 * MiB, WS_SSQ32 = 308 * MiB, WS_HD = 310 * MiB, WS_HB = 318 * MiB, WS_END = 320 * MiB;
constexpr size_t W_IN = 0, W_G = W_IN + (size_t)5120 * 1024, W_B = W_G + (size_t)4096 * 1024, W_MO = W_B + (size_t)4 * 1024 * 512, W_XQ = W_MO + (size_t)1024 * 1024,
                 W_XKV = W_XQ + (size_t)512 * 1024, W_XO = W_XKV + (size_t)1024 * 1024, W_FI = W_XO + (size_t)1024 * 512, W_FO = W_FI + (size_t)5632 * 1024, W_TOT = W_FO + (size_t)1024 * 2816;
static_assert(W_TOT * 2 <= 48 * MiB, "weights fit");
constexpr size_t MS_DT = 0, MS_SSQ = 512 * 1024, MS_MN = 1 * MiB, MS_KV = 3 * MiB, MS_BAR = 4 * MiB, MS_VTX = 5 * MiB, MS_ROPE = 6 * MiB, MS_CNT = 7 * MiB, MS_FLG = 7 * MiB + 4096, MS_GD = 7 * MiB + 8192;
constexpr int C_AQ = 0, C_AK = 512, C_AV = 1024, C_BQ = 1536, C_BK = 1792, C_BG = 2048, C_CQ = 2560, C_CK = 3072, C_DZ = 3584, C_DX = 4096;
constexpr int VT_C = 0, VT_B = 512;
constexpr int C_GS = 512, C_MG = 4096;
constexpr int LDS_BYTES = 147456;

__device__ __forceinline__ float bf2f(bf16 v) { return __builtin_bit_cast(float, (unsigned)v << 16); }
__device__ __forceinline__ float bflo(unsigned w) { return __builtin_bit_cast(float, w << 16); }
__device__ __forceinline__ float bfhi(unsigned w) { return __builtin_bit_cast(float, w & 0xffff0000u); }
__device__ __forceinline__ unsigned f2bf(float f) { unsigned u = __builtin_bit_cast(unsigned, f); return (u + 0x7fffu + ((u >> 16) & 1u)) >> 16; }
__device__ __forceinline__ unsigned pk2(float lo, float hi) { return f2bf(lo) | (f2bf(hi) << 16); }
__device__ __forceinline__ float wave_sum(float v) {
#pragma unroll
    for (int o = 1; o < 64; o <<= 1) v += __shfl_xor(v, o);
    return v;
}
__device__ __forceinline__ float siluf_(float x) { return x * __builtin_amdgcn_rcpf(1.f + __expf(-x)); }
__device__ __forceinline__ void unpack8(const u32x4 w, float* f) { f[0] = bflo(w.x); f[1] = bfhi(w.x); f[2] = bflo(w.y); f[3] = bfhi(w.y); f[4] = bflo(w.z); f[5] = bfhi(w.z); f[6] = bflo(w.w); f[7] = bfhi(w.w); }

#ifndef PHMASK
#define PHMASK 0xFFFF
#endif
#ifndef DRYMASK
#define DRYMASK 0
#endif
#ifndef XSYNC
#define XSYNC 0
#endif
#ifndef DRYSEG
#define DRYSEG 3
#endif
#ifndef PROBE
#define PROBE 0
#endif
#ifndef PROBE_LO
#define PROBE_LO 0
#define PROBE_HI 2
#endif
#ifndef REPMASK
#define REPMASK 0
#endif
struct Args { const float* in[24]; float* out; unsigned char* ws; int ph_lo, ph_hi; };
typedef const __attribute__((address_space(4))) Args* ArgP;
struct Ctx {
    unsigned char* ws;
    int tid, lane, wave, wg, nwg;
};

__device__ __forceinline__ void conv_w(const Ctx& c, unsigned char* lds_raw, const float* W, int srcN, int K, int Ndst, bf16* WT, int mode, int off, int rot, const float* gk = nullptr) {
    float* T = (float*)lds_raw;
    const int nb = Ndst / 64, kb = K / 64, tot = nb * kb, tid = c.tid;
    int start = c.wg - (rot % c.nwg); if (start < 0) start += c.nwg;
    for (int it = start; it < tot; it += c.nwg) {
        const int n0 = (it % nb) * 64, k0 = (it / nb) * 64;
        {   const int n4 = (tid & 15) * 4, n = n0 + n4;
            const int sc = mode == 0 ? off + n : (((n & 255) < 128) ? (n >> 8) * 128 + (n & 255) : FFH + (n >> 8) * 128 + (n & 255) - 128);
#pragma unroll
            for (int i = 0; i < 2; ++i) { const int kk = (tid >> 4) + 32 * i; f32x4 v = *(const f32x4*)(W + (size_t)(k0 + kk) * srcN + sc);
                if (gk) v = v * gk[k0 + kk];
                T[kk * 65 + n4] = v[0]; T[kk * 65 + n4 + 1] = v[1]; T[kk * 65 + n4 + 2] = v[2]; T[kk * 65 + n4 + 3] = v[3]; } }
        __syncthreads();
        {   const int n = tid >> 3, kc = (tid & 7) * 8; const float* tp = T + kc * 65 + n;
            u32x4 o; o.x = pk2(tp[0], tp[65]); o.y = pk2(tp[130], tp[195]); o.z = pk2(tp[260], tp[325]); o.w = pk2(tp[390], tp[455]);
            *(u32x4*)(WT + (size_t)(n0 + n) * K + k0 + kc) = o; }
        __syncthreads();
    }
}
__device__ __forceinline__ void convert_layer(const Ctx& c, ArgP A, unsigned char* lds_raw, int l) {
    bf16* Wb = (bf16*)(c.ws + WS_W);
    const float* w_in = A->in[3] + (size_t)l * DM * INW;
    conv_w(c, lds_raw, w_in, INW, 1024, 1536, Wb + W_IN, 0, 0, 0);
    conv_w(c, lds_raw, w_in, INW, 1024, 512, Wb + W_IN + (size_t)1536 * 1024, 0, 1536, 16);
    conv_w(c, lds_raw, w_in, INW, 1024, 512, Wb + W_IN + (size_t)2048 * 1024, 0, 2560, 80);
    conv_w(c, lds_raw, w_in, INW, 1024, 1024, Wb + W_IN + (size_t)2560 * 1024, 0, 3072, 144);
    conv_w(c, lds_raw, w_in, INW, 1024, 1536, Wb + W_IN + (size_t)3584 * 1024, 0, 4608, 0);
    conv_w(c, lds_raw, w_in, INW, 1024, 4096, Wb + W_G, 0, 6152, 0);
    conv_w(c, lds_raw, w_in, INW, 1024, 512, (bf16*)(c.ws + WS_WVT), 0, 4096, 192);
    conv_w(c, lds_raw, w_in, INW, 1024, 512, (bf16*)(c.ws + WS_WVT) + (size_t)512 * 1024, 0, 2048, 128);
    for (int i = 0; i < 4; ++i) conv_w(c, lds_raw, A->in[13] + ((size_t)l * 4 + i) * 512 * 1024, 1024, 512, 1024, Wb + W_B + (size_t)i * 1024 * 512, 0, 0, 32 * i);
    conv_w(c, lds_raw, A->in[14] + (size_t)l * 1024 * 1024, 1024, 1024, 1024, Wb + W_MO, 0, 0, 128);
    conv_w(c, lds_raw, A->in[17] + (size_t)l * 1024 * 512, 512, 1024, 512, Wb + W_XQ, 0, 0, 0, A->in[15] + (size_t)l * DM);
    conv_w(c, lds_raw, A->in[18] + (size_t)l * 1024 * 1024, 1024, 1024, 1024, Wb + W_XKV, 0, 0, 128);
    conv_w(c, lds_raw, A->in[19] + (size_t)l * 512 * 1024, 1024, 512, 1024, Wb + W_XO, 0, 0, 0);
    conv_w(c, lds_raw, A->in[21] + (size_t)l * 1024 * 5632, 5632, 1024, 5632, Wb + W_FI, 1, 0, 128, A->in[20] + (size_t)l * DM);
    conv_w(c, lds_raw, A->in[22] + (size_t)l * FFH * 1024, 1024, FFH, 1024, Wb + W_FO, 0, 0, 0);
}

__device__ __forceinline__ void norm_rows(const Ctx& c, const float* X, const float* g, bf16* out, int nrows, const float* Wdt, float* dt_out) {
    const int gw = c.wg * 8 + c.wave, ngw = c.nwg * 8, lane = c.lane;
    f32x4 gv[4];
#pragma unroll
    for (int j = 0; j < 4; ++j) gv[j] = *((const f32x4*)g + lane + 64 * j);
    for (int row = gw; row < nrows; row += ngw) {
        const f32x4* xr = (const f32x4*)(X + (size_t)row * DM) + lane;
        f32x4 v[4]; float s = 0.f;
#pragma unroll
        for (int j = 0; j < 4; ++j) { v[j] = xr[64 * j]; s += (v[j].x * v[j].x + v[j].y * v[j].y) + (v[j].z * v[j].z + v[j].w * v[j].w); }
        const float rs = rsqrtf(wave_sum(s) * (1.f / DM) + EPSN);
        unsigned long long* o8 = (unsigned long long*)(out + (size_t)row * DM) + lane;
#pragma unroll
        for (int j = 0; j < 4; ++j) { v[j] = v[j] * rs * gv[j]; o8[64 * j] = (unsigned long long)pk2(v[j].x, v[j].y) | ((unsigned long long)pk2(v[j].z, v[j].w) << 32); }
        if (Wdt) {
            f32x4 a0 = (f32x4){0.f, 0.f, 0.f, 0.f}, a1 = a0;
#pragma unroll
            for (int j = 0; j < 4; ++j)
#pragma unroll
                for (int e = 0; e < 4; ++e) { const int k = 4 * lane + 256 * j + e; const float* wp = Wdt + k * 8;
                    const f32x4 w0 = *(const f32x4*)wp, w1 = *(const f32x4*)(wp + 4); a0 += w0 * v[j][e]; a1 += w1 * v[j][e]; }
#pragma unroll
            for (int e = 0; e < 4; ++e) { a0[e] = wave_sum(a0[e]); a1[e] = wave_sum(a1[e]); }
            if (lane == 0) { *(f32x4*)(dt_out + (size_t)row * 8) = a0; *(f32x4*)(dt_out + (size_t)row * 8 + 4) = a1; }
        }
    }
}
__device__ __forceinline__ void final_norm(const Ctx& c, float* X, const float* g) {
    const int gw = c.wg * 8 + c.wave, ngw = c.nwg * 8, lane = c.lane;
    for (int row = gw; row < NT; row += ngw) {
        f32x4* xr = (f32x4*)(X + (size_t)row * DM) + lane;
        f32x4 v[4]; float s = 0.f;
#pragma unroll
        for (int j = 0; j < 4; ++j) { v[j] = xr[64 * j]; s += (v[j].x * v[j].x + v[j].y * v[j].y) + (v[j].z * v[j].z + v[j].w * v[j].w); }
        const float rs = rsqrtf(wave_sum(s) * (1.f / DM) + EPSN);
#pragma unroll
        for (int j = 0; j < 4; ++j) xr[64 * j] = v[j] * rs * *((const f32x4*)g + lane + 64 * j);
    }
}

#define OSM_UPDATE(sc, NV, vexpr) do { float _p; if ((sc) > mrun) { const float _r = __expf(mrun - (sc)); lrun *= _r; _Pragma("unroll") for (int _i = 0; _i < NV; ++_i) o[_i] *= _r; mrun = (sc); _p = 1.f; } \
    else _p = __expf((sc) - mrun); lrun += _p; _Pragma("unroll") for (int _i = 0; _i < NV; ++_i) o[_i] += _p * (vexpr); } while (0)

#define WG_BARRIER() asm volatile("s_waitcnt lgkmcnt(0)\n\ts_barrier" ::: "memory")
typedef short bf16x8_t __attribute__((ext_vector_type(8)));
typedef short s16x4_t __attribute__((ext_vector_type(4)));
typedef float f32x2_t __attribute__((ext_vector_type(2)));
typedef __bf16 bf16x2_t __attribute__((ext_vector_type(2)));
#define MFMA16(a, b, c) __builtin_amdgcn_mfma_f32_16x16x32_bf16((a), (b), (c), 0, 0, 0)
__device__ __forceinline__ unsigned cvtpk(float lo, float hi) { f32x2_t v = {lo, hi}; bf16x2_t b = __builtin_convertvector(v, bf16x2_t); return __builtin_bit_cast(unsigned, b); }
__device__ __forceinline__ bf16x8_t pack8(const float* p) { u32x4 w; w.x = cvtpk(p[0], p[1]); w.y = cvtpk(p[2], p[3]); w.z = cvtpk(p[4], p[5]); w.w = cvtpk(p[6], p[7]); return __builtin_bit_cast(bf16x8_t, w); }
__device__ __forceinline__ float ex2(float x) { return __builtin_amdgcn_exp2f(x); }

__device__ __forceinline__ void mixer_c_mfma(const Ctx& c, ArgP A, unsigned char* lds_raw, int l, int dry, unsigned* cnt) {
    bf16* P = (bf16*)(c.ws + WS_PROJ); const bf16* VT = (const bf16*)(c.ws + WS_VT) + (size_t)VT_C * NT;
    unsigned char* sK = lds_raw;
    unsigned char* sV = lds_raw + 64 * 272;
    const float* lp = A->in[5] + (size_t)l * 256;
    float d0 = 0.f, d1 = 0.f;
    for (int i = 0; i < 64; ++i) { d0 += lp[i] * lp[64 + i]; d1 += lp[128 + i] * lp[192 + i]; }
    const float lam_init = 0.8f - 0.6f * expf(-0.3f * (float)l);
    const float lam = expf(d0) - expf(d1) + lam_init;
    const float* sg = A->in[6] + (size_t)l * 128;
    const int tid = c.tid, lane = c.lane, wave = c.wave, fr = lane & 15, fq = lane >> 4;
    constexpr float C2 = 0.125f * 1.4426950408889634f;
    volatile int* sIdx = (volatile int*)(lds_raw + 73728);
    for (;;) {
        __syncthreads();
        if (tid == 0) *sIdx = (int)atomicAdd(cnt, 1u);
        __syncthreads();
        const int u0 = *sIdx; if (u0 >= 512) break;
        const int bh = u0 & 15, qblk = 31 - (u0 >> 4);
        const int b = bh >> 2, h = bh & 3;
        const int qs = qblk * 128 + wave * 16 + fr;
        bf16* qp = P + ((size_t)b * SEQL + qs) * PW + C_CQ + h * 128;
        bf16x8_t qf[2][2];
#pragma unroll
        for (int c2 = 0; c2 < 2; ++c2)
#pragma unroll
            for (int ks = 0; ks < 2; ++ks) qf[c2][ks] = *(const bf16x8_t*)(qp + c2 * 64 + ks * 32 + fq * 8);
        f32x4 oacc[2][8];
#pragma unroll
        for (int c2 = 0; c2 < 2; ++c2)
#pragma unroll
            for (int eb = 0; eb < 8; ++eb) oacc[c2][eb] = (f32x4){0.f, 0.f, 0.f, 0.f};
        float mrun[2] = {-1e30f, -1e30f};
        f32x4 lacc[2] = {(f32x4){0.f, 0.f, 0.f, 0.f}, (f32x4){0.f, 0.f, 0.f, 0.f}};
        unsigned o1_ = 0x3F803F80u; asm volatile("" : "+v"(o1_));
        const u32x4 ones_u = {o1_, o1_, o1_, o1_}; const bf16x8_t ones = __builtin_bit_cast(bf16x8_t, ones_u);
        const int qmax_w = qblk * 128 + wave * 16 + 15;
        const int ntile = 2 * (qblk + 1);
        const size_t rowb0 = (size_t)b * SEQL;
        u32x4 pk[2], pv[2];
#pragma unroll
        for (int i = 0; i < 2; ++i) { const int ch = tid + 512 * i;
            pk[i] = *(const u32x4*)(P + (rowb0 + (ch >> 4)) * PW + C_CK + h * 128 + (ch & 15) * 8);
            pv[i] = *(const u32x4*)(VT + (size_t)(h * 128 + (ch >> 3)) * NT + rowb0 + (ch & 7) * 8); }
        for (int kt = 0; kt < ntile; ++kt) {
            unsigned char* bK = sK + (kt & 1) * 36864; unsigned char* bV = bK + 64 * 272;
#pragma unroll
            for (int i = 0; i < 2; ++i) { const int ch = tid + 512 * i;
                *(u32x4*)(bK + (ch >> 4) * 272 + (ch & 15) * 16) = pk[i]; *(u32x4*)(bV + (ch >> 3) * 144 + (ch & 7) * 16) = pv[i]; }
            if (kt + 1 < ntile) { const size_t rowb = rowb0 + (kt + 1) * 64;
#pragma unroll
                for (int i = 0; i < 2; ++i) { const int ch = tid + 512 * i;
                    pk[i] = *(const u32x4*)(P + (rowb + (ch >> 4)) * PW + C_CK + h * 128 + (ch & 15) * 8);
                    pv[i] = *(const u32x4*)(VT + (size_t)(h * 128 + (ch >> 3)) * NT + rowb + (ch & 7) * 8); } }
            WG_BARRIER();
#pragma unroll
            for (int kb2 = 0; kb2 < 2; ++kb2) {
                const int k0 = kt * 64 + kb2 * 32;
                if (k0 > qmax_w) continue;
                bf16x8_t vf[8];
#pragma unroll
                for (int eb = 0; eb < 8; ++eb) { const unsigned char* vp = bV + (eb * 16 + fr) * 144 + (kb2 * 32 + 4 * fq) * 2;
                    const s16x4_t lo = *(const s16x4_t*)vp, hi = *(const s16x4_t*)(vp + 32); vf[eb] = __builtin_shufflevector(lo, hi, 0, 1, 2, 3, 4, 5, 6, 7); }
#pragma unroll
                for (int c2 = 0; c2 < 2; ++c2) {
                    f32x4 s0 = (f32x4){0.f, 0.f, 0.f, 0.f}, s1 = s0;
#pragma unroll
                    for (int ks = 0; ks < 2; ++ks) { const unsigned char* kp = bK + (kb2 * 32 + fr) * 272 + (c2 * 64 + ks * 32 + fq * 8) * 2;
                        const bf16x8_t ka = *(const bf16x8_t*)kp, kb = *(const bf16x8_t*)(kp + 16 * 272);
                        s0 = MFMA16(ka, qf[c2][ks], s0); s1 = MFMA16(kb, qf[c2][ks], s1); }
                    float sc[8];
                    if (k0 + 31 <= qblk * 128 + wave * 16) {
#pragma unroll
                        for (int j = 0; j < 4; ++j) { sc[j] = s0[j]; sc[4 + j] = s1[j]; }
                    } else {
#pragma unroll
                        for (int j = 0; j < 4; ++j) { const int kp0 = k0 + 4 * fq + j; sc[j] = (kp0 <= qs) ? s0[j] : -1e30f; sc[4 + j] = (kp0 + 16 <= qs) ? s1[j] : -1e30f; }
                    }
                    float mx = fmaxf(fmaxf(fmaxf(sc[0], sc[1]), fmaxf(sc[2], sc[3])), fmaxf(fmaxf(sc[4], sc[5]), fmaxf(sc[6], sc[7])));
                    mx = fmaxf(mx, __shfl_xor(mx, 16)); mx = fmaxf(mx, __shfl_xor(mx, 32));
                    const float mnew = fmaxf(mrun[c2], mx); const float alpha = ex2((mrun[c2] - mnew) * C2); mrun[c2] = mnew; const float nm = -mnew * C2;
                    float p[8];
#pragma unroll
                    for (int i = 0; i < 8; ++i) p[i] = ex2(__builtin_fmaf(sc[i], C2, nm));
                    const bf16x8_t pf = pack8(p);
                    if (__any(alpha != 1.f)) { lacc[c2] = lacc[c2] * alpha;
#pragma unroll
                        for (int eb = 0; eb < 8; ++eb) oacc[c2][eb] = oacc[c2][eb] * alpha; }
#pragma unroll
                    for (int eb = 0; eb < 8; ++eb) oacc[c2][eb] = MFMA16(vf[eb], pf, oacc[c2][eb]);
                    lacc[c2] = MFMA16(ones, pf, lacc[c2]);
                }
            }
        }
        float linv[2];
#pragma unroll
        for (int c2 = 0; c2 < 2; ++c2) linv[c2] = 1.f / lacc[c2][0];
        float ss = 0.f;
#pragma unroll
        for (int eb = 0; eb < 8; ++eb) { oacc[0][eb] = oacc[0][eb] * linv[0] - oacc[1][eb] * (lam * linv[1]);
            ss += (oacc[0][eb][0] * oacc[0][eb][0] + oacc[0][eb][1] * oacc[0][eb][1]) + (oacc[0][eb][2] * oacc[0][eb][2] + oacc[0][eb][3] * oacc[0][eb][3]); }
        ss += __shfl_xor(ss, 16); ss += __shfl_xor(ss, 32);
        const float rs = rsqrtf(ss * (1.f / 128.f) + EPSN) * (1.f - lam_init);
#pragma unroll
        for (int eb = 0; eb < 8; ++eb) { const int e0 = eb * 16 + 4 * fq; const f32x4 g4 = *(const f32x4*)(sg + e0);
            const unsigned lo = cvtpk(oacc[0][eb][0] * rs * g4[0], oacc[0][eb][1] * rs * g4[1]), hi = cvtpk(oacc[0][eb][2] * rs * g4[2], oacc[0][eb][3] * rs * g4[3]);
            if (!dry) *(unsigned long long*)(qp + e0) = (unsigned long long)lo | ((unsigned long long)hi << 32); }
    }
    __syncthreads();
}

typedef short v4i16_t __attribute__((ext_vector_type(4)));
__device__ __forceinline__ s16x4_t lds_tr16(const LAS unsigned char* p) { return __builtin_bit_cast(s16x4_t, __builtin_amdgcn_ds_read_tr16_b64_v4i16((LAS v4i16_t*)p)); }
__device__ __forceinline__ void mixer_a_mfma(const Ctx& c, unsigned char* lds_raw, int dry, unsigned* cnt) {
    bf16* P = (bf16*)(c.ws + WS_PROJ);
    const int lane = c.lane, fr = lane & 15, fq = lane >> 4;
    LAS unsigned char* wl = (LAS unsigned char*)lds_raw + c.wave * 4608;
    const LAS unsigned char* trp = wl + (4 * fq + (fr >> 2)) * 144 + (fr & 3) * 8;
    constexpr float C2 = 0.125f * 1.4426950408889634f;
    for (;;) {
        int g = 0; if (lane == 0) g = (int)atomicAdd(cnt, 1u); g = __shfl(g, 0); if (g >= 4096) break;
        const int r8 = g & 7, h = (g >> 3) & 7, blk = (g >> 6) & 15, b = g >> 10;
        const int sbase0 = blk * 256 + r8;
        const size_t tb = (size_t)b * SEQL;
        bf16* qp0 = P + (tb + sbase0 + 16 * fr) * PW + C_AQ + h * 64;
        bf16x8_t qf[2][2];
#pragma unroll
        for (int gq = 0; gq < 2; ++gq)
#pragma unroll
            for (int ks = 0; ks < 2; ++ks) qf[gq][ks] = *(const bf16x8_t*)(qp0 + (size_t)gq * 8 * PW + ks * 32 + fq * 8);
        f32x4 oacc[2][4];
#pragma unroll
        for (int gq = 0; gq < 2; ++gq)
#pragma unroll
            for (int eb = 0; eb < 4; ++eb) oacc[gq][eb] = (f32x4){0.f, 0.f, 0.f, 0.f};
        float mrun[2] = {-1e30f, -1e30f}, lrun[2] = {0.f, 0.f};
        for (int st = 0; st < 28; ++st) {
            int sh, m0, boff, gmask;
            if (st < 12) { sh = 0; m0 = -128 + 32 * st; boff = 0; gmask = 3; }
            else if (st < 18) { sh = 2; m0 = -128 + 32 * (st - 12); boff = 0; gmask = 3; }
            else if (st < 23) { sh = 4; m0 = -128 + 32 * (st - 18); boff = 0; gmask = 1; }
            else { sh = 4; m0 = -128 + 32 * (st - 23); boff = 8; gmask = 2; }
            const int d = 1 << sh, kb0 = sbase0 + boff;
            if (kb0 + d * (m0 + 31) < 0) continue;
            u32x4 vr[4];
#pragma unroll
            for (int i = 0; i < 4; ++i) { const int cch = lane + 64 * i, rr = cch >> 3, part = cch & 7; int tk = kb0 + d * (m0 + rr); tk = min(max(tk, 0), SEQL - 1);
                vr[i] = *(const u32x4*)(P + (tb + tk) * PW + C_AV + h * 64 + part * 8); }
            int tk0 = kb0 + d * (m0 + fr), tk1 = tk0 + 16 * d;
            tk0 = min(max(tk0, 0), SEQL - 1); tk1 = min(max(tk1, 0), SEQL - 1);
            const bf16* k0p = P + (tb + tk0) * PW + C_AK + h * 64 + fq * 8; const bf16* k1p = P + (tb + tk1) * PW + C_AK + h * 64 + fq * 8;
            bf16x8_t ka[2], kb[2];
#pragma unroll
            for (int ks = 0; ks < 2; ++ks) { ka[ks] = *(const bf16x8_t*)(k0p + ks * 32); kb[ks] = *(const bf16x8_t*)(k1p + ks * 32); }
#pragma unroll
            for (int i = 0; i < 4; ++i) { const int cch = lane + 64 * i, rr = cch >> 3, part = cch & 7; *(LAS u32x4*)(wl + rr * 144 + part * 16) = vr[i]; }
            bf16x8_t vf[4];
#pragma unroll
            for (int eb = 0; eb < 4; ++eb) { const s16x4_t lo = lds_tr16(trp + eb * 32), hi = lds_tr16(trp + 16 * 144 + eb * 32); vf[eb] = __builtin_shufflevector(lo, hi, 0, 1, 2, 3, 4, 5, 6, 7); }
#pragma unroll
            for (int gq = 0; gq < 2; ++gq) {
                if (!((gmask >> gq) & 1)) continue;
                const int qm = (8 * gq - boff + 16 * fr) >> sh;
                f32x4 s0 = (f32x4){0.f, 0.f, 0.f, 0.f}, s1 = s0;
#pragma unroll
                for (int ks = 0; ks < 2; ++ks) { s0 = MFMA16(ka[ks], qf[gq][ks], s0); s1 = MFMA16(kb[ks], qf[gq][ks], s1); }
                float sc[8]; bool vis[8];
#pragma unroll
                for (int j = 0; j < 4; ++j) { const int m = m0 + 4 * fq + j; const int dj0 = qm - m, dj1 = dj0 - 16; const int t0 = kb0 + d * m, t1 = t0 + 16 * d;
                    vis[j] = (dj0 >= 0) && (dj0 <= 128) && (t0 >= 0); vis[4 + j] = (dj1 >= 0) && (dj1 <= 128) && (t1 >= 0);
                    sc[j] = vis[j] ? s0[j] : -1e30f; sc[4 + j] = vis[4 + j] ? s1[j] : -1e30f; }
                float mx = fmaxf(fmaxf(fmaxf(sc[0], sc[1]), fmaxf(sc[2], sc[3])), fmaxf(fmaxf(sc[4], sc[5]), fmaxf(sc[6], sc[7])));
                mx = fmaxf(mx, __shfl_xor(mx, 16)); mx = fmaxf(mx, __shfl_xor(mx, 32));
                const float mnew = fmaxf(mrun[gq], mx); const float alpha = ex2((mrun[gq] - mnew) * C2); mrun[gq] = mnew; const float nm = -mnew * C2;
                float pr[8], ps = 0.f;
#pragma unroll
                for (int i = 0; i < 8; ++i) { pr[i] = vis[i] ? ex2(__builtin_fmaf(sc[i], C2, nm)) : 0.f; ps += pr[i]; }
                lrun[gq] = lrun[gq] * alpha + ps;
                const bf16x8_t pf = pack8(pr);
#pragma unroll
                for (int eb = 0; eb < 4; ++eb) { oacc[gq][eb] = oacc[gq][eb] * alpha; oacc[gq][eb] = MFMA16(vf[eb], pf, oacc[gq][eb]); }
            }
        }
#pragma unroll
        for (int gq = 0; gq < 2; ++gq) {
            float lt = lrun[gq]; lt += __shfl_xor(lt, 16); lt += __shfl_xor(lt, 32); const float linv = 1.f / lt;
            bf16* qp = qp0 + (size_t)gq * 8 * PW;
#pragma unroll
            for (int eb = 0; eb < 4; ++eb) { const unsigned lo = cvtpk(oacc[gq][eb][0] * linv, oacc[gq][eb][1] * linv), hi = cvtpk(oacc[gq][eb][2] * linv, oacc[gq][eb][3] * linv);
                if (!dry) *(unsigned long long*)(qp + eb * 16 + 4 * fq) = (unsigned long long)lo | ((unsigned long long)hi << 32); }
        }
    }
}

typedef __attribute__((address_space(1))) unsigned long long gu64_t;
typedef __attribute__((address_space(1))) unsigned gu32_t;
typedef unsigned long long u64x2_t __attribute__((ext_vector_type(2)));
__device__ __forceinline__ void st_pub16(void* p, const f32x4 v) {
    const u64x2_t q = __builtin_bit_cast(u64x2_t, v);
    __hip_atomic_store((gu64_t*)p, q[0], __ATOMIC_RELAXED, __HIP_MEMORY_SCOPE_AGENT);
    __hip_atomic_store((gu64_t*)((char*)p + 8), q[1], __ATOMIC_RELAXED, __HIP_MEMORY_SCOPE_AGENT);
}
__device__ __forceinline__ f32x4 ld_pub16(const void* p) {
    const unsigned long long a = __hip_atomic_load((gu64_t*)p, __ATOMIC_RELAXED, __HIP_MEMORY_SCOPE_AGENT), b = __hip_atomic_load((gu64_t*)p + 1, __ATOMIC_RELAXED, __HIP_MEMORY_SCOPE_AGENT);
    f32x4 v; v[0] = __builtin_bit_cast(float, (unsigned)a); v[1] = __builtin_bit_cast(float, (unsigned)(a >> 32)); v[2] = __builtin_bit_cast(float, (unsigned)b); v[3] = __builtin_bit_cast(float, (unsigned)(b >> 32)); return v;
}
__device__ __forceinline__ void pub_flag(unsigned* flag, unsigned epoch, int tid) {
    asm volatile("s_waitcnt vmcnt(0)" ::: "memory");
    __syncthreads();
    if (tid == 0) __hip_atomic_store((gu32_t*)flag, epoch, __ATOMIC_RELAXED, __HIP_MEMORY_SCOPE_AGENT);
}
__device__ __forceinline__ void wait_flags(unsigned* flags, int n, unsigned epoch, int wave) {
    if (wave == 0) {
        for (int i = 0; i < n; ++i) { unsigned sp = 0;
            while (__hip_atomic_load((gu32_t*)(flags + i), __ATOMIC_RELAXED, __HIP_MEMORY_SCOPE_AGENT) != epoch) { __builtin_amdgcn_s_sleep(2); if (++sp > (1u << 22)) break; } }
        __builtin_amdgcn_fence(__ATOMIC_ACQUIRE, "agent");
        asm volatile("s_waitcnt vmcnt(0)" ::: "memory");
    }
    __syncthreads();
}

struct BLoad { u32x4 x0, x1; f32x4 rp[4]; bf16x8_t vf[2]; s16x4_t vl[2], vh[2]; u32x2 gt[4]; };
__device__ __forceinline__ void b_issue(BLoad& L, const bf16* P, const float* rope, const bf16* vrow, int b, int h, int ch, int tid, int w, int fr, int fq) {
    const int s0 = ch * 64; const size_t t0 = (size_t)b * SEQL + s0;
    const int which = tid >> 8, tk = (tid >> 2) & 63, c4 = tid & 3;
    const bf16* src = P + (t0 + tk) * PW + (which ? C_BK : C_BQ) + h * 64 + 8 * c4;
    L.x0 = *(const u32x4*)src; L.x1 = *(const u32x4*)(src + 32);
    const float* rp = rope + ((size_t)(s0 + tk) * 32 + 8 * c4) * 2;
#pragma unroll
    for (int q = 0; q < 4; ++q) L.rp[q] = *(const f32x4*)(rp + 4 * q);
#pragma unroll
    for (int ks = 0; ks < 2; ++ks) { L.vf[ks] = *(const bf16x8_t*)(vrow + s0 + ks * 32 + fq * 8); L.vl[ks] = *(const s16x4_t*)(vrow + s0 + ks * 32 + 4 * fq); L.vh[ks] = *(const s16x4_t*)(vrow + s0 + ks * 32 + 16 + 4 * fq); }
#pragma unroll
    for (int qb = 0; qb < 4; ++qb) L.gt[qb] = *(const u32x2*)(P + (t0 + qb * 16 + fr) * PW + C_BG + h * 128 + 16 * w + 4 * fq);
}
__device__ __forceinline__ void mixer_b_mfma(const Ctx& c, ArgP A, unsigned char* lds_raw, int l, int unit, int seg, int dry) {
    constexpr int NSEG = 4, CPS = 16;
    const int c0 = seg * CPS, n1 = (seg < NSEG - 1) ? CPS : 0, nv = n1 + CPS;
    float* hloc = (float*)(c.ws + WS_HB); unsigned* flg = (unsigned*)(c.ws + WS_MISC + MS_FLG) + 128 + unit * NSEG;
    bf16* P = (bf16*)(c.ws + WS_PROJ); const bf16* VTb = (const bf16*)(c.ws + WS_VT) + (size_t)VT_B * NT;
    const float* rope = (const float*)(c.ws + WS_MISC + MS_ROPE);
    unsigned char* sQ = lds_raw;
    unsigned char* sK = lds_raw + 9216;
    unsigned char* sKT0 = lds_raw + 18432;
    unsigned char* sP = lds_raw + 36864;
    float* sSt = (float*)(lds_raw + 45056);
    const int b = unit >> 2, h = unit & 3, tid = c.tid, lane = c.lane, w = c.wave, fr = lane & 15, fq = lane >> 4;
    const float lg = log2f(1.f - exp2f(-5.f - (float)h));
    const float* gn = A->in[4] + (size_t)l * 512 + h * 128;
    f32x4 R[4];
#pragma unroll
    for (int i = 0; i < 4; ++i) R[i] = (f32x4){0.f, 0.f, 0.f, 0.f};
    const bf16* vrow = VTb + (size_t)(h * 128 + 16 * w + fr) * NT + (size_t)b * SEQL;
    const int which = tid >> 8, tk_s = (tid >> 2) & 63, c4 = tid & 3;
    BLoad nx; b_issue(nx, P, rope, vrow, b, h, c0, tid, w, fr, fq);
    for (int v = 0; v < nv; ++v) {
        if (v == n1) {
            int lane_l = lane; asm volatile("" : "+v"(lane_l));
            if (n1 > 0) {
                char* pb_ = (char*)hloc + (unsigned)((((unit * NSEG + seg) * 8 + w) * 4) * 64 + lane_l) * 16u;
#pragma unroll
                for (int db = 0; db < 4; ++db) st_pub16(pb_ + db * 1024, R[db]);
                pub_flag(flg + seg, (unsigned)(l + 1), tid);
            }
#pragma unroll
            for (int db = 0; db < 4; ++db) R[db] = (f32x4){0.f, 0.f, 0.f, 0.f};
            if (seg > 0) {
                wait_flags(flg, seg, (unsigned)(l + 1), w);
                const float gg = ex2(64.f * (float)CPS * lg);
#pragma unroll 1
                for (int sp = 0; sp < seg; ++sp) { const char* cb_ = (const char*)hloc + (unsigned)((((unit * NSEG + sp) * 8 + w) * 4) * 64 + lane_l) * 16u;
#pragma unroll
                    for (int db = 0; db < 4; ++db) R[db] = R[db] * gg + *(const f32x4*)(cb_ + db * 1024); }
            }
        }
        const int ch = c0 + (v < n1 ? v : v - n1);
        const int s0 = ch * 64; const size_t t0 = (size_t)b * SEQL + s0;
        const bool full = v >= n1;
        unsigned char* sKT = sKT0 + (v & 1) * 9216;
        const BLoad cu = nx;
        {
            float xa[8], xb[8], r1[8], r2[8]; unpack8(cu.x0, xa); unpack8(cu.x1, xb);
#pragma unroll
            for (int e = 0; e < 8; ++e) { const float cs = cu.rp[e >> 1][(e & 1) * 2], sn = cu.rp[e >> 1][(e & 1) * 2 + 1]; r1[e] = xa[e] * cs - xb[e] * sn; r2[e] = xa[e] * sn + xb[e] * cs; }
            if (which == 0) { if (full) { *(bf16x8_t*)(sQ + tk_s * 144 + c4 * 16) = pack8(r1); *(bf16x8_t*)(sQ + tk_s * 144 + 64 + c4 * 16) = pack8(r2); } }
            else {
#pragma unroll
                for (int e = 0; e < 8; ++e) { r1[e] *= 0.125f; r2[e] *= 0.125f; }
                if (full) { *(bf16x8_t*)(sK + tk_s * 144 + c4 * 16) = pack8(r1); *(bf16x8_t*)(sK + tk_s * 144 + 64 + c4 * 16) = pack8(r2); }
                const float dk = ex2((float)(63 - tk_s) * lg);
#pragma unroll
                for (int e = 0; e < 8; ++e) { *(bf16*)(sKT + (8 * c4 + e) * 144 + tk_s * 2) = (bf16)f2bf(r1[e] * dk); *(bf16*)(sKT + (32 + 8 * c4 + e) * 144 + tk_s * 2) = (bf16)f2bf(r2[e] * dk); } }
        }
        if (v + 1 < nv) b_issue(nx, P, rope, vrow, b, h, c0 + (v + 1 < n1 ? v + 1 : v + 1 - n1), tid, w, fr, fq);
        WG_BARRIER();
        if (full && w < 6) {
            const int qb = (w == 0) ? 0 : (w == 1) ? 1 : (w < 4) ? 2 : 3, kp = (w == 3 || w == 5) ? 1 : 0;
            f32x4 sa = (f32x4){0.f, 0.f, 0.f, 0.f}, sb = sa;
            const bool two = (2 * kp + 1) <= qb;
#pragma unroll
            for (int ks = 0; ks < 2; ++ks) { const bf16x8_t qf = *(const bf16x8_t*)(sQ + (qb * 16 + fr) * 144 + (ks * 32 + fq * 8) * 2);
                const bf16x8_t ka = *(const bf16x8_t*)(sK + (kp * 32 + fr) * 144 + (ks * 32 + fq * 8) * 2);
                sa = MFMA16(ka, qf, sa);
                if (two) { const bf16x8_t kb = *(const bf16x8_t*)(sK + (kp * 32 + 16 + fr) * 144 + (ks * 32 + fq * 8) * 2); sb = MFMA16(kb, qf, sb); } }
            float p[8]; const int qi = qb * 16 + fr;
#pragma unroll
            for (int j = 0; j < 4; ++j) { const int k0 = kp * 32 + 4 * fq + j, k1 = k0 + 16;
                p[j] = (k0 <= qi) ? sa[j] * ex2((float)(qi - k0) * lg) : 0.f; p[4 + j] = (k1 <= qi) ? sb[j] * ex2((float)(qi - k1) * lg) : 0.f; }
            *(bf16x8_t*)(sP + (qb * 2 + kp) * 1024 + lane * 16) = pack8(p);
        }
        f32x4 acc[4];
        if (full) {
            bf16x8_t Rop[2];
#pragma unroll
            for (int ks = 0; ks < 2; ++ks) { float t8[8];
#pragma unroll
                for (int j = 0; j < 4; ++j) { t8[j] = R[2 * ks][j]; t8[4 + j] = R[2 * ks + 1][j]; }
                Rop[ks] = pack8(t8); }
#pragma unroll
            for (int qb = 0; qb < 4; ++qb) { acc[qb] = (f32x4){0.f, 0.f, 0.f, 0.f};
#pragma unroll
                for (int ks = 0; ks < 2; ++ks) { const unsigned char* qp = sQ + (qb * 16 + fr) * 144 + (ks * 32 + 4 * fq) * 2;
                    const s16x4_t lo = *(const s16x4_t*)qp, hi = *(const s16x4_t*)(qp + 32);
                    acc[qb] = MFMA16(Rop[ks], __builtin_shufflevector(lo, hi, 0, 1, 2, 3, 4, 5, 6, 7), acc[qb]); }
                acc[qb] = acc[qb] * ex2((float)(qb * 16 + fr + 1) * lg); }
        }
        {
            f32x4 kvn[4];
#pragma unroll
            for (int db = 0; db < 4; ++db) kvn[db] = (f32x4){0.f, 0.f, 0.f, 0.f};
#pragma unroll
            for (int ks = 0; ks < 2; ++ks) {
#pragma unroll
                for (int db = 0; db < 4; ++db) { const bf16x8_t kt = *(const bf16x8_t*)(sKT + (db * 16 + fr) * 144 + (ks * 32 + fq * 8) * 2); kvn[db] = MFMA16(kt, cu.vf[ks], kvn[db]); } }
            const float g64 = ex2(64.f * lg);
#pragma unroll
            for (int db = 0; db < 4; ++db) R[db] = R[db] * g64 + kvn[db];
        }
        if (full) {
        WG_BARRIER();
#pragma unroll
        for (int qb = 0; qb < 4; ++qb)
#pragma unroll
            for (int kp = 0; kp < 2; ++kp) { if (2 * kp > qb) continue;
                const bf16x8_t pf = *(const bf16x8_t*)(sP + (qb * 2 + kp) * 1024 + lane * 16);
                acc[qb] = MFMA16(__builtin_shufflevector(cu.vl[kp], cu.vh[kp], 0, 1, 2, 3, 4, 5, 6, 7), pf, acc[qb]); }
#pragma unroll
        for (int qb = 0; qb < 4; ++qb) { float s1 = (acc[qb][0] + acc[qb][1]) + (acc[qb][2] + acc[qb][3]);
            float s2 = (acc[qb][0] * acc[qb][0] + acc[qb][1] * acc[qb][1]) + (acc[qb][2] * acc[qb][2] + acc[qb][3] * acc[qb][3]);
            s1 += __shfl_xor(s1, 16); s1 += __shfl_xor(s1, 32); s2 += __shfl_xor(s2, 16); s2 += __shfl_xor(s2, 32);
            if (fq == 0) { sSt[((qb * 16 + fr) * 8 + w) * 2] = s1; sSt[((qb * 16 + fr) * 8 + w) * 2 + 1] = s2; } }
        WG_BARRIER();
#pragma unroll
        for (int qb = 0; qb < 4; ++qb) { const int tk = qb * 16 + fr; float s1 = 0.f, s2 = 0.f;
#pragma unroll
            for (int ww = 0; ww < 8; ww += 2) { const f32x4 v = *(const f32x4*)(sSt + (tk * 8 + ww) * 2); s1 += v[0] + v[2]; s2 += v[1] + v[3]; }
            const float mu = s1 * (1.f / 128.f); const float var = fmaxf(s2 * (1.f / 128.f) - mu * mu, 0.f); const float rstd = rsqrtf(var + EPSN);
            const int e0 = 16 * w + 4 * fq; bf16* gp = P + (t0 + tk) * PW + C_BG + h * 128 + e0;
            const u32x2 gw = cu.gt[qb]; const f32x4 g4 = *(const f32x4*)(gn + e0);
            const float y0 = siluf_(bflo(gw.x)) * (acc[qb][0] - mu) * rstd * g4[0], y1 = siluf_(bfhi(gw.x)) * (acc[qb][1] - mu) * rstd * g4[1];
            const float y2 = siluf_(bflo(gw.y)) * (acc[qb][2] - mu) * rstd * g4[2], y3 = siluf_(bfhi(gw.y)) * (acc[qb][3] - mu) * rstd * g4[3];
            u32x2 o; o.x = cvtpk(y0, y1); o.y = cvtpk(y2, y3); if (!dry) *(u32x2*)gp = o; }
        }
    }
    __syncthreads();
}

#define XB_TMO      128
#define XB_XCNT(j)  (256  + 64 * (j))
#define XB_XSUB(j)  (1280 + 64 * (j))
#define XB_XGEN(j)  (2304 + 64 * (j))
#define XB_TOP      3328
#define XB_TOPGEN   3392
#define XCD_BAR_WORDS 3456
#define XB_SPIN_CAP (1u << 23)

__device__ __forceinline__ unsigned xb_ld(unsigned* p)              { return __hip_atomic_load(p, __ATOMIC_RELAXED, __HIP_MEMORY_SCOPE_AGENT); }
__device__ __forceinline__ unsigned xb_add(unsigned* p, unsigned v) { return __hip_atomic_fetch_add(p, v, __ATOMIC_RELAXED, __HIP_MEMORY_SCOPE_AGENT); }
__device__ __forceinline__ unsigned xb_xcc_id() { return (unsigned)__builtin_amdgcn_s_getreg((3 << 11) | 20) & 0xFu; }
#define XB_SPIN(cond, bar) do { unsigned _sp = 0; while (cond) { __builtin_amdgcn_s_sleep(1); \
    if ((++_sp & 255u) == 0u) { if (xb_ld(&(bar)[XB_TMO])) break; if (_sp > XB_SPIN_CAP) { atomicAdd(&(bar)[XB_TMO], 1u); break; } } } } while (0)

struct XcdBarrier {
    unsigned* bar; unsigned x;
    volatile LAS unsigned* st;
};

__device__ __forceinline__ XcdBarrier xcd_barrier_post(unsigned* bar, volatile LAS unsigned* st) {
    XcdBarrier b; b.bar = bar; b.x = xb_xcc_id(); b.st = st;
    if (threadIdx.x == 0) (void)xb_add(&bar[XB_XCNT(b.x)], 1u);
    return b;
}
__device__ __forceinline__ void xcd_barrier_complete(unsigned* bar, unsigned x, unsigned& nloc, unsigned& nx) {
    const unsigned G = gridDim.x * gridDim.y * gridDim.z;
    unsigned sum, cnt, mine, sp = 0u;
    for (;;) {
        sum = 0u; cnt = 0u; mine = 0u;
#pragma unroll
        for (unsigned j = 0; j < 16; ++j) { const unsigned c = xb_ld(&bar[XB_XCNT(j)]); sum += c; cnt += (c > 0u) ? 1u : 0u; mine = (j == x) ? c : mine; }
        if (sum == G) break;
        __builtin_amdgcn_s_sleep(1);
        if ((++sp & 255u) == 0u) { if (xb_ld(&bar[XB_TMO])) break; if (sp > XB_SPIN_CAP) { atomicAdd(&bar[XB_TMO], 1u); break; } }
    }
    nloc = mine > 0u ? mine : 1u; nx = cnt > 0u ? cnt : 1u;
}

__device__ __forceinline__ void xcd_barrier(const XcdBarrier& b) {
    asm volatile("s_waitcnt vmcnt(0)" ::: "memory");
    __syncthreads();
    if (threadIdx.x == 0) {
        unsigned* bar = b.bar;
        __builtin_amdgcn_s_waitcnt(0);
        unsigned nloc = b.st[0], nx = b.st[1];
        if (nloc == 0u) { xcd_barrier_complete(bar, b.x, nloc, nx); b.st[0] = nloc; b.st[1] = nx; }
        const unsigned old = xb_add(&bar[XB_XSUB(b.x)], 1u);
        const unsigned gen = old / nloc;
        if (old + 1u == (gen + 1u) * nloc) {
            __builtin_amdgcn_fence(__ATOMIC_RELEASE, "agent");
            asm volatile("s_waitcnt vmcnt(0)" ::: "memory");
            const unsigned og = xb_add(&bar[XB_TOP], 1u);
            const unsigned tg = og / nx;
            if (og + 1u == (tg + 1u) * nx) xb_add(&bar[XB_TOPGEN], 1u);
            else XB_SPIN(xb_ld(&bar[XB_TOPGEN]) == tg, bar);
            __builtin_amdgcn_fence(__ATOMIC_ACQUIRE, "agent");
            xb_add(&bar[XB_XGEN(b.x)], 1u);
            asm volatile("s_waitcnt vmcnt(0)" ::: "memory");
        } else {
            XB_SPIN(xb_ld(&bar[XB_XGEN(b.x)]) == gen, bar);
            __builtin_amdgcn_fence(__ATOMIC_ACQUIRE, "agent");
            asm volatile("s_waitcnt vmcnt(0)" ::: "memory");
        }
    }
    __syncthreads();
}

#define CONV_GRID_BAR() do { XcdBarrier xb_; xb_.bar = (unsigned*)(ws + WS_MISC + MS_BAR); xb_.x = xb_xcc_id(); xb_.st = (volatile LAS unsigned*)((LAS unsigned char*)lds + LDS_BYTES - 64); xcd_barrier(xb_); } while (0)
__device__ __forceinline__ void conv_prepass(const Ctx& c, ArgP A, int l, unsigned char* ws, unsigned char* lds, int dry) {
    bf16* P = (bf16*)(c.ws + WS_PROJ); bf16* XCT = (bf16*)(c.ws + WS_XCT);
    const int item = c.wg * 512 + c.tid; const bool act = item < 131072;
    const int cg8 = item & 127, run = (item >> 7) & 1023, ch0 = cg8 * 8;
    const size_t tok0 = (size_t)run * 16; const int s_in = (int)(tok0 & (SEQL - 1));
    unsigned outp[16][4];
    if (act) {
        const float* cw = A->in[7] + (size_t)l * 4 * 1024 + ch0; const float* cb = A->in[8] + (size_t)l * 1024 + ch0;
        float wt[4][8], bias[8];
#pragma unroll
        for (int k = 0; k < 8; ++k) { bias[k] = cb[k];
#pragma unroll
            for (int w = 0; w < 4; ++w) wt[w][k] = cw[w * 1024 + k]; }
        float win[3][8];
#pragma unroll
        for (int r = 0; r < 3; ++r) {
            if (s_in == 0) {
#pragma unroll
                for (int k = 0; k < 8; ++k) win[r][k] = 0.f; }
            else unpack8(*(const u32x4*)(P + (tok0 - 3 + r) * PW + C_DX + ch0), win[r]); }
#pragma unroll
        for (int tk = 0; tk < 16; ++tk) { float cur[8]; unpack8(*(const u32x4*)(P + (tok0 + tk) * PW + C_DX + ch0), cur); float o[8];
#pragma unroll
            for (int k = 0; k < 8; ++k) { const float a = bias[k] + wt[0][k] * win[0][k] + wt[1][k] * win[1][k] + wt[2][k] * win[2][k] + wt[3][k] * cur[k]; o[k] = siluf_(a);
                win[0][k] = win[1][k]; win[1][k] = win[2][k]; win[2][k] = cur[k]; }
#pragma unroll
            for (int q = 0; q < 4; ++q) outp[tk][q] = cvtpk(o[2 * q], o[2 * q + 1]); }
        if (cg8 < 96) {
#pragma unroll
            for (int q = 0; q < 4; ++q) { u32x4 lo0, lo1, hi0, hi1;
#pragma unroll
                for (int m = 0; m < 4; ++m) { const unsigned a0 = outp[2 * m][q], a1 = outp[2 * m + 1][q], b0 = outp[8 + 2 * m][q], b1 = outp[8 + 2 * m + 1][q];
                    lo0[m] = (a0 & 0xffffu) | (a1 << 16); hi0[m] = (a0 >> 16) | (a1 & 0xffff0000u); lo1[m] = (b0 & 0xffffu) | (b1 << 16); hi1[m] = (b0 >> 16) | (b1 & 0xffff0000u); }
                bf16* r0 = XCT + (size_t)(ch0 + 2 * q) * NT + tok0; bf16* r1 = r0 + NT;
                *(u32x4*)r0 = lo0; *(u32x4*)(r0 + 8) = lo1; *(u32x4*)r1 = hi0; *(u32x4*)(r1 + 8) = hi1; } }
    }
    CONV_GRID_BAR();
    if (act && !dry) {
#pragma unroll
        for (int tk = 0; tk < 16; ++tk) { u32x4 o; o.x = outp[tk][0]; o.y = outp[tk][1]; o.z = outp[tk][2]; o.w = outp[tk][3]; *(u32x4*)(P + (tok0 + tk) * PW + C_DX + ch0) = o; }
    }
}

struct DLoad { u32x4 bc[4]; u32x4 bt[2]; float dtr; u32x4 xf[2]; s16x4_t xl[2], xh[2]; };
__device__ __forceinline__ void d_issue(DLoad& L, const bf16* P, const bf16* XCT, const float* dtr, unsigned xoff, int b, int g, int head, int head_s, int pb, int ch, int tid, int lane, int w, int fr, int fq) {
    const char* Pc = (const char*)P; const char* Xc = (const char*)XCT; const char* Dc = (const char*)dtr;
    const unsigned s0 = (unsigned)ch * 64u, t0 = (unsigned)b * SEQL + s0;
#pragma unroll
    for (int r = 0; r < 4; ++r) { const unsigned cn = tid + 512 * r, which = cn >> 10, tk = (cn >> 4) & 63, cc = cn & 15;
        L.bc[r] = *(const u32x4*)(Pc + ((t0 + tk) * PW + C_DX + 512 + which * 256 + g * 128 + cc * 8) * 2u); }
#pragma unroll
    for (int r = 0; r < 2; ++r) { const unsigned cn = tid + 512 * r, n = cn >> 3, cc = cn & 7; L.bt[r] = *(const u32x4*)(Xc + ((512u + g * 128 + n) * NT + t0 + cc * 8) * 2u); }
    L.dtr = (w < 2) ? *(const float*)(Dc + ((t0 + lane) * 8u + head_s) * 4u) : 0.f;
#pragma unroll
    for (int ks = 0; ks < 2; ++ks) { L.xf[ks] = *(const u32x4*)(Xc + xoff + (s0 + ks * 32 + fq * 8) * 2u); L.xl[ks] = *(const s16x4_t*)(Xc + xoff + (s0 + ks * 32 + 4 * fq) * 2u); L.xh[ks] = *(const s16x4_t*)(Xc + xoff + (s0 + ks * 32 + 16 + 4 * fq) * 2u); }
}
__device__ __forceinline__ void mixer_d_mfma(const Ctx& c, ArgP A, unsigned char* lds_raw, int l, int unit, int seg, int dry) {
    constexpr int NSEG = 4, CPS = 16;
    const int c0 = seg * CPS, n1 = (seg < NSEG - 1) ? CPS : 0, nv = n1 + CPS;
    float* hloc = (float*)(c.ws + WS_HD); unsigned* flg = (unsigned*)(c.ws + WS_MISC + MS_FLG) + unit * NSEG; float* gdl = (float*)(c.ws + WS_MISC + MS_GD) + unit * NSEG * 2;
    float gsum = 0.f;
    bf16* P = (bf16*)(c.ws + WS_PROJ); const bf16* XCT = (const bf16*)(c.ws + WS_XCT);
    unsigned char* sB = lds_raw;
    unsigned char* sC = lds_raw + 17408;
    unsigned char* sBT0 = lds_raw + 34816;
    unsigned char* sS = lds_raw + 71680;
    float* sDt = (float*)(lds_raw + 81920);
    float* sAc = sDt + 256;
    const int b = unit >> 2, pair = unit & 3, g = pair >> 1;
    const int tid = c.tid, lane = c.lane, w = c.wave, fr = lane & 15, fq = lane >> 4, hh = w >> 2, pb = w & 3, head = pair * 2 + hh;
    constexpr float L2E = 1.4426950408889634f;
    const int head_s = pair * 2 + (w & 1);
    const float* p_dtb = A->in[9] + l * 8 + head_s; const float* p_al = A->in[10] + l * 8 + head_s; const float* p_dsk = A->in[11] + l * 8 + head;
    const float* p_g4 = A->in[12] + (size_t)l * 512 + head * 64 + pb * 16 + 4 * fq;
    const float* dtr = (const float*)(c.ws + WS_MISC + MS_DT); float* ssq = (float*)(c.ws + WS_SSQ32);
    f32x4 H[8];
#pragma unroll
    for (int i = 0; i < 8; ++i) H[i] = (f32x4){0.f, 0.f, 0.f, 0.f};
    const unsigned xoff = ((unsigned)(head * 64 + pb * 16 + fr) * NT + (unsigned)b * SEQL) * 2u;
    DLoad nx; d_issue(nx, P, XCT, dtr, xoff, b, g, head, head_s, pb, c0, tid, lane, w, fr, fq);
    for (int v = 0; v < nv; ++v) {
        if (v == n1) {
            int lane_l = lane; asm volatile("" : "+v"(lane_l));
            if (n1 > 0) {
                char* pb_ = (char*)hloc + (unsigned)((((unit * NSEG + seg) * 8 + w) * 8) * 64 + lane_l) * 16u;
#pragma unroll
                for (int nb = 0; nb < 8; ++nb) st_pub16(pb_ + nb * 1024, H[nb]);
                if (pb == 0 && lane == 0) __hip_atomic_store((gu32_t*)(gdl + seg * 2 + hh), __builtin_bit_cast(unsigned, gsum), __ATOMIC_RELAXED, __HIP_MEMORY_SCOPE_AGENT);
                pub_flag(flg + seg, (unsigned)(l + 1), tid);
            }
#pragma unroll
            for (int nb = 0; nb < 8; ++nb) H[nb] = (f32x4){0.f, 0.f, 0.f, 0.f};
            if (seg > 0) {
                wait_flags(flg, seg, (unsigned)(l + 1), w);
#pragma unroll 1
                for (int sp = 0; sp < seg; ++sp) { const float gg = ex2(gdl[sp * 2 + hh]);
                    const char* cb_ = (const char*)hloc + (unsigned)((((unit * NSEG + sp) * 8 + w) * 8) * 64 + lane_l) * 16u;
#pragma unroll
                    for (int nb = 0; nb < 8; ++nb) H[nb] = H[nb] * gg + *(const f32x4*)(cb_ + nb * 1024); }
            }
        }
        const int ch = c0 + (v < n1 ? v : v - n1);
        const int s0 = ch * 64, par = v & 1; const size_t t0 = (size_t)b * SEQL + s0;
        const bool full = v >= n1;
        unsigned char* sBT = sBT0 + par * 18432;
        const DLoad cu = nx;
        if (full) {
#pragma unroll
            for (int r = 0; r < 4; ++r) { const int cn = tid + 512 * r, which = cn >> 10, tk = (cn >> 4) & 63, cc = cn & 15; *(u32x4*)((which ? sC : sB) + tk * 272 + cc * 16) = cu.bc[r]; } }
#pragma unroll
        for (int r = 0; r < 2; ++r) { const int cn = tid + 512 * r, n = cn >> 3, cc = cn & 7; *(u32x4*)(sBT + n * 144 + cc * 16) = cu.bt[r]; }
        if (w < 2) { const float x = cu.dtr + *p_dtb; const float dt = fmaxf(x, 0.f) + log1pf(__expf(-fabsf(x)));
            float a = dt * (-__expf(*p_al)) * L2E;
#pragma unroll
            for (int off = 1; off < 64; off <<= 1) { const float v = __shfl_up(a, off); if (lane >= off) a += v; }
            sDt[(par * 2 + w) * 64 + lane] = dt; sAc[(par * 2 + w) * 64 + lane] = a; }
        if (v + 1 < nv) d_issue(nx, P, XCT, dtr, xoff, b, g, head, head_s, pb, c0 + (v + 1 < n1 ? v + 1 : v + 1 - n1), tid, lane, w, fr, fq);
        WG_BARRIER();
        const float* dtv = sDt + (par * 2 + hh) * 64; const float* acv = sAc + (par * 2 + hh) * 64;
        f32x4 acc[4];
        if (full) {
        for (int ti = w; ti < 10; ti += 8) { const int qb = (ti >= 6) ? 3 : (ti >= 3) ? 2 : (ti >= 1) ? 1 : 0, kb = ti - qb * (qb + 1) / 2;
            f32x4 sacc = (f32x4){0.f, 0.f, 0.f, 0.f};
#pragma unroll
            for (int ks = 0; ks < 4; ++ks) { const bf16x8_t bfv = *(const bf16x8_t*)(sB + (kb * 16 + fr) * 272 + (ks * 32 + fq * 8) * 2), cfv = *(const bf16x8_t*)(sC + (qb * 16 + fr) * 272 + (ks * 32 + fq * 8) * 2);
                sacc = MFMA16(bfv, cfv, sacc); }
            *(f32x4*)(sS + ti * 1024 + lane * 16) = sacc; }
        {
            bf16x8_t Hop[4];
#pragma unroll
            for (int ks = 0; ks < 4; ++ks) { float t8[8];
#pragma unroll
                for (int j = 0; j < 4; ++j) { t8[j] = H[2 * ks][j]; t8[4 + j] = H[2 * ks + 1][j]; }
                Hop[ks] = pack8(t8); }
#pragma unroll
            for (int qb = 0; qb < 4; ++qb) { acc[qb] = (f32x4){0.f, 0.f, 0.f, 0.f};
#pragma unroll
                for (int ks = 0; ks < 4; ++ks) { const unsigned char* cp = sC + (qb * 16 + fr) * 272 + (ks * 32 + 4 * fq) * 2;
                    const s16x4_t lo = *(const s16x4_t*)cp, hi = *(const s16x4_t*)(cp + 32);
                    acc[qb] = MFMA16(Hop[ks], __builtin_shufflevector(lo, hi, 0, 1, 2, 3, 4, 5, 6, 7), acc[qb]); }
                acc[qb] = acc[qb] * ex2(acv[qb * 16 + fr]); }
        }
        }
        {
            const float aend = acv[63]; if (!full) gsum += aend;
            bf16x8_t xw[2];
#pragma unroll
            for (int ks = 0; ks < 2; ++ks) { float xv[8]; unpack8(cu.xf[ks], xv);
                const f32x4 d0 = *(const f32x4*)(dtv + ks * 32 + fq * 8), d1 = *(const f32x4*)(dtv + ks * 32 + fq * 8 + 4), a0 = *(const f32x4*)(acv + ks * 32 + fq * 8), a1 = *(const f32x4*)(acv + ks * 32 + fq * 8 + 4);
#pragma unroll
                for (int j = 0; j < 4; ++j) { xv[j] *= d0[j] * ex2(aend - a0[j]); xv[4 + j] *= d1[j] * ex2(aend - a1[j]); }
                xw[ks] = pack8(xv); }
            const float ge = ex2(aend);
#pragma unroll
            for (int nh = 0; nh < 2; ++nh) {
                f32x4 kvn[4];
#pragma unroll
                for (int nb = 0; nb < 4; ++nb) kvn[nb] = (f32x4){0.f, 0.f, 0.f, 0.f};
#pragma unroll
                for (int ks = 0; ks < 2; ++ks)
#pragma unroll
                    for (int nb = 0; nb < 4; ++nb) { const bf16x8_t bt = *(const bf16x8_t*)(sBT + ((nh * 4 + nb) * 16 + fr) * 144 + (ks * 32 + fq * 8) * 2); kvn[nb] = MFMA16(bt, xw[ks], kvn[nb]); }
#pragma unroll
                for (int nb = 0; nb < 4; ++nb) H[nh * 4 + nb] = H[nh * 4 + nb] * ge + kvn[nb];
            }
        }
        if (full) {
        WG_BARRIER();
        u32x2 xr[4], zr[4];
#pragma unroll
        for (int qb = 0; qb < 4; ++qb) { const unsigned t = (unsigned)t0 + qb * 16 + fr; const unsigned p0 = head * 64 + pb * 16 + 4 * fq;
            xr[qb] = *(const u32x2*)((const char*)P + (t * PW + C_DX + p0) * 2u); zr[qb] = *(const u32x2*)((const char*)P + (t * PW + C_DZ + p0) * 2u); }
#pragma unroll
        for (int qb = 0; qb < 4; ++qb) { const int qi = qb * 16 + fr; const float aq = acv[qi];
#pragma unroll
            for (int kp = 0; kp < 2; ++kp) { if (2 * kp > qb) continue;
                const int ti = qb * (qb + 1) / 2 + 2 * kp; const bool two = (2 * kp + 1) <= qb;
                const f32x4 sa = *(const f32x4*)(sS + ti * 1024 + lane * 16); f32x4 sb = (f32x4){0.f, 0.f, 0.f, 0.f}; if (two) sb = *(const f32x4*)(sS + (ti + 1) * 1024 + lane * 16);
                const int k0 = kp * 32 + 4 * fq;
                const f32x4 da = *(const f32x4*)(dtv + k0), db = *(const f32x4*)(dtv + k0 + 16), aa = *(const f32x4*)(acv + k0), ab = *(const f32x4*)(acv + k0 + 16);
                float p[8];
#pragma unroll
                for (int j = 0; j < 4; ++j) { p[j] = (k0 + j <= qi) ? sa[j] * da[j] * ex2(aq - aa[j]) : 0.f; p[4 + j] = (k0 + 16 + j <= qi) ? sb[j] * db[j] * ex2(aq - ab[j]) : 0.f; }
                acc[qb] = MFMA16(__builtin_shufflevector(cu.xl[kp], cu.xh[kp], 0, 1, 2, 3, 4, 5, 6, 7), pack8(p), acc[qb]); } }
        const float Dsk = *p_dsk; const f32x4 g4 = *(const f32x4*)p_g4;
#pragma unroll
        for (int qb = 0; qb < 4; ++qb) { const unsigned t = (unsigned)t0 + qb * 16 + fr; const unsigned p0 = head * 64 + pb * 16 + 4 * fq;
            const u32x2 xw = xr[qb]; bf16* zp = (bf16*)((char*)P + (t * PW + C_DZ + p0) * 2u); const u32x2 zw = zr[qb];
            const float y0 = (acc[qb][0] + Dsk * bflo(xw.x)) * siluf_(bflo(zw.x)), y1 = (acc[qb][1] + Dsk * bfhi(xw.x)) * siluf_(bfhi(zw.x));
            const float y2 = (acc[qb][2] + Dsk * bflo(xw.y)) * siluf_(bflo(zw.y)), y3 = (acc[qb][3] + Dsk * bfhi(xw.y)) * siluf_(bfhi(zw.y));
            float sq = (y0 * y0 + y1 * y1) + (y2 * y2 + y3 * y3); sq += __shfl_xor(sq, 16); sq += __shfl_xor(sq, 32);
            if (fq == 0 && !dry) ssq[t * 32 + head * 4 + pb] = sq;
            u32x2 o; o.x = cvtpk(y0 * g4[0], y1 * g4[1]); o.y = cvtpk(y2 * g4[2], y3 * g4[3]); if (!dry) *(u32x2*)zp = o; }
        }
    }
    __syncthreads();
}

__device__ __forceinline__ void xattn_mfma(const Ctx& c, unsigned char* lds_raw) {
    const bf16* XQ = (const bf16*)(c.ws + WS_PROJ); bf16* AO = (bf16*)(c.ws + WS_PROJ + 16 * MiB);
    const bf16* KX = (const bf16*)(c.ws + WS_MISC + MS_KV);
    const bf16* VTX = (const bf16*)(c.ws + WS_MISC + MS_VTX);
    unsigned char* sK = lds_raw;
    unsigned char* sV = lds_raw + 256 * 272;
    const int tid = c.tid, lane = c.lane, fr = lane & 15, fq = lane >> 4;
    constexpr float C2 = 0.08838834764831845f * 1.4426950408889634f;
    for (int u = c.wg; u < 256; u += c.nwg) {
        const int b = u >> 6, h = (u >> 4) & 3, tq = u & 15;
        __syncthreads();
#pragma unroll
        for (int i = 0; i < 8; ++i) { const int ch = tid + 512 * i;
            { const int rr = ch >> 4, cc = ch & 15; *(u32x4*)(sK + rr * 272 + cc * 16) = *(const u32x4*)(KX + (size_t)(b * 256 + rr) * 512 + h * 128 + cc * 8); }
            { const int e = ch >> 5, cc = ch & 31; *(u32x4*)(sV + e * 528 + cc * 16) = *(const u32x4*)(VTX + (size_t)(h * 128 + e) * 1024 + b * 256 + cc * 8); } }
        __syncthreads();
#pragma unroll 1
        for (int gi = 0; gi < 2; ++gi) {
            const size_t t = (size_t)b * SEQL + tq * 256 + (c.wave * 2 + gi) * 16 + fr;
            bf16x8_t qf[4];
#pragma unroll
            for (int ks = 0; ks < 4; ++ks) qf[ks] = *(const bf16x8_t*)(XQ + t * 512 + h * 128 + ks * 32 + fq * 8);
            f32x4 oacc[8];
#pragma unroll
            for (int eb = 0; eb < 8; ++eb) oacc[eb] = (f32x4){0.f, 0.f, 0.f, 0.f};
            float mrun = -1e30f, lrun = 0.f;
#pragma unroll 2
            for (int kp = 0; kp < 8; ++kp) {
                const unsigned char* k0p = sK + (kp * 32 + fr) * 272 + fq * 16;
                f32x4 s0 = (f32x4){0.f, 0.f, 0.f, 0.f}, s1 = s0;
#pragma unroll
                for (int ks = 0; ks < 4; ++ks) { const bf16x8_t ka = *(const bf16x8_t*)(k0p + ks * 64), kb = *(const bf16x8_t*)(k0p + 16 * 272 + ks * 64);
                    s0 = MFMA16(ka, qf[ks], s0); s1 = MFMA16(kb, qf[ks], s1); }
                float sc[8];
#pragma unroll
                for (int j = 0; j < 4; ++j) { sc[j] = s0[j]; sc[4 + j] = s1[j]; }
                float mx = fmaxf(fmaxf(fmaxf(sc[0], sc[1]), fmaxf(sc[2], sc[3])), fmaxf(fmaxf(sc[4], sc[5]), fmaxf(sc[6], sc[7])));
                mx = fmaxf(mx, __shfl_xor(mx, 16)); mx = fmaxf(mx, __shfl_xor(mx, 32));
                const float mnew = fmaxf(mrun, mx); const float alpha = ex2((mrun - mnew) * C2); mrun = mnew; const float nm = -mnew * C2;
                float pr[8], ps = 0.f;
#pragma unroll
                for (int i = 0; i < 8; ++i) { pr[i] = ex2(__builtin_fmaf(sc[i], C2, nm)); ps += pr[i]; }
                lrun = lrun * alpha + ps;
                const bf16x8_t pf = pack8(pr);
#pragma unroll
                for (int eb = 0; eb < 8; ++eb) { const unsigned char* vp = sV + (eb * 16 + fr) * 528 + (kp * 32 + 4 * fq) * 2;
                    const s16x4_t lo = *(const s16x4_t*)vp, hi = *(const s16x4_t*)(vp + 32);
                    oacc[eb] = oacc[eb] * alpha; oacc[eb] = MFMA16(__builtin_shufflevector(lo, hi, 0, 1, 2, 3, 4, 5, 6, 7), pf, oacc[eb]); }
            }
            float lt = lrun; lt += __shfl_xor(lt, 16); lt += __shfl_xor(lt, 32); const float linv = 1.f / lt;
            bf16* op = AO + t * 512 + h * 128 + 4 * fq;
#pragma unroll
            for (int eb = 0; eb < 8; ++eb) { u32x2 o; o.x = cvtpk(oacc[eb][0] * linv, oacc[eb][1] * linv); o.y = cvtpk(oacc[eb][2] * linv, oacc[eb][3] * linv); *(u32x2*)(op + eb * 16) = o; }
        }
    }
    __syncthreads();
}

__device__ __forceinline__ void mixer_b_naive(const Ctx& c, ArgP A, unsigned char* lds_raw, int l, int unit) {
    bf16* P = (bf16*)(c.ws + WS_PROJ); const bf16* VTb = (const bf16*)(c.ws + WS_VT) + (size_t)VT_B * NT;
    float* sQ = (float*)lds_raw;
    float* sKk = sQ + 32 * 64;
    float* sVv = sKk + 32 * 64;
    float* sP = sVv + 32 * 128;
    const int b = unit >> 2, h = unit & 3, tid = c.tid, e = tid & 127, dg = tid >> 7;
    const float gamma = 1.f - exp2f(-5.f - (float)h);
    const float* gn = A->in[4] + (size_t)l * 512 + h * 128;
    float S[16];
#pragma unroll
    for (int i = 0; i < 16; ++i) S[i] = 0.f;
    for (int s0 = 0; s0 < SEQL; s0 += 32) {
        const size_t t0 = (size_t)b * SEQL + s0;
#pragma unroll
        for (int r = 0; r < 4; ++r) { const int it = tid + 512 * r, which = it >> 10, st = (it >> 5) & 31, i = it & 31;
            const bf16* src = P + (t0 + st) * PW + (which ? C_BK : C_BQ) + h * 64;
            const float t1 = bf2f(src[i]), t2 = bf2f(src[i + 32]);
            const float invf = powf(10000.f, -(float)i / 32.f); const float ang = (float)(s0 + st) * invf;
            float sn, cs; sincosf(ang, &sn, &cs);
            const float sc = which ? 0.125f : 1.f; float* dst = (which ? sKk : sQ) + st * 64;
            dst[i] = (t1 * cs - t2 * sn) * sc; dst[i + 32] = (t1 * sn + t2 * cs) * sc; }
#pragma unroll
        for (int r = 0; r < 8; ++r) { const int it = tid + 512 * r, st = it >> 7, ee = it & 127; sVv[st * 128 + ee] = bf2f(VTb[(size_t)(h * 128 + ee) * NT + t0 + st]); }
        __syncthreads();
        for (int st = 0; st < 32; ++st) {
            const float vv = sVv[st * 128 + e]; float po = 0.f;
#pragma unroll
            for (int i4 = 0; i4 < 4; ++i4) { const f32x4 kk = *(const f32x4*)(sKk + st * 64 + dg * 16 + 4 * i4), qq = *(const f32x4*)(sQ + st * 64 + dg * 16 + 4 * i4);
#pragma unroll
                for (int j = 0; j < 4; ++j) { S[4 * i4 + j] = gamma * S[4 * i4 + j] + kk[j] * vv; po += qq[j] * S[4 * i4 + j]; } }
            sP[(st * 4 + dg) * 128 + e] = po;
        }
        __syncthreads();
#pragma unroll
        for (int r = 0; r < 4; ++r) { const int st = c.wave * 4 + r, lane = c.lane;
            float o0 = 0.f, o1 = 0.f;
#pragma unroll
            for (int g = 0; g < 4; ++g) { o0 += sP[(st * 4 + g) * 128 + lane]; o1 += sP[(st * 4 + g) * 128 + lane + 64]; }
            const float mu = wave_sum(o0 + o1) * (1.f / 128.f); const float a0 = o0 - mu, a1 = o1 - mu;
            const float var = wave_sum(a0 * a0 + a1 * a1) * (1.f / 128.f); const float rstd = rsqrtf(var + EPSN);
            bf16* gp = P + (t0 + st) * PW + C_BG + h * 128;
            const float g0 = bf2f(gp[lane]), g1 = bf2f(gp[lane + 64]);
            gp[lane] = (bf16)f2bf(siluf_(g0) * a0 * rstd * gn[lane]); gp[lane + 64] = (bf16)f2bf(siluf_(g1) * a1 * rstd * gn[lane + 64]); }
    }
    __syncthreads();
}

__device__ __forceinline__ void mixer_d_naive(const Ctx& c, ArgP A, unsigned char* lds_raw, int l, int unit) {
    bf16* P = (bf16*)(c.ws + WS_PROJ);
    float* sXs = (float*)lds_raw;
    float* sB = sXs + 32 * 64;
    float* sC = sB + 32 * 128;
    float* sDt = sC + 32 * 128;
    float* sA = sDt + 32;
    float* sP = sA + 32;
    const int b = unit >> 3, hd = unit & 7, g = hd >> 2, tid = c.tid, p = tid & 63, ng = tid >> 6;
    const float* cw = A->in[7] + (size_t)l * 4 * 1024; const float* cb = A->in[8] + (size_t)l * 1024;
    const float dtb = A->in[9][l * 8 + hd], Aneg = -expf(A->in[10][l * 8 + hd]), Dsk = A->in[11][l * 8 + hd];
    const float* ng_ = A->in[12] + (size_t)l * 512 + hd * 64;
    const float* dtr = (const float*)(c.ws + WS_MISC + MS_DT); float* ssq = (float*)(c.ws + WS_MISC + MS_SSQ);
    float S[16];
#pragma unroll
    for (int i = 0; i < 16; ++i) S[i] = 0.f;
    for (int s0 = 0; s0 < SEQL; s0 += 32) {
        const size_t t0 = (size_t)b * SEQL + s0;
        for (int it = tid; it < 32 * 320; it += 512) { const int st = it / 320, ch = it % 320;
            int cc; float* dst;
            if (ch < 64) { cc = hd * 64 + ch; dst = sXs + st * 64 + ch; } else if (ch < 192) { cc = 512 + g * 128 + (ch - 64); dst = sB + st * 128 + (ch - 64); } else { cc = 768 + g * 128 + (ch - 192); dst = sC + st * 128 + (ch - 192); }
            float a = cb[cc];
#pragma unroll
            for (int w = 0; w < 4; ++w) { const int sp = s0 + st - 3 + w; if (sp >= 0) a += cw[w * 1024 + cc] * bf2f(P[((size_t)b * SEQL + sp) * PW + C_DX + cc]); }
            *dst = siluf_(a); }
        if (tid < 32) { const float x = dtr[(t0 + tid) * 8 + hd] + dtb; const float dt = fmaxf(x, 0.f) + log1pf(__expf(-fabsf(x))); sDt[tid] = dt; sA[tid] = __expf(dt * Aneg); }
        __syncthreads();
        for (int st = 0; st < 32; ++st) {
            const float a = sA[st], xdt = sDt[st] * sXs[st * 64 + p]; float po = 0.f;
#pragma unroll
            for (int i4 = 0; i4 < 4; ++i4) { const f32x4 bb = *(const f32x4*)(sB + st * 128 + ng * 16 + 4 * i4), cc4 = *(const f32x4*)(sC + st * 128 + ng * 16 + 4 * i4);
#pragma unroll
                for (int j = 0; j < 4; ++j) { S[4 * i4 + j] = a * S[4 * i4 + j] + bb[j] * xdt; po += cc4[j] * S[4 * i4 + j]; } }
            sP[(st * 8 + ng) * 64 + p] = po;
        }
        __syncthreads();
#pragma unroll
        for (int r = 0; r < 4; ++r) { const int st = c.wave * 4 + r, lane = c.lane;
            float y = 0.f;
#pragma unroll
            for (int q = 0; q < 8; ++q) y += sP[(st * 8 + q) * 64 + lane];
            y += Dsk * sXs[st * 64 + lane];
            bf16* zp = P + (t0 + st) * PW + C_DZ + hd * 64;
            const float yz = y * siluf_(bf2f(zp[lane]));
            const float sq = wave_sum(yz * yz);
            if (lane == 0) ssq[(t0 + st) * 8 + hd] = sq;
            zp[lane] = (bf16)f2bf(yz * ng_[lane]); }
    }
    __syncthreads();
}

__device__ __forceinline__ void xattn_naive(const Ctx& c) {
    const bf16* XQ = (const bf16*)(c.ws + WS_PROJ); bf16* AO = (bf16*)(c.ws + WS_PROJ + 16 * MiB);
    const bf16* KV = (const bf16*)(c.ws + WS_MISC + MS_KV);
    for (int item = c.wg * 512 + c.tid; item < NT * 8; item += c.nwg * 512) {
        const int w = item >> 6, h = w & 3, t = (w >> 2) * 32 + ((item & 63) >> 1), half = item & 1, b = t >> 12;
        const bf16* qp = XQ + (size_t)t * 512 + h * 128 + half * 64;
        float q[64], o[64];
#pragma unroll
        for (int i = 0; i < 8; ++i) { float f[8]; unpack8(*(const u32x4*)(qp + 8 * i), f);
#pragma unroll
            for (int j = 0; j < 8; ++j) { q[8 * i + j] = f[j] * 0.08838834764831845f; o[8 * i + j] = 0.f; } }
        float mrun = -1e30f, lrun = 0.f;
        for (int m = 0; m < 256; ++m) {
            const bf16* kr = KV + (size_t)(b * 256 + m) * 1024 + h * 128 + half * 64; const bf16* vr = kr + 512;
            float sc = 0.f;
#pragma unroll
            for (int i = 0; i < 8; ++i) { float f[8]; unpack8(*(const u32x4*)(kr + 8 * i), f);
#pragma unroll
                for (int jj = 0; jj < 8; ++jj) sc += q[8 * i + jj] * f[jj]; }
            sc += __shfl_xor(sc, 1);
            float p_; if (sc > mrun) { const float r = __expf(mrun - sc); lrun *= r;
#pragma unroll
                for (int i = 0; i < 64; ++i) o[i] *= r;
                mrun = sc; p_ = 1.f; } else p_ = __expf(sc - mrun);
            lrun += p_;
#pragma unroll
            for (int i = 0; i < 8; ++i) { float f[8]; unpack8(*(const u32x4*)(vr + 8 * i), f);
#pragma unroll
                for (int jj = 0; jj < 8; ++jj) o[8 * i + jj] += p_ * f[jj]; }
        }
        const float inv = 1.f / lrun;
        bf16* op = AO + (size_t)t * 512 + h * 128 + half * 64;
#pragma unroll
        for (int i = 0; i < 8; ++i) { u32x4 wv; wv.x = pk2(o[8 * i] * inv, o[8 * i + 1] * inv); wv.y = pk2(o[8 * i + 2] * inv, o[8 * i + 3] * inv);
            wv.z = pk2(o[8 * i + 4] * inv, o[8 * i + 5] * inv); wv.w = pk2(o[8 * i + 6] * inv, o[8 * i + 7] * inv); *(u32x4*)(op + 8 * i) = wv; }
    }
}


#define GEMM_PHASE(EPI_T, Aptr, LDA, Bptr, MM, NN, KK, ...) do { \
    pg8::Gemm g_{(const pg8::bf16_t*)(Aptr), (const pg8::bf16_t*)(Bptr), (MM), (NN), (KK), (LDA)}; pg8::StaticOrder S_; S_.init((MM), (NN), c.nwg, c.wg); \
    EPI_T E_{__VA_ARGS__}; pg8::gemm_phase<EPI_T, pg8::StaticOrder, true, true>((PG8_LAS unsigned char*)lds, g_, S_, E_); } while (0)
#define GEMM_PHASE_C(CIDX, EPI_T, Aptr, LDA, Bptr, MM, NN, KK, ...) do { \
    pg8::Gemm g_{(const pg8::bf16_t*)(Aptr), (const pg8::bf16_t*)(Bptr), (MM), (NN), (KK), (LDA)}; pg8::StaticOrder S_; S_.init((MM), (NN), c.nwg, (CIDX)); \
    EPI_T E_{__VA_ARGS__}; pg8::gemm_phase<EPI_T, pg8::StaticOrder, true, true>((PG8_LAS unsigned char*)lds, g_, S_, E_); } while (0)

__global__ void __launch_bounds__(512, 2) mega_fwd(Args args) {
    extern __shared__ __attribute__((aligned(16))) unsigned char lds[];
    cg::grid_group grid = cg::this_grid();
    {
        volatile LAS unsigned* st0 = (volatile LAS unsigned*)((LAS unsigned char*)lds + LDS_BYTES - 64);
        if (threadIdx.x == 0) { st0[0] = 0u; st0[1] = 0u; }
        __syncthreads();
        (void)xcd_barrier_post((unsigned*)(args.ws + WS_MISC + MS_BAR), st0);
    }
#define GRID_BAR() do { XcdBarrier xb_; xb_.bar = (unsigned*)(ws + WS_MISC + MS_BAR); xb_.x = xb_xcc_id(); xb_.st = (volatile LAS unsigned*)((LAS unsigned char*)lds + LDS_BYTES - 64); xcd_barrier(xb_); } while (0)
#if XSYNC
    { unsigned char* ws = args.ws; for (int i_ = 0; i_ < XSYNC; ++i_) { asm volatile("" : "+s"(i_)); GRID_BAR(); } }
#endif
    int ph = 0;
    const int lo = args.ph_lo, hi = args.ph_hi;
#define PHASE_BEGIN if (ph >= lo && ph < hi) { ArgP ap = (ArgP)__builtin_amdgcn_kernarg_segment_ptr(); asm volatile("" : "+s"(ap)); unsigned char* ws = ap->ws; Ctx c; c.ws = ws; \
    { int t_ = threadIdx.x, g_ = blockIdx.x, n_ = gridDim.x; asm volatile("" : "+v"(t_), "+s"(g_), "+s"(n_)); c.tid = t_; c.lane = t_ & 63; c.wave = __builtin_amdgcn_readfirstlane(t_ >> 6); c.wg = g_; c.nwg = n_; } \
    bf16* Wb = (bf16*)(ws + WS_W); bf16* XN = (bf16*)(ws + WS_XN); bf16* PJ = (bf16*)(ws + WS_PROJ); float* X = ap->out; (void)Wb; (void)XN; (void)PJ; (void)X;
#define PHASE_END   if (ph + 1 < hi) { if (ph == 0) grid.sync(); else GRID_BAR(); } } ++ph;

    for (int l = 0; l < 2; ++l) {
        asm volatile("" : "+s"(l));
        PHASE_BEGIN for (int rep_ = 0; rep_ <= ((REPMASK >> 0) & 1); ++rep_) {
            convert_layer(c, ap, lds, l);
            if (c.wg == 0 && c.tid < 16) ((unsigned*)(ws + WS_MISC + MS_CNT))[l * 16 + c.tid] = 0u;
            { float* rz = (float*)(ws + WS_MISC + MS_SSQ); for (int i = c.wg * 512 + c.tid; i < 2 * NT; i += c.nwg * 512) rz[i] = 0.f; }
            if (l == 0) { float* rope = (float*)(ws + WS_MISC + MS_ROPE);
                for (int it = c.wg * 512 + c.tid; it < SEQL * 32; it += c.nwg * 512) { const int i = it & 31; const float ang = (float)(it >> 5) * powf(10000.f, -(float)i / 32.f); float sn, cs; sincosf(ang, &sn, &cs); rope[2 * it] = cs; rope[2 * it + 1] = sn; } }
            { float* wdt = (float*)(lds + 32768); const float* wsrc = ap->in[3] + (size_t)l * DM * INW + 6144;
                __syncthreads();
                for (int i = c.tid; i < 2048; i += 512) *(f32x4*)(wdt + i * 4) = *(const f32x4*)(wsrc + (size_t)(i >> 1) * INW + (i & 1) * 4);
                __syncthreads();
                norm_rows(c, (l == 0) ? ap->in[0] : X, ap->in[2] + (size_t)l * DM, XN, NT, wdt, (float*)(ws + WS_MISC + MS_DT)); }
            norm_rows(c, ap->in[1], ap->in[16] + (size_t)l * DM, (bf16*)(ws + WS_MISC + MS_MN), 1024, nullptr, nullptr);
        } PHASE_END
        PHASE_BEGIN for (int rep_ = 0; rep_ <= ((REPMASK >> 1) & 1); ++rep_) {
            GEMM_PHASE(pg8::EpiStore<0>, XN, 1024, Wb + W_IN, NT, 5120, 1024, PJ, PW, nullptr);
            GEMM_PHASE(pg8::EpiStore<0>, (bf16*)(ws + WS_WVT), 1024, XN, 1024, NT, 1024, (bf16*)(ws + WS_VT), NT, nullptr);
        } PHASE_END
        PHASE_BEGIN for (int rep_ = 0; rep_ <= ((REPMASK >> 2) & 1); ++rep_) {
#if DRYMASK & 128
            { int dry1_ = 1; asm volatile("" : "+s"(dry1_)); conv_prepass(c, ap, l, ws, lds, dry1_); }
#endif
#if PROBE
            if (c.wg == 0 && c.tid == 0) ((unsigned long long*)(ws + WS_MISC + MS_CNT + 1024))[0] = __builtin_amdgcn_s_memrealtime();
#endif
            conv_prepass(c, ap, l, ws, lds, 0);
            GRID_BAR();
#if PROBE
            if (c.wg == 0 && c.tid == 0) ((unsigned long long*)(ws + WS_MISC + MS_CNT + 1024))[1] = __builtin_amdgcn_s_memrealtime();
#endif
            int dry0 = 0; asm volatile("" : "+s"(dry0));
            unsigned* cnt = (unsigned*)(ws + WS_MISC + MS_CNT) + l * 16;
#if DRYMASK & 256
            for (int rr_ = 0; rr_ < 2; ++rr_) { int dryr = 1 - rr_; asm volatile("" : "+s"(dryr)); unsigned* cntr = cnt + 8 * (1 - rr_);
            if (c.wg < 64) mixer_d_mfma(c, ap, lds, l, c.wg >> 2, c.wg & 3, dryr);
            else if (c.wg < 128) mixer_b_mfma(c, ap, lds, l, (c.wg - 64) >> 2, c.wg & 3, dryr);
            mixer_c_mfma(c, ap, lds, l, dryr, cntr);
            mixer_a_mfma(c, lds, dryr, cntr + 1);
            GRID_BAR(); }
#else
            if (c.wg < 64) mixer_d_mfma(c, ap, lds, l, c.wg >> 2, c.wg & 3, dry0);
            else if (c.wg < 128) mixer_b_mfma(c, ap, lds, l, (c.wg - 64) >> 2, c.wg & 3, dry0);
#if DRYMASK & 4
            { int dry1 = 1; asm volatile("" : "+s"(dry1)); mixer_c_mfma(c, ap, lds, l, dry1, cnt + 3); }
#endif
            mixer_c_mfma(c, ap, lds, l, dry0, cnt);
#if DRYMASK & 2
            { int dry1 = 1; asm volatile("" : "+s"(dry1)); mixer_a_mfma(c, lds, dry1, cnt + 2); __syncthreads(); }
#endif
            mixer_a_mfma(c, lds, dry0, cnt + 1);
#endif
        } PHASE_END
        PHASE_BEGIN for (int rep_ = 0; rep_ <= ((REPMASK >> 3) & 1); ++rep_) {
#if PROBE
            if (c.wg == 0 && c.tid == 0 && rep_ == 0) ((unsigned long long*)(ws + WS_MISC + MS_CNT + 1024))[2] = __builtin_amdgcn_s_memrealtime();
#endif
            {
                pg8::Gemm g_{(const pg8::bf16_t*)XN, (const pg8::bf16_t*)(Wb + W_G), NT, 1024, 1024, 1024, 0u, 0u, 0u, 0u, 1024u * 1024u * 2u};
                pg8::BranchOrder S_; S_.init(NT, 1024, c.nwg, c.wg, 4);
                pg8::EpiGate8 E_{(unsigned char*)PJ, PW * 2};
                pg8::gemm_phase<pg8::EpiGate8, pg8::BranchOrder, true, true>((PG8_LAS unsigned char*)lds, g_, S_, E_); }
            {
                pg8::Gemm g_{(const pg8::bf16_t*)PJ, (const pg8::bf16_t*)(Wb + W_B), NT, 1024, 512, PW, (unsigned)C_AQ * 2u, (unsigned)C_BG * 2u, (unsigned)C_CQ * 2u, (unsigned)C_DZ * 2u, 1024u * 512u * 2u};
                pg8::BranchOrder S_; S_.init(NT, 1024, c.nwg, c.wg, 4);
                pg8::EpiGateAcc8 E_{(const unsigned char*)PJ, PW * 2, (pg8::bf16_t*)(PJ + C_MG), PW, (const float*)(ws + WS_SSQ32)};
                pg8::gemm_phase<pg8::EpiGateAcc8, pg8::BranchOrder, true, true>((PG8_LAS unsigned char*)lds, g_, S_, E_); }
        } PHASE_END
        PHASE_BEGIN for (int rep_ = 0; rep_ <= ((REPMASK >> 4) & 1); ++rep_) {
#if DRYMASK & 64
            { int dry1_ = 1; asm volatile("" : "+s"(dry1_));
            GEMM_PHASE(pg8::EpiResid, PJ + C_MG, PW, Wb + W_MO, NT, 1024, 1024, (l == 0) ? ap->in[0] : X, X, XN, (float*)(ws + WS_MISC + MS_SSQ), dry1_);
            }
#endif
            GEMM_PHASE(pg8::EpiResid, PJ + C_MG, PW, Wb + W_MO, NT, 1024, 1024, (l == 0) ? ap->in[0] : X, X, XN, (float*)(ws + WS_MISC + MS_SSQ), 0);
        } PHASE_END
        PHASE_BEGIN for (int rep_ = 0; rep_ <= ((REPMASK >> 5) & 1); ++rep_) {
            GEMM_PHASE(pg8::EpiStore<0>, XN, 1024, Wb + W_XQ, NT, 512, 1024, PJ, 512, (const float*)(ws + WS_MISC + MS_SSQ));
            GEMM_PHASE_C((c.wg + c.nwg - 128) % c.nwg, pg8::EpiStore<0>, (bf16*)(ws + WS_MISC + MS_MN), 1024, Wb + W_XKV, 1024, 512, 1024, (bf16*)(ws + WS_MISC + MS_KV), 512, nullptr);
            GEMM_PHASE_C((c.wg + c.nwg - 144) % c.nwg, pg8::EpiStore<0>, Wb + W_XKV + (size_t)512 * 1024, 1024, (bf16*)(ws + WS_MISC + MS_MN), 512, 1024, 1024, (bf16*)(ws + WS_MISC + MS_VTX), 1024, nullptr);
        } PHASE_END
        PHASE_BEGIN for (int rep_ = 0; rep_ <= ((REPMASK >> 6) & 1); ++rep_) {
#if DRYMASK & 32
            { int dry1 = 1; asm volatile("" : "+s"(dry1)); if (c.wg < 16) mixer_d_mfma(c, ap, lds, l, c.wg, DRYSEG, dry1); }
#endif
            xattn_mfma(c, lds);
        } PHASE_END
        PHASE_BEGIN for (int rep_ = 0; rep_ <= ((REPMASK >> 7) & 1); ++rep_) {
#if DRYMASK & 64
            { int dry1_ = 1; asm volatile("" : "+s"(dry1_));
            GEMM_PHASE(pg8::EpiResid, (bf16*)(ws + WS_PROJ + 16 * MiB), 512, Wb + W_XO, NT, 1024, 512, X, X, XN, (float*)(ws + WS_MISC + MS_SSQ) + NT, dry1_);
            }
#endif
            GEMM_PHASE(pg8::EpiResid, (bf16*)(ws + WS_PROJ + 16 * MiB), 512, Wb + W_XO, NT, 1024, 512, X, X, XN, (float*)(ws + WS_MISC + MS_SSQ) + NT, 0);
        } PHASE_END
        PHASE_BEGIN for (int rep_ = 0; rep_ <= ((REPMASK >> 8) & 1); ++rep_) {
            GEMM_PHASE(pg8::EpiSwiglu, XN, 1024, Wb + W_FI, NT, 5632, 1024, PJ, FFH, (const float*)(ws + WS_MISC + MS_SSQ) + NT);
        } PHASE_END
        PHASE_BEGIN for (int rep_ = 0; rep_ <= ((REPMASK >> 9) & 1); ++rep_) {
#if DRYMASK & 64
            { int dry1_ = 1; asm volatile("" : "+s"(dry1_));
            GEMM_PHASE(pg8::EpiResid, PJ, FFH, Wb + W_FO, NT, 1024, FFH, X, X, nullptr, nullptr, dry1_);
            }
#endif
            GEMM_PHASE(pg8::EpiResid, PJ, FFH, Wb + W_FO, NT, 1024, FFH, X, X, nullptr, nullptr, 0);
        } PHASE_END
    }
    PHASE_BEGIN for (int rep_ = 0; rep_ <= ((REPMASK >> 10) & 1); ++rep_) {
        final_norm(c, X, ap->in[23]);
#if PROBE
        GRID_BAR();
        if (c.wg == 0) { const unsigned long long* tsb = (const unsigned long long*)(ws + WS_MISC + MS_CNT + 1024);
            const float T = (float)(tsb[PROBE_HI] - tsb[PROBE_LO]) * 0.01f;
            const int n = (int)(T * 800.f);
            for (int i = c.tid; i < n && i < 4000000; i += 512) X[i] += 0.08f; }
#endif
    } PHASE_END
}

extern "C" void kernel_launch(void* const* d_in, const int* in_sizes, int n_in, void* d_out, int out_size, void* d_ws, size_t ws_size, hipStream_t stream) {
    static int grid_blocks = 0;
    if (grid_blocks == 0) {
        if (n_in != 24 || out_size != NT * DM || ws_size < WS_END) { fprintf(stderr, "kernel_launch: unexpected shapes (n_in %d out %d ws %zu)\n", n_in, out_size, ws_size); grid_blocks = -1; return; }
        int dev = 0, cus = 0, per_cu = 0;
        hipGetDevice(&dev);
        hipDeviceGetAttribute(&cus, hipDeviceAttributeMultiprocessorCount, dev);
        if (hipFuncSetAttribute((const void*)mega_fwd, hipFuncAttributeMaxDynamicSharedMemorySize, LDS_BYTES) != hipSuccess) { fprintf(stderr, "kernel_launch: hipFuncSetAttribute failed\n"); grid_blocks = -1; return; }
        if (hipOccupancyMaxActiveBlocksPerMultiprocessor(&per_cu, (const void*)mega_fwd, 512, LDS_BYTES) != hipSuccess || per_cu < 1) { fprintf(stderr, "kernel_launch: occupancy query says %d\n", per_cu); per_cu = 1; }
        (void)hipGetLastError();
        grid_blocks = cus * 1;
        fprintf(stderr, "kernel_launch: grid %d (cus %d, per_cu %d)\n", grid_blocks, cus, per_cu);
    }
    if (grid_blocks < 0) return;
    if (hipMemsetAsync((char*)d_ws + WS_MISC + MS_FLG, 0, 1024, stream) != hipSuccess) { fprintf(stderr, "kernel_launch: memset failed\n"); return; }
    if (hipMemsetAsync((char*)d_ws + WS_MISC + MS_BAR, 0, XCD_BAR_WORDS * 4, stream) != hipSuccess) { fprintf(stderr, "kernel_launch: memset failed\n"); return; }
    Args a{};
    for (int i = 0; i < 24; ++i) a.in[i] = (const float*)d_in[i];
    a.out = (float*)d_out; a.ws = (unsigned char*)d_ws; a.ph_lo = 0; a.ph_hi = 1000;
    void* kargs[] = {&a};
    hipError_t e = hipLaunchCooperativeKernel((const void*)mega_fwd, dim3(grid_blocks), dim3(512), kargs, LDS_BYTES, stream);
    if (e != hipSuccess) fprintf(stderr, "kernel_launch: cooperative launch failed: %s (grid %d)\n", hipGetErrorString(e), grid_blocks);
}
```

```cpp
#include <hip/hip_runtime.h>
#include <hip/hip_cooperative_groups.h>
#include <cstdio>
#include <cstdint>
namespace cg = cooperative_groups;
namespace pg8 {
#define PG8_LAS __attribute__((address_space(3)))
typedef unsigned short bf16_t;
typedef short bf16x8 __attribute__((ext_vector_type(8)));
typedef float f32x4 __attribute__((ext_vector_type(4)));
typedef unsigned u32x4 __attribute__((ext_vector_type(4)));
constexpr int BM = 256, BK = 64, HALF = 128, HTB = HALF * BK * 2  , STAGE_BYTES = 8 * HTB, NXCD = 8, WGM = 4;

__host__ __device__ __forceinline__ int lds_byte(int r, int c) { const int st = (r >> 4) * 2 + (c >> 5), rr = r & 15, cc = c & 31, ob = rr * 64 + cc * 2; return st * 1024 + (ob ^ (((ob >> 9) & 1) << 5)); }
__host__ __device__ __forceinline__ void stage_rc(int b, int& R, int& C) { const int st = b / 1024, sb = b % 1024, swz = sb ^ (((sb >> 9) & 1) << 5); R = (st >> 1) * 16 + swz / 64; C = (st & 1) * 32 + (swz % 64) / 2; }
__host__ __device__ __forceinline__ int perm32(int rho) { const int n = rho >> 4, i = rho & 15; return 8 * (i >> 2) + 4 * n + (i & 3); }

struct Unit { int pm, pn, z; };
struct Gemm { const bf16_t* A; const bf16_t* Bt; int M, N, K, lda; unsigned zA0, zA1, zA2, zA3; unsigned zB;
    __device__ __forceinline__ unsigned za(int z) const { return z == 0 ? zA0 : z == 1 ? zA1 : z == 2 ? zA2 : zA3; } };

struct StaticOrder {
    int nM, nN, nwg, G, c;
    __host__ __device__ void init(int M, int N, int G_, int c_) { nM = M / BM; nN = N / BM; nwg = nM * nN; G = G_; c = c_; }
    __host__ __device__ bool next(int i, Unit& u) const {
        const long L = (long)i * G + c; if (L >= nwg) return false;
        int wgid = (int)L; { const int q = nwg / NXCD, r = nwg % NXCD, xcd = wgid % NXCD, off = wgid / NXCD; wgid = (xcd < r ? xcd * (q + 1) : r * (q + 1) + (xcd - r) * q) + off; }
        const int nig = WGM * nN, gid = wgid / nig, fm = gid * WGM, gsz = (nM - fm) < WGM ? (nM - fm) : WGM;
        u.pm = fm + ((wgid % nig) % gsz); u.pn = (wgid % nig) / gsz; u.z = 0; return true;
    }
    __device__ __forceinline__ void a_ready(const Unit&) const {}
    __device__ __forceinline__ void done(const Unit&) const {}
};

struct BranchOrder {
    StaticOrder S; int nz;
    __host__ __device__ void init(int M, int N, int G_, int c_, int nz_) { S.init(M, N, G_, c_); nz = nz_; }
    __host__ __device__ bool next(int i, Unit& u) const { if (i >= nz) return false; if (!S.next(0, u)) return false; u.z = i; return true; }
    __device__ __forceinline__ void a_ready(const Unit&) const {}
    __device__ __forceinline__ void done(const Unit&) const {}
};

__device__ __forceinline__ unsigned cvt_pk_bf16(float lo, float hi) { unsigned r; asm volatile("v_cvt_pk_bf16_f32 %0, %1, %2" : "=v"(r) : "v"(lo), "v"(hi)); return r; }

template <class Epi, class Sched, bool ALIGN_EPI = false, bool SP2 = false>
__device__ __forceinline__ void gemm_phase(PG8_LAS unsigned char* lds, const Gemm g, const Sched& S, const Epi& E) {
    int tid_l = threadIdx.x; asm volatile("" : "+v"(tid_l));
    const int tid = tid_l, wid = __builtin_amdgcn_readfirstlane(tid >> 6), lane = tid & 63, wr = wid >> 2, wc = wid & 3, fr = lane & 15, fq = lane >> 4;
    const int K = g.K, nt = K / BK;
    unsigned voffA[2], voffB[2];
#pragma unroll
    for (int i = 0; i < 2; ++i) { int R, C; stage_rc(tid * 16 + i * 8192, R, C); const int Rb = Epi::PERM ? ((R & ~31) + perm32(R & 31)) : R;
        voffA[i] = (unsigned)(R * g.lda + C) * 2u; voffB[i] = (unsigned)(Rb * K + C) * 2u; }
    const size_t kstep = (size_t)(BK * 2);
    const size_t hstepA = (size_t)HALF * g.lda * 2, hstepB = (size_t)HALF * K * 2;
    const size_t tstepA = 2 * hstepA, tstepB = 2 * hstepB;
    const unsigned ldsw = (unsigned)wid * 1024u;
    const int aoff = lds_byte(wr * 64 + fr, fq * 8), boff = lds_byte(wc * 32 + fr, fq * 8);
#define PG8_SA(b, h) (((b) * 2 + (h)) * HTB)
#define PG8_SB(b, h) ((4 + (b) * 2 + (h)) * HTB)
#define PG8_STAGE(bufoff, gbase, voff) do { _Pragma("unroll") for (int _i = 0; _i < 2; ++_i) \
        __builtin_amdgcn_global_load_lds((const unsigned*)((const char*)(gbase) + (voff)[_i]), (PG8_LAS unsigned*)(lds + (bufoff) + ldsw + _i * 8192), 16, 0, 0); } while (0)
#define PG8_LDA(dst, b, h) do { _Pragma("unroll") for (int m = 0; m < 4; ++m) _Pragma("unroll") for (int k = 0; k < 2; ++k) dst[m][k] = *(const PG8_LAS bf16x8*)(lds + PG8_SA(b, h) + aoff + m * 2048 + k * 1024); } while (0)
#define PG8_LDB(dst, b, h) do { _Pragma("unroll") for (int n = 0; n < 2; ++n) _Pragma("unroll") for (int k = 0; k < 2; ++k) dst[n][k] = *(const PG8_LAS bf16x8*)(lds + PG8_SB(b, h) + boff + n * 2048 + k * 1024); } while (0)
#define PG8_MMA(ai, bj, At, Bt) do { __builtin_amdgcn_s_setprio(1); _Pragma("unroll") for (int m = 0; m < 4; ++m) _Pragma("unroll") for (int n = 0; n < 2; ++n) _Pragma("unroll") for (int k = 0; k < 2; ++k) \
        acc[ai][bj][m][n] = __builtin_amdgcn_mfma_f32_16x16x32_bf16(Bt[n][k], At[m][k], acc[ai][bj][m][n], 0, 0, 0); __builtin_amdgcn_s_setprio(0); } while (0)
#define PG8_WAIT_V(n) asm volatile("s_waitcnt vmcnt(" #n ")" ::: "memory")
#define PG8_WAIT_L(n) asm volatile("s_waitcnt lgkmcnt(" #n ")" ::: "memory")
#define PG8_BAR __builtin_amdgcn_s_barrier()
#define PG8_SCHED __builtin_amdgcn_sched_barrier(0)
    Unit cur, nxt; int ui = 0;
    if (!S.next(0, cur)) return;
    f32x4 acc[2][2][4][2];
#pragma unroll
    for (int a = 0; a < 2; ++a)
#pragma unroll
        for (int b = 0; b < 2; ++b)
#pragma unroll
            for (int m = 0; m < 4; ++m)
#pragma unroll
                for (int n = 0; n < 2; ++n) acc[a][b][m][n] = (f32x4){0.f, 0.f, 0.f, 0.f};
    bf16x8 At[4][2], B0[2][2], B1[2][2];
    const char* cA = (const char*)g.A + g.za(cur.z) + (size_t)cur.pm * tstepA; const char* cB = (const char*)g.Bt + (size_t)cur.z * g.zB + (size_t)cur.pn * tstepB;
    S.a_ready(cur);
    if constexpr (SP2) {
        PG8_STAGE(PG8_SB(0, 0), cB, voffB); PG8_STAGE(PG8_SB(0, 1), cB + hstepB, voffB); PG8_STAGE(PG8_SA(0, 0), cA, voffA); PG8_STAGE(PG8_SA(0, 1), cA + hstepA, voffA);
        if (wr == 1) PG8_BAR;
        PG8_WAIT_V(2); PG8_BAR;
        PG8_STAGE(PG8_SB(1, 0), cB + kstep, voffB); PG8_STAGE(PG8_SA(1, 0), cA + kstep, voffA); PG8_STAGE(PG8_SB(1, 1), cB + hstepB + kstep, voffB);
        PG8_WAIT_V(6); PG8_BAR;
    } else {
        PG8_STAGE(PG8_SB(0, 0), cB, voffB); PG8_STAGE(PG8_SA(0, 0), cA, voffA); PG8_STAGE(PG8_SB(0, 1), cB + hstepB, voffB); PG8_STAGE(PG8_SA(0, 1), cA + hstepA, voffA);
        if (wr == 1) PG8_BAR;
        PG8_WAIT_V(4); PG8_BAR;
        PG8_STAGE(PG8_SB(1, 0), cB + kstep, voffB); PG8_STAGE(PG8_SA(1, 0), cA + kstep, voffA); PG8_STAGE(PG8_SB(1, 1), cB + hstepB + kstep, voffB);
        PG8_WAIT_V(6); PG8_BAR;
    }
    for (;;) {
        const bool has_next = S.next(ui + 1, nxt);
        const char* nA = has_next ? (const char*)g.A + g.za(nxt.z) + (size_t)nxt.pm * tstepA : cA; const char* nB = has_next ? (const char*)g.Bt + (size_t)nxt.z * g.zB + (size_t)nxt.pn * tstepB : cB;
        for (int t = 0; t < nt; t += 2) {
            const bool last = (t == nt - 2);
            const char* a1 = cA + (size_t)(t + 1) * kstep;
            const char* a2 = last ? nA : cA + (size_t)(t + 2) * kstep; const char* b2 = last ? nB : cB + (size_t)(t + 2) * kstep;
            const char* a3 = a2 + kstep; const char* b3 = b2 + kstep;
            if (last && has_next) S.a_ready(nxt);
            if constexpr (SP2) {
            PG8_LDB(B0, 0, 0); PG8_LDB(B1, 0, 1); PG8_SCHED; PG8_LDA(At, 0, 0); PG8_STAGE(PG8_SA(1, 1), a1 + hstepA, voffA);
            PG8_WAIT_V(8); PG8_WAIT_L(0); PG8_BAR; PG8_MMA(0, 0, At, B0); PG8_MMA(0, 1, At, B1); PG8_BAR; PG8_SCHED;
            PG8_LDA(At, 0, 1); PG8_STAGE(PG8_SB(0, 0), b2, voffB); PG8_STAGE(PG8_SB(0, 1), b2 + hstepB, voffB); PG8_STAGE(PG8_SA(0, 0), a2, voffA);
            PG8_WAIT_V(8); PG8_WAIT_L(0); PG8_BAR; PG8_MMA(1, 0, At, B0); PG8_MMA(1, 1, At, B1); PG8_BAR; PG8_SCHED;
            PG8_LDB(B0, 1, 0); PG8_LDB(B1, 1, 1); PG8_SCHED; PG8_LDA(At, 1, 0); PG8_STAGE(PG8_SA(0, 1), a2 + hstepA, voffA);
            PG8_WAIT_V(8); PG8_WAIT_L(0); PG8_BAR; PG8_MMA(0, 0, At, B0); PG8_MMA(0, 1, At, B1); PG8_BAR; PG8_SCHED;
            PG8_LDA(At, 1, 1); PG8_STAGE(PG8_SB(1, 0), b3, voffB); PG8_STAGE(PG8_SB(1, 1), b3 + hstepB, voffB); PG8_STAGE(PG8_SA(1, 0), a3, voffA);
            PG8_WAIT_V(8); PG8_WAIT_L(0); PG8_BAR; PG8_MMA(1, 0, At, B0); PG8_MMA(1, 1, At, B1); PG8_BAR; PG8_SCHED;
            } else {
            PG8_LDB(B0, 0, 0); PG8_SCHED; PG8_LDA(At, 0, 0); PG8_STAGE(PG8_SA(1, 1), a1 + hstepA, voffA);
            PG8_WAIT_L(8); PG8_BAR; PG8_WAIT_L(0); PG8_MMA(0, 0, At, B0); PG8_BAR; PG8_SCHED;
            PG8_LDB(B1, 0, 1); PG8_STAGE(PG8_SB(0, 0), b2, voffB);
            PG8_BAR; PG8_WAIT_L(0); PG8_MMA(0, 1, At, B1); PG8_BAR;
            PG8_LDA(At, 0, 1); PG8_STAGE(PG8_SA(0, 0), a2, voffA);
            PG8_BAR; PG8_WAIT_L(0); PG8_MMA(1, 0, At, B0); PG8_BAR; PG8_SCHED;
            PG8_STAGE(PG8_SB(0, 1), b2 + hstepB, voffB);
            PG8_WAIT_V(6); PG8_BAR; PG8_MMA(1, 1, At, B1); PG8_BAR;
            PG8_LDB(B0, 1, 0); PG8_SCHED; PG8_LDA(At, 1, 0); PG8_STAGE(PG8_SA(0, 1), a2 + hstepA, voffA);
            PG8_WAIT_L(8); PG8_BAR; PG8_WAIT_L(0); PG8_MMA(0, 0, At, B0); PG8_BAR; PG8_SCHED;
            PG8_LDB(B1, 1, 1); PG8_STAGE(PG8_SB(1, 0), b3, voffB);
            PG8_BAR; PG8_WAIT_L(0); PG8_MMA(0, 1, At, B1); PG8_BAR;
            PG8_LDA(At, 1, 1); PG8_STAGE(PG8_SA(1, 0), a3, voffA);
            PG8_BAR; PG8_WAIT_L(0); PG8_MMA(1, 0, At, B0); PG8_BAR; PG8_SCHED;
            PG8_STAGE(PG8_SB(1, 1), b3 + hstepB, voffB);
            PG8_WAIT_V(6); PG8_BAR; PG8_MMA(1, 1, At, B1); PG8_BAR;
            }
        }
        if constexpr (ALIGN_EPI) { if (wr == 0) PG8_BAR; }
        if constexpr (!Epi::AFTER_DRAIN) { E(acc, cur, wr, wc, fr, fq); S.done(cur); }
        if (!has_next) break;
#pragma unroll
        for (int a = 0; a < 2; ++a)
#pragma unroll
            for (int b = 0; b < 2; ++b)
#pragma unroll
                for (int m = 0; m < 4; ++m)
#pragma unroll
                    for (int n = 0; n < 2; ++n) acc[a][b][m][n] = (f32x4){0.f, 0.f, 0.f, 0.f};
        cur = nxt; cA = nA; cB = nB; ++ui;
        if constexpr (ALIGN_EPI) { if (wr == 1) PG8_BAR; }
    }
    PG8_WAIT_V(0);
    if constexpr (!ALIGN_EPI) { if (wr == 0) PG8_BAR; }
    PG8_BAR;
    if constexpr (Epi::AFTER_DRAIN) { E.fused(acc, cur, wr, wc, fr, fq, lds, wid, lane); S.done(cur); }
#undef PG8_SA
#undef PG8_SB
#undef PG8_STAGE
#undef PG8_LDA
#undef PG8_LDB
#undef PG8_MMA
#undef PG8_WAIT_V
#undef PG8_WAIT_L
#undef PG8_BAR
#undef PG8_SCHED
}
}

namespace pg8 {
__device__ __forceinline__ float bfu_lo(unsigned w) { return __builtin_bit_cast(float, w << 16); }
__device__ __forceinline__ float bfu_hi(unsigned w) { return __builtin_bit_cast(float, w & 0xffff0000u); }
__device__ __forceinline__ float sigmoidf_(float x) { return __builtin_amdgcn_rcpf(1.f + __expf(-x)); }

template <int ACT  > struct EpiStore {
    static constexpr bool PERM = true, AFTER_DRAIN = false;
    bf16_t* O; int ldc; const float* rss;
    __device__ __forceinline__ void operator()(const f32x4 (&acc)[2][2][4][2], const Unit& u, int wr, int wc, int fr, int fq) const {
        const int row0 = u.pm * BM + wr * 64 + fr, col0 = u.pn * BM + wc * 32 + 8 * fq;
#pragma unroll
        for (int ai = 0; ai < 2; ++ai)
#pragma unroll
            for (int m = 0; m < 4; ++m) { bf16_t* rowp = O + (size_t)(row0 + ai * HALF + m * 16) * ldc + col0;
                float rs = 1.f; if (rss) rs = rsqrtf(rss[row0 + ai * HALF + m * 16] * (1.f / 1024.f) + 1e-6f);
#pragma unroll
                for (int bj = 0; bj < 2; ++bj) { f32x4 v0 = acc[ai][bj][m][0] * rs, v1 = acc[ai][bj][m][1] * rs;
                    if (ACT == 1) {
#pragma unroll
                        for (int j = 0; j < 4; ++j) { v0[j] = sigmoidf_(v0[j]); v1[j] = sigmoidf_(v1[j]); } }
                    u32x4 w; w.x = cvt_pk_bf16(v0[0], v0[1]); w.y = cvt_pk_bf16(v0[2], v0[3]); w.z = cvt_pk_bf16(v1[0], v1[1]); w.w = cvt_pk_bf16(v1[2], v1[3]);
                    *(u32x4*)(rowp + bj * HALF) = w; } }
    }
};

typedef unsigned u32x2 __attribute__((ext_vector_type(2)));
__device__ __forceinline__ int gs8_off(int z) { return z < 3 ? 1024 + z * 1024 : 6144; }
struct EpiGate8 {
    static constexpr bool PERM = true, AFTER_DRAIN = false;
    unsigned char* G8; int ldb;
    __device__ __forceinline__ void operator()(const f32x4 (&acc)[2][2][4][2], const Unit& u, int wr, int wc, int fr, int fq) const {
        const int row0 = u.pm * BM + wr * 64 + fr, col0 = gs8_off(u.z) + u.pn * BM + wc * 32 + 8 * fq;
#pragma unroll
        for (int ai = 0; ai < 2; ++ai)
#pragma unroll
            for (int m = 0; m < 4; ++m) { unsigned char* rowp = G8 + (size_t)(row0 + ai * HALF + m * 16) * ldb + col0;
#pragma unroll
                for (int bj = 0; bj < 2; ++bj) { unsigned q[8];
#pragma unroll
                    for (int j = 0; j < 4; ++j) { q[j] = (unsigned)(sigmoidf_(acc[ai][bj][m][0][j]) * 255.f + 0.5f); q[4 + j] = (unsigned)(sigmoidf_(acc[ai][bj][m][1][j]) * 255.f + 0.5f); }
                    u32x2 w; w.x = q[0] | (q[1] << 8) | (q[2] << 16) | (q[3] << 24); w.y = q[4] | (q[5] << 8) | (q[6] << 16) | (q[7] << 24);
                    *(u32x2*)(rowp + bj * HALF) = w; } }
    }
};
struct EpiGateAcc8 {
    static constexpr bool PERM = true, AFTER_DRAIN = false;
    const unsigned char* G8; int ldb; bf16_t* MG; int ld; const float* ssq;
    __device__ __forceinline__ void operator()(const f32x4 (&acc)[2][2][4][2], const Unit& u, int wr, int wc, int fr, int fq) const {
        const int row0 = u.pm * BM + wr * 64 + fr, col0 = u.pn * BM + wc * 32 + 8 * fq, goff = gs8_off(u.z) + col0; const bool first = (u.z == 0);
#pragma unroll
        for (int ai = 0; ai < 2; ++ai)
#pragma unroll
        for (int mh = 0; mh < 2; ++mh) {
            u32x2 gv[4][2]; u32x4 ov[4][2]; float rsv[4];
#pragma unroll
            for (int m = mh * 2; m < mh * 2 + 2; ++m) { const int row = row0 + ai * HALF + m * 16; const size_t ro = (size_t)row * ld + col0;
#pragma unroll
                for (int bj = 0; bj < 2; ++bj) { gv[m][bj] = *(const u32x2*)(G8 + (size_t)row * ldb + goff + bj * HALF); ov[m][bj] = (u32x4){0u, 0u, 0u, 0u}; if (!first) ov[m][bj] = *(const u32x4*)(MG + ro + bj * HALF); }
                rsv[m] = 1.f / 255.f;
                if (u.z == 3) { float sm = 0.f;
#pragma unroll
                    for (int q = 0; q < 8; ++q) { const f32x4 v = *(const f32x4*)(ssq + (size_t)row * 32 + 4 * q); sm += (v[0] + v[1]) + (v[2] + v[3]); }
                    rsv[m] = rsqrtf(sm * (1.f / 512.f) + 1e-6f) * (1.f / 255.f); } }
#pragma unroll
            for (int m = mh * 2; m < mh * 2 + 2; ++m) { const int row = row0 + ai * HALF + m * 16; const size_t ro = (size_t)row * ld + col0; const float rs = rsv[m];
#pragma unroll
                for (int bj = 0; bj < 2; ++bj) { const f32x4 a0 = acc[ai][bj][m][0], a1 = acc[ai][bj][m][1]; const u32x2 g = gv[m][bj]; const u32x4 o = ov[m][bj];
                    float r[8];
                    r[0] = bfu_lo(o.x) + (float)(g.x & 255u) * a0[0] * rs;         r[1] = bfu_hi(o.x) + (float)((g.x >> 8) & 255u) * a0[1] * rs;
                    r[2] = bfu_lo(o.y) + (float)((g.x >> 16) & 255u) * a0[2] * rs; r[3] = bfu_hi(o.y) + (float)(g.x >> 24) * a0[3] * rs;
                    r[4] = bfu_lo(o.z) + (float)(g.y & 255u) * a1[0] * rs;         r[5] = bfu_hi(o.z) + (float)((g.y >> 8) & 255u) * a1[1] * rs;
                    r[6] = bfu_lo(o.w) + (float)((g.y >> 16) & 255u) * a1[2] * rs; r[7] = bfu_hi(o.w) + (float)(g.y >> 24) * a1[3] * rs;
                    u32x4 w; w.x = cvt_pk_bf16(r[0], r[1]); w.y = cvt_pk_bf16(r[2], r[3]); w.z = cvt_pk_bf16(r[4], r[5]); w.w = cvt_pk_bf16(r[6], r[7]);
                    *(u32x4*)(MG + ro + bj * HALF) = w; } }
        }
    }
};

struct EpiGateAcc {
    static constexpr bool PERM = true, AFTER_DRAIN = false;
    const bf16_t* GS; bf16_t* MG; int ld; int first; const float* ssq;
    __device__ __forceinline__ void operator()(const f32x4 (&acc)[2][2][4][2], const Unit& u, int wr, int wc, int fr, int fq) const {
        const int row0 = u.pm * BM + wr * 64 + fr, col0 = u.pn * BM + wc * 32 + 8 * fq;
#pragma unroll
        for (int ai = 0; ai < 2; ++ai)
#pragma unroll
        for (int mh = 0; mh < 2; ++mh) {
            u32x4 gv[4][2], ov[4][2]; float rsv[4];
#pragma unroll
            for (int m = mh * 2; m < mh * 2 + 2; ++m) { const int row = row0 + ai * HALF + m * 16; const size_t ro = (size_t)row * ld + col0;
#pragma unroll
                for (int bj = 0; bj < 2; ++bj) { gv[m][bj] = *(const u32x4*)(GS + ro + bj * HALF); ov[m][bj] = (u32x4){0u, 0u, 0u, 0u}; if (!first) ov[m][bj] = *(const u32x4*)(MG + ro + bj * HALF); }
                rsv[m] = 1.f;
                if (ssq) { float sm = 0.f;
#pragma unroll
                    for (int q = 0; q < 8; ++q) { const f32x4 v = *(const f32x4*)(ssq + (size_t)row * 32 + 4 * q); sm += (v[0] + v[1]) + (v[2] + v[3]); }
                    rsv[m] = rsqrtf(sm * (1.f / 512.f) + 1e-6f); } }
#pragma unroll
            for (int m = mh * 2; m < mh * 2 + 2; ++m) { const int row = row0 + ai * HALF + m * 16; const size_t ro = (size_t)row * ld + col0; const float rs = rsv[m];
#pragma unroll
                for (int bj = 0; bj < 2; ++bj) { const f32x4 a0 = acc[ai][bj][m][0], a1 = acc[ai][bj][m][1]; const u32x4 g = gv[m][bj], o = ov[m][bj];
                    float r[8];
                    r[0] = bfu_lo(o.x) + bfu_lo(g.x) * a0[0] * rs; r[1] = bfu_hi(o.x) + bfu_hi(g.x) * a0[1] * rs;
                    r[2] = bfu_lo(o.y) + bfu_lo(g.y) * a0[2] * rs; r[3] = bfu_hi(o.y) + bfu_hi(g.y) * a0[3] * rs;
                    r[4] = bfu_lo(o.z) + bfu_lo(g.z) * a1[0] * rs; r[5] = bfu_hi(o.z) + bfu_hi(g.z) * a1[1] * rs;
                    r[6] = bfu_lo(o.w) + bfu_lo(g.w) * a1[2] * rs; r[7] = bfu_hi(o.w) + bfu_hi(g.w) * a1[3] * rs;
                    u32x4 w; w.x = cvt_pk_bf16(r[0], r[1]); w.y = cvt_pk_bf16(r[2], r[3]); w.z = cvt_pk_bf16(r[4], r[5]); w.w = cvt_pk_bf16(r[6], r[7]);
                    *(u32x4*)(MG + ro + bj * HALF) = w; } }
        }
    }
};

struct EpiResid {
    static constexpr bool PERM = true, AFTER_DRAIN = false;
    const float* XI; float* XO; bf16_t* XB; float* rowss; int dry;
    __device__ __forceinline__ void operator()(const f32x4 (&acc)[2][2][4][2], const Unit& u, int wr, int wc, int fr, int fq) const {
        const int row0 = u.pm * BM + wr * 64 + fr, col0 = u.pn * BM + wc * 32 + 8 * fq;
#pragma unroll
        for (int ai = 0; ai < 2; ++ai)
#pragma unroll
        for (int mh = 0; mh < 2; ++mh) {
            f32x4 xv[2][2][2];
#pragma unroll
            for (int mm = 0; mm < 2; ++mm) { const size_t ro = (size_t)(row0 + ai * HALF + (mh * 2 + mm) * 16) * 1024 + col0;
#pragma unroll
                for (int bj = 0; bj < 2; ++bj) { xv[mm][bj][0] = *(const f32x4*)(XI + ro + bj * HALF); xv[mm][bj][1] = *(const f32x4*)(XI + ro + bj * HALF + 4); } }
#pragma unroll
            for (int mm = 0; mm < 2; ++mm) { const int m = mh * 2 + mm; const int row = row0 + ai * HALF + m * 16; const size_t ro = (size_t)row * 1024 + col0; float sq = 0.f;
#pragma unroll
                for (int bj = 0; bj < 2; ++bj) {
                    const f32x4 y0 = xv[mm][bj][0] + acc[ai][bj][m][0], y1 = xv[mm][bj][1] + acc[ai][bj][m][1];
                    if (!dry) { *(f32x4*)(XO + ro + bj * HALF) = y0; *(f32x4*)(XO + ro + bj * HALF + 4) = y1; }
                    if (XB && !dry) { u32x4 w; w.x = cvt_pk_bf16(y0[0], y0[1]); w.y = cvt_pk_bf16(y0[2], y0[3]); w.z = cvt_pk_bf16(y1[0], y1[1]); w.w = cvt_pk_bf16(y1[2], y1[3]); *(u32x4*)(XB + ro + bj * HALF) = w;
                        sq += ((y0[0] * y0[0] + y0[1] * y0[1]) + (y0[2] * y0[2] + y0[3] * y0[3])) + ((y1[0] * y1[0] + y1[1] * y1[1]) + (y1[2] * y1[2] + y1[3] * y1[3])); } }
                if (XB && !dry) { sq += __shfl_xor(sq, 16); sq += __shfl_xor(sq, 32); if (fq == 0) atomicAdd(rowss + row, sq); } }
        }
    }
};

struct EpiSwiglu {
    static constexpr bool PERM = true, AFTER_DRAIN = false;
    bf16_t* H; int ldc; const float* rss;
    __device__ __forceinline__ void operator()(const f32x4 (&acc)[2][2][4][2], const Unit& u, int wr, int wc, int fr, int fq) const {
        const int row0 = u.pm * BM + wr * 64 + fr, col0 = u.pn * 128 + wc * 32 + 8 * fq;
#pragma unroll
        for (int ai = 0; ai < 2; ++ai)
#pragma unroll
            for (int m = 0; m < 4; ++m) { bf16_t* rowp = H + (size_t)(row0 + ai * HALF + m * 16) * ldc + col0;
                float rs = 1.f; if (rss) rs = rsqrtf(rss[row0 + ai * HALF + m * 16] * (1.f / 1024.f) + 1e-6f);
                float r[8];
#pragma unroll
                for (int n = 0; n < 2; ++n)
#pragma unroll
                    for (int j = 0; j < 4; ++j) { const float a = acc[ai][0][m][n][j] * rs, b = acc[ai][1][m][n][j] * rs; r[4 * n + j] = a * sigmoidf_(a) * b; }
                u32x4 w; w.x = cvt_pk_bf16(r[0], r[1]); w.y = cvt_pk_bf16(r[2], r[3]); w.z = cvt_pk_bf16(r[4], r[5]); w.w = cvt_pk_bf16(r[6], r[7]);
                *(u32x4*)rowp = w; }
    }
};
}

typedef unsigned short bf16;
typedef float f32x4 __attribute__((ext_vector_type(4)));
typedef unsigned u32x4 __attribute__((ext_vector_type(4)));
typedef unsigned u32x2 __attribute__((ext_vector_type(2)));
#define LAS __attribute__((address_space(3)))
constexpr int NT = 16384, SEQL = 4096, DM = 1024, PW = 5120, INW = 10248, FFH = 2816;
constexpr float EPSN = 1e-6f;
constexpr size_t MiB = 1u << 20;
constexpr size_t WS_W = 0, WS_XN = 48 * MiB, WS_PROJ = 80 * MiB, WS_MISC = 240 * MiB, WS_VT = 248 * MiB, WS_WVT = 280 * MiB, WS_XCT = 284 * MiB, WS_SSQ32 = 308 * MiB, WS_HD = 310 * MiB, WS_HB = 318 * MiB, WS_END = 320 * MiB;
constexpr size_t W_IN = 0, W_G = W_IN + (size_t)5120 * 1024, W_B = W_G + (size_t)4096 * 1024, W_MO = W_B + (size_t)4 * 1024 * 512, W_XQ = W_MO + (size_t)1024 * 1024,
                 W_XKV = W_XQ + (size_t)512 * 1024, W_XO = W_XKV + (size_t)1024 * 1024, W_FI = W_XO + (size_t)1024 * 512, W_FO = W_FI + (size_t)5632 * 1024, W_TOT = W_FO + (size_t)1024 * 2816;
static_assert(W_TOT * 2 <= 48 * MiB, "weights fit");
constexpr size_t MS_DT = 0, MS_SSQ = 512 * 1024, MS_MN = 1 * MiB, MS_KV = 3 * MiB, MS_BAR = 4 * MiB, MS_VTX = 5 * MiB, MS_ROPE = 6 * MiB, MS_CNT = 7 * MiB, MS_FLG = 7 * MiB + 4096, MS_GD = 7 * MiB + 8192;
constexpr int C_AQ = 0, C_AK = 512, C_AV = 1024, C_BQ = 1536, C_BK = 1792, C_BG = 2048, C_CQ = 2560, C_CK = 3072, C_DZ = 3584, C_DX = 4096;
constexpr int VT_C = 0, VT_B = 512;
constexpr int C_GS = 512, C_MG = 4096;
constexpr int LDS_BYTES = 147456;

__device__ __forceinline__ float bf2f(bf16 v) { return __builtin_bit_cast(float, (unsigned)v << 16); }
__device__ __forceinline__ float bflo(unsigned w) { return __builtin_bit_cast(float, w << 16); }
__device__ __forceinline__ float bfhi(unsigned w) { return __builtin_bit_cast(float, w & 0xffff0000u); }
__device__ __forceinline__ unsigned f2bf(float f) { unsigned u = __builtin_bit_cast(unsigned, f); return (u + 0x7fffu + ((u >> 16) & 1u)) >> 16; }
__device__ __forceinline__ unsigned pk2(float lo, float hi) { return f2bf(lo) | (f2bf(hi) << 16); }
__device__ __forceinline__ float wave_sum(float v) {
#pragma unroll
    for (int o = 1; o < 64; o <<= 1) v += __shfl_xor(v, o);
    return v;
}
__device__ __forceinline__ float siluf_(float x) { return x * __builtin_amdgcn_rcpf(1.f + __expf(-x)); }
__device__ __forceinline__ void unpack8(const u32x4 w, float* f) { f[0] = bflo(w.x); f[1] = bfhi(w.x); f[2] = bflo(w.y); f[3] = bfhi(w.y); f[4] = bflo(w.z); f[5] = bfhi(w.z); f[6] = bflo(w.w); f[7] = bfhi(w.w); }

#ifndef PHMASK
#define PHMASK 0xFFFF
#endif
#ifndef DRYMASK
#define DRYMASK 0
#endif
#ifndef XSYNC
#define XSYNC 0
#endif
#ifndef DRYSEG
#define DRYSEG 3
#endif
#ifndef PROBE
#define PROBE 0
#endif
#ifndef PROBE_LO
#define PROBE_LO 0
#define PROBE_HI 2
#endif
#ifndef REPMASK
#define REPMASK 0
#endif
struct Args { const float* in[24]; float* out; unsigned char* ws; int ph_lo, ph_hi; };
typedef const __attribute__((address_space(4))) Args* ArgP;
struct Ctx {
    unsigned char* ws;
    int tid, lane, wave, wg, nwg;
};

__device__ __forceinline__ void conv_w(const Ctx& c, unsigned char* lds_raw, const float* W, int srcN, int K, int Ndst, bf16* WT, int mode, int off, int rot, const float* gk = nullptr) {
    float* T = (float*)lds_raw;
    const int nb = Ndst / 64, kb = K / 64, tot = nb * kb, tid = c.tid;
    int start = c.wg - (rot % c.nwg); if (start < 0) start += c.nwg;
    for (int it = start; it < tot; it += c.nwg) {
        const int n0 = (it % nb) * 64, k0 = (it / nb) * 64;
        {   const int n4 = (tid & 15) * 4, n = n0 + n4;
            const int sc = mode == 0 ? off + n : (((n & 255) < 128) ? (n >> 8) * 128 + (n & 255) : FFH + (n >> 8) * 128 + (n & 255) - 128);
#pragma unroll
            for (int i = 0; i < 2; ++i) { const int kk = (tid >> 4) + 32 * i; f32x4 v = *(const f32x4*)(W + (size_t)(k0 + kk) * srcN + sc);
                if (gk) v = v * gk[k0 + kk];
                T[kk * 65 + n4] = v[0]; T[kk * 65 + n4 + 1] = v[1]; T[kk * 65 + n4 + 2] = v[2]; T[kk * 65 + n4 + 3] = v[3]; } }
        __syncthreads();
        {   const int n = tid >> 3, kc = (tid & 7) * 8; const float* tp = T + kc * 65 + n;
            u32x4 o; o.x = pk2(tp[0], tp[65]); o.y = pk2(tp[130], tp[195]); o.z = pk2(tp[260], tp[325]); o.w = pk2(tp[390], tp[455]);
            *(u32x4*)(WT + (size_t)(n0 + n) * K + k0 + kc) = o; }
        __syncthreads();
    }
}
__device__ __forceinline__ void convert_layer(const Ctx& c, ArgP A, unsigned char* lds_raw, int l) {
    bf16* Wb = (bf16*)(c.ws + WS_W);
    const float* w_in = A->in[3] + (size_t)l * DM * INW;
    conv_w(c, lds_raw, w_in, INW, 1024, 1536, Wb + W_IN, 0, 0, 0);
    conv_w(c, lds_raw, w_in, INW, 1024, 512, Wb + W_IN + (size_t)1536 * 1024, 0, 1536, 16);
    conv_w(c, lds_raw, w_in, INW, 1024, 512, Wb + W_IN + (size_t)2048 * 1024, 0, 2560, 80);
    conv_w(c, lds_raw, w_in, INW, 1024, 1024, Wb + W_IN + (size_t)2560 * 1024, 0, 3072, 144);
    conv_w(c, lds_raw, w_in, INW, 1024, 1536, Wb + W_IN + (size_t)3584 * 1024, 0, 4608, 0);
    conv_w(c, lds_raw, w_in, INW, 1024, 4096, Wb + W_G, 0, 6152, 0);
    conv_w(c, lds_raw, w_in, INW, 1024, 512, (bf16*)(c.ws + WS_WVT), 0, 4096, 192);
    conv_w(c, lds_raw, w_in, INW, 1024, 512, (bf16*)(c.ws + WS_WVT) + (size_t)512 * 1024, 0, 2048, 128);
    for (int i = 0; i < 4; ++i) conv_w(c, lds_raw, A->in[13] + ((size_t)l * 4 + i) * 512 * 1024, 1024, 512, 1024, Wb + W_B + (size_t)i * 1024 * 512, 0, 0, 32 * i);
    conv_w(c, lds_raw, A->in[14] + (size_t)l * 1024 * 1024, 1024, 1024, 1024, Wb + W_MO, 0, 0, 128);
    conv_w(c, lds_raw, A->in[17] + (size_t)l * 1024 * 512, 512, 1024, 512, Wb + W_XQ, 0, 0, 0, A->in[15] + (size_t)l * DM);
    conv_w(c, lds_raw, A->in[18] + (size_t)l * 1024 * 1024, 1024, 1024, 1024, Wb + W_XKV, 0, 0, 128);
    conv_w(c, lds_raw, A->in[19] + (size_t)l * 512 * 1024, 1024, 512, 1024, Wb + W_XO, 0, 0, 0);
    conv_w(c, lds_raw, A->in[21] + (size_t)l * 1024 * 5632, 5632, 1024, 5632, Wb + W_FI, 1, 0, 128, A->in[20] + (size_t)l * DM);
    conv_w(c, lds_raw, A->in[22] + (size_t)l * FFH * 1024, 1024, FFH, 1024, Wb + W_FO, 0, 0, 0);
}

__device__ __forceinline__ void norm_rows(const Ctx& c, const float* X, const float* g, bf16* out, int nrows, const float* Wdt, float* dt_out) {
    const int gw = c.wg * 8 + c.wave, ngw = c.nwg * 8, lane = c.lane;
    f32x4 gv[4];
#pragma unroll
    for (int j = 0; j < 4; ++j) gv[j] = *((const f32x4*)g + lane + 64 * j);
    for (int row = gw; row < nrows; row += ngw) {
        const f32x4* xr = (const f32x4*)(X + (size_t)row * DM) + lane;
        f32x4 v[4]; float s = 0.f;
#pragma unroll
        for (int j = 0; j < 4; ++j) { v[j] = xr[64 * j]; s += (v[j].x * v[j].x + v[j].y * v[j].y) + (v[j].z * v[j].z + v[j].w * v[j].w); }
        const float rs = rsqrtf(wave_sum(s) * (1.f / DM) + EPSN);
        unsigned long long* o8 = (unsigned long long*)(out + (size_t)row * DM) + lane;
#pragma unroll
        for (int j = 0; j < 4; ++j) { v[j] = v[j] * rs * gv[j]; o8[64 * j] = (unsigned long long)pk2(v[j].x, v[j].y) | ((unsigned long long)pk2(v[j].z, v[j].w) << 32); }
        if (Wdt) {
            f32x4 a0 = (f32x4){0.f, 0.f, 0.f, 0.f}, a1 = a0;
#pragma unroll
            for (int j = 0; j < 4; ++j)
#pragma unroll
                for (int e = 0; e < 4; ++e) { const int k = 4 * lane + 256 * j + e; const float* wp = Wdt + k * 8;
                    const f32x4 w0 = *(const f32x4*)wp, w1 = *(const f32x4*)(wp + 4); a0 += w0 * v[j][e]; a1 += w1 * v[j][e]; }
#pragma unroll
            for (int e = 0; e < 4; ++e) { a0[e] = wave_sum(a0[e]); a1[e] = wave_sum(a1[e]); }
            if (lane == 0) { *(f32x4*)(dt_out + (size_t)row * 8) = a0; *(f32x4*)(dt_out + (size_t)row * 8 + 4) = a1; }
        }
    }
}
__device__ __forceinline__ void final_norm(const Ctx& c, float* X, const float* g) {
    const int gw = c.wg * 8 + c.wave, ngw = c.nwg * 8, lane = c.lane;
    for (int row = gw; row < NT; row += ngw) {
        f32x4* xr = (f32x4*)(X + (size_t)row * DM) + lane;
        f32x4 v[4]; float s = 0.f;
#pragma unroll
        for (int j = 0; j < 4; ++j) { v[j] = xr[64 * j]; s += (v[j].x * v[j].x + v[j].y * v[j].y) + (v[j].z * v[j].z + v[j].w * v[j].w); }
        const float rs = rsqrtf(wave_sum(s) * (1.f / DM) + EPSN);
#pragma unroll
        for (int j = 0; j < 4; ++j) xr[64 * j] = v[j] * rs * *((const f32x4*)g + lane + 64 * j);
    }
}

#define OSM_UPDATE(sc, NV, vexpr) do { float _p; if ((sc) > mrun) { const float _r = __expf(mrun - (sc)); lrun *= _r; _Pragma("unroll") for (int _i = 0; _i < NV; ++_i) o[_i] *= _r; mrun = (sc); _p = 1.f; } \
    else _p = __expf((sc) - mrun); lrun += _p; _Pragma("unroll") for (int _i = 0; _i < NV; ++_i) o[_i] += _p * (vexpr); } while (0)

#define WG_BARRIER() asm volatile("s_waitcnt lgkmcnt(0)\n\ts_barrier" ::: "memory")
typedef short bf16x8_t __attribute__((ext_vector_type(8)));
typedef short s16x4_t __attribute__((ext_vector_type(4)));
typedef float f32x2_t __attribute__((ext_vector_type(2)));
typedef __bf16 bf16x2_t __attribute__((ext_vector_type(2)));
#define MFMA16(a, b, c) __builtin_amdgcn_mfma_f32_16x16x32_bf16((a), (b), (c), 0, 0, 0)
__device__ __forceinline__ unsigned cvtpk(float lo, float hi) { f32x2_t v = {lo, hi}; bf16x2_t b = __builtin_convertvector(v, bf16x2_t); return __builtin_bit_cast(unsigned, b); }
__device__ __forceinline__ bf16x8_t pack8(const float* p) { u32x4 w; w.x = cvtpk(p[0], p[1]); w.y = cvtpk(p[2], p[3]); w.z = cvtpk(p[4], p[5]); w.w = cvtpk(p[6], p[7]); return __builtin_bit_cast(bf16x8_t, w); }
__device__ __forceinline__ float ex2(float x) { return __builtin_amdgcn_exp2f(x); }

__device__ __forceinline__ void mixer_c_mfma(const Ctx& c, ArgP A, unsigned char* lds_raw, int l, int dry, unsigned* cnt) {
    bf16* P = (bf16*)(c.ws + WS_PROJ); const bf16* VT = (const bf16*)(c.ws + WS_VT) + (size_t)VT_C * NT;
    unsigned char* sK = lds_raw;
    unsigned char* sV = lds_raw + 64 * 272;
    const float* lp = A->in[5] + (size_t)l * 256;
    float d0 = 0.f, d1 = 0.f;
    for (int i = 0; i < 64; ++i) { d0 += lp[i] * lp[64 + i]; d1 += lp[128 + i] * lp[192 + i]; }
    const float lam_init = 0.8f - 0.6f * expf(-0.3f * (float)l);
    const float lam = expf(d0) - expf(d1) + lam_init;
    const float* sg = A->in[6] + (size_t)l * 128;
    const int tid = c.tid, lane = c.lane, wave = c.wave, fr = lane & 15, fq = lane >> 4;
    constexpr float C2 = 0.125f * 1.4426950408889634f;
    volatile int* sIdx = (volatile int*)(lds_raw + 73728);
    for (;;) {
        __syncthreads();
        if (tid == 0) *sIdx = (int)atomicAdd(cnt, 1u);
        __syncthreads();
        const int u0 = *sIdx; if (u0 >= 512) break;
        const int bh = u0 & 15, qblk = 31 - (u0 >> 4);
        const int b = bh >> 2, h = bh & 3;
        const int qs = qblk * 128 + wave * 16 + fr;
        bf16* qp = P + ((size_t)b * SEQL + qs) * PW + C_CQ + h * 128;
        bf16x8_t qf[2][2];
#pragma unroll
        for (int c2 = 0; c2 < 2; ++c2)
#pragma unroll
            for (int ks = 0; ks < 2; ++ks) qf[c2][ks] = *(const bf16x8_t*)(qp + c2 * 64 + ks * 32 + fq * 8);
        f32x4 oacc[2][8];
#pragma unroll
        for (int c2 = 0; c2 < 2; ++c2)
#pragma unroll
            for (int eb = 0; eb < 8; ++eb) oacc[c2][eb] = (f32x4){0.f, 0.f, 0.f, 0.f};
        float mrun[2] = {-1e30f, -1e30f};
        f32x4 lacc[2] = {(f32x4){0.f, 0.f, 0.f, 0.f}, (f32x4){0.f, 0.f, 0.f, 0.f}};
        unsigned o1_ = 0x3F803F80u; asm volatile("" : "+v"(o1_));
        const u32x4 ones_u = {o1_, o1_, o1_, o1_}; const bf16x8_t ones = __builtin_bit_cast(bf16x8_t, ones_u);
        const int qmax_w = qblk * 128 + wave * 16 + 15;
        const int ntile = 2 * (qblk + 1);
        const size_t rowb0 = (size_t)b * SEQL;
        u32x4 pk[2], pv[2];
#pragma unroll
        for (int i = 0; i < 2; ++i) { const int ch = tid + 512 * i;
            pk[i] = *(const u32x4*)(P + (rowb0 + (ch >> 4)) * PW + C_CK + h * 128 + (ch & 15) * 8);
            pv[i] = *(const u32x4*)(VT + (size_t)(h * 128 + (ch >> 3)) * NT + rowb0 + (ch & 7) * 8); }
        for (int kt = 0; kt < ntile; ++kt) {
            unsigned char* bK = sK + (kt & 1) * 36864; unsigned char* bV = bK + 64 * 272;
#pragma unroll
            for (int i = 0; i < 2; ++i) { const int ch = tid + 512 * i;
                *(u32x4*)(bK + (ch >> 4) * 272 + (ch & 15) * 16) = pk[i]; *(u32x4*)(bV + (ch >> 3) * 144 + (ch & 7) * 16) = pv[i]; }
            if (kt + 1 < ntile) { const size_t rowb = rowb0 + (kt + 1) * 64;
#pragma unroll
                for (int i = 0; i < 2; ++i) { const int ch = tid + 512 * i;
                    pk[i] = *(const u32x4*)(P + (rowb + (ch >> 4)) * PW + C_CK + h * 128 + (ch & 15) * 8);
                    pv[i] = *(const u32x4*)(VT + (size_t)(h * 128 + (ch >> 3)) * NT + rowb + (ch & 7) * 8); } }
            WG_BARRIER();
#pragma unroll
            for (int kb2 = 0; kb2 < 2; ++kb2) {
                const int k0 = kt * 64 + kb2 * 32;
                if (k0 > qmax_w) continue;
                bf16x8_t vf[8];
#pragma unroll
                for (int eb = 0; eb < 8; ++eb) { const unsigned char* vp = bV + (eb * 16 + fr) * 144 + (kb2 * 32 + 4 * fq) * 2;
                    const s16x4_t lo = *(const s16x4_t*)vp, hi = *(const s16x4_t*)(vp + 32); vf[eb] = __builtin_shufflevector(lo, hi, 0, 1, 2, 3, 4, 5, 6, 7); }
#pragma unroll
                for (int c2 = 0; c2 < 2; ++c2) {
                    f32x4 s0 = (f32x4){0.f, 0.f, 0.f, 0.f}, s1 = s0;
#pragma unroll
                    for (int ks = 0; ks < 2; ++ks) { const unsigned char* kp = bK + (kb2 * 32 + fr) * 272 + (c2 * 64 + ks * 32 + fq * 8) * 2;
                        const bf16x8_t ka = *(const bf16x8_t*)kp, kb = *(const bf16x8_t*)(kp + 16 * 272);
                        s0 = MFMA16(ka, qf[c2][ks], s0); s1 = MFMA16(kb, qf[c2][ks], s1); }
                    float sc[8];
                    if (k0 + 31 <= qblk * 128 + wave * 16) {
#pragma unroll
                        for (int j = 0; j < 4; ++j) { sc[j] = s0[j]; sc[4 + j] = s1[j]; }
                    } else {
#pragma unroll
                        for (int j = 0; j < 4; ++j) { const int kp0 = k0 + 4 * fq + j; sc[j] = (kp0 <= qs) ? s0[j] : -1e30f; sc[4 + j] = (kp0 + 16 <= qs) ? s1[j] : -1e30f; }
                    }
                    float mx = fmaxf(fmaxf(fmaxf(sc[0], sc[1]), fmaxf(sc[2], sc[3])), fmaxf(fmaxf(sc[4], sc[5]), fmaxf(sc[6], sc[7])));
                    mx = fmaxf(mx, __shfl_xor(mx, 16)); mx = fmaxf(mx, __shfl_xor(mx, 32));
                    const float mnew = fmaxf(mrun[c2], mx); const float alpha = ex2((mrun[c2] - mnew) * C2); mrun[c2] = mnew; const float nm = -mnew * C2;
                    float p[8];
#pragma unroll
                    for (int i = 0; i < 8; ++i) p[i] = ex2(__builtin_fmaf(sc[i], C2, nm));
                    const bf16x8_t pf = pack8(p);
                    if (__any(alpha != 1.f)) { lacc[c2] = lacc[c2] * alpha;
#pragma unroll
                        for (int eb = 0; eb < 8; ++eb) oacc[c2][eb] = oacc[c2][eb] * alpha; }
#pragma unroll
                    for (int eb = 0; eb < 8; ++eb) oacc[c2][eb] = MFMA16(vf[eb], pf, oacc[c2][eb]);
                    lacc[c2] = MFMA16(ones, pf, lacc[c2]);
                }
            }
        }
        float linv[2];
#pragma unroll
        for (int c2 = 0; c2 < 2; ++c2) linv[c2] = 1.f / lacc[c2][0];
        float ss = 0.f;
#pragma unroll
        for (int eb = 0; eb < 8; ++eb) { oacc[0][eb] = oacc[0][eb] * linv[0] - oacc[1][eb] * (lam * linv[1]);
            ss += (oacc[0][eb][0] * oacc[0][eb][0] + oacc[0][eb][1] * oacc[0][eb][1]) + (oacc[0][eb][2] * oacc[0][eb][2] + oacc[0][eb][3] * oacc[0][eb][3]); }
        ss += __shfl_xor(ss, 16); ss += __shfl_xor(ss, 32);
        const float rs = rsqrtf(ss * (1.f / 128.f) + EPSN) * (1.f - lam_init);
#pragma unroll
        for (int eb = 0; eb < 8; ++eb) { const int e0 = eb * 16 + 4 * fq; const f32x4 g4 = *(const f32x4*)(sg + e0);
            const unsigned lo = cvtpk(oacc[0][eb][0] * rs * g4[0], oacc[0][eb][1] * rs * g4[1]), hi = cvtpk(oacc[0][eb][2] * rs * g4[2], oacc[0][eb][3] * rs * g4[3]);
            if (!dry) *(unsigned long long*)(qp + e0) = (unsigned long long)lo | ((unsigned long long)hi << 32); }
    }
    __syncthreads();
}

typedef short v4i16_t __attribute__((ext_vector_type(4)));
__device__ __forceinline__ s16x4_t lds_tr16(const LAS unsigned char* p) { return __builtin_bit_cast(s16x4_t, __builtin_amdgcn_ds_read_tr16_b64_v4i16((LAS v4i16_t*)p)); }
__device__ __forceinline__ void mixer_a_mfma(const Ctx& c, unsigned char* lds_raw, int dry, unsigned* cnt) {
    bf16* P = (bf16*)(c.ws + WS_PROJ);
    const int lane = c.lane, fr = lane & 15, fq = lane >> 4;
    LAS unsigned char* wl = (LAS unsigned char*)lds_raw + c.wave * 4608;
    const LAS unsigned char* trp = wl + (4 * fq + (fr >> 2)) * 144 + (fr & 3) * 8;
    constexpr float C2 = 0.125f * 1.4426950408889634f;
    for (;;) {
        int g = 0; if (lane == 0) g = (int)atomicAdd(cnt, 1u); g = __shfl(g, 0); if (g >= 4096) break;
        const int r8 = g & 7, h = (g >> 3) & 7, blk = (g >> 6) & 15, b = g >> 10;
        const int sbase0 = blk * 256 + r8;
        const size_t tb = (size_t)b * SEQL;
        bf16* qp0 = P + (tb + sbase0 + 16 * fr) * PW + C_AQ + h * 64;
        bf16x8_t qf[2][2];
#pragma unroll
        for (int gq = 0; gq < 2; ++gq)
#pragma unroll
            for (int ks = 0; ks < 2; ++ks) qf[gq][ks] = *(const bf16x8_t*)(qp0 + (size_t)gq * 8 * PW + ks * 32 + fq * 8);
        f32x4 oacc[2][4];
#pragma unroll
        for (int gq = 0; gq < 2; ++gq)
#pragma unroll
            for (int eb = 0; eb < 4; ++eb) oacc[gq][eb] = (f32x4){0.f, 0.f, 0.f, 0.f};
        float mrun[2] = {-1e30f, -1e30f}, lrun[2] = {0.f, 0.f};
        for (int st = 0; st < 28; ++st) {
            int sh, m0, boff, gmask;
            if (st < 12) { sh = 0; m0 = -128 + 32 * st; boff = 0; gmask = 3; }
            else if (st < 18) { sh = 2; m0 = -128 + 32 * (st - 12); boff = 0; gmask = 3; }
            else if (st < 23) { sh = 4; m0 = -128 + 32 * (st - 18); boff = 0; gmask = 1; }
            else { sh = 4; m0 = -128 + 32 * (st - 23); boff = 8; gmask = 2; }
            const int d = 1 << sh, kb0 = sbase0 + boff;
            if (kb0 + d * (m0 + 31) < 0) continue;
            u32x4 vr[4];
#pragma unroll
            for (int i = 0; i < 4; ++i) { const int cch = lane + 64 * i, rr = cch >> 3, part = cch & 7; int tk = kb0 + d * (m0 + rr); tk = min(max(tk, 0), SEQL - 1);
                vr[i] = *(const u32x4*)(P + (tb + tk) * PW + C_AV + h * 64 + part * 8); }
            int tk0 = kb0 + d * (m0 + fr), tk1 = tk0 + 16 * d;
            tk0 = min(max(tk0, 0), SEQL - 1); tk1 = min(max(tk1, 0), SEQL - 1);
            const bf16* k0p = P + (tb + tk0) * PW + C_AK + h * 64 + fq * 8; const bf16* k1p = P + (tb + tk1) * PW + C_AK + h * 64 + fq * 8;
            bf16x8_t ka[2], kb[2];
#pragma unroll
            for (int ks = 0; ks < 2; ++ks) { ka[ks] = *(const bf16x8_t*)(k0p + ks * 32); kb[ks] = *(const bf16x8_t*)(k1p + ks * 32); }
#pragma unroll
            for (int i = 0; i < 4; ++i) { const int cch = lane + 64 * i, rr = cch >> 3, part = cch & 7; *(LAS u32x4*)(wl + rr * 144 + part * 16) = vr[i]; }
            bf16x8_t vf[4];
#pragma unroll
            for (int eb = 0; eb < 4; ++eb) { const s16x4_t lo = lds_tr16(trp + eb * 32), hi = lds_tr16(trp + 16 * 144 + eb * 32); vf[eb] = __builtin_shufflevector(lo, hi, 0, 1, 2, 3, 4, 5, 6, 7); }
#pragma unroll
            for (int gq = 0; gq < 2; ++gq) {
                if (!((gmask >> gq) & 1)) continue;
                const int qm = (8 * gq - boff + 16 * fr) >> sh;
                f32x4 s0 = (f32x4){0.f, 0.f, 0.f, 0.f}, s1 = s0;
#pragma unroll
                for (int ks = 0; ks < 2; ++ks) { s0 = MFMA16(ka[ks], qf[gq][ks], s0); s1 = MFMA16(kb[ks], qf[gq][ks], s1); }
                float sc[8]; bool vis[8];
#pragma unroll
                for (int j = 0; j < 4; ++j) { const int m = m0 + 4 * fq + j; const int dj0 = qm - m, dj1 = dj0 - 16; const int t0 = kb0 + d * m, t1 = t0 + 16 * d;
                    vis[j] = (dj0 >= 0) && (dj0 <= 128) && (t0 >= 0); vis[4 + j] = (dj1 >= 0) && (dj1 <= 128) && (t1 >= 0);
                    sc[j] = vis[j] ? s0[j] : -1e30f; sc[4 + j] = vis[4 + j] ? s1[j] : -1e30f; }
                float mx = fmaxf(fmaxf(fmaxf(sc[0], sc[1]), fmaxf(sc[2], sc[3])), fmaxf(fmaxf(sc[4], sc[5]), fmaxf(sc[6], sc[7])));
                mx = fmaxf(mx, __shfl_xor(mx, 16)); mx = fmaxf(mx, __shfl_xor(mx, 32));
                const float mnew = fmaxf(mrun[gq], mx); const float alpha = ex2((mrun[gq] - mnew) * C2); mrun[gq] = mnew; const float nm = -mnew * C2;
                float pr[8], ps = 0.f;
#pragma unroll
                for (int i = 0; i < 8; ++i) { pr[i] = vis[i] ? ex2(__builtin_fmaf(sc[i], C2, nm)) : 0.f; ps += pr[i]; }
                lrun[gq] = lrun[gq] * alpha + ps;
                const bf16x8_t pf = pack8(pr);
#pragma unroll
                for (int eb = 0; eb < 4; ++eb) { oacc[gq][eb] = oacc[gq][eb] * alpha; oacc[gq][eb] = MFMA16(vf[eb], pf, oacc[gq][eb]); }
            }
        }
#pragma unroll
        for (int gq = 0; gq < 2; ++gq) {
            float lt = lrun[gq]; lt += __shfl_xor(lt, 16); lt += __shfl_xor(lt, 32); const float linv = 1.f / lt;
            bf16* qp = qp0 + (size_t)gq * 8 * PW;
#pragma unroll
            for (int eb = 0; eb < 4; ++eb) { const unsigned lo = cvtpk(oacc[gq][eb][0] * linv, oacc[gq][eb][1] * linv), hi = cvtpk(oacc[gq][eb][2] * linv, oacc[gq][eb][3] * linv);
                if (!dry) *(unsigned long long*)(qp + eb * 16 + 4 * fq) = (unsigned long long)lo | ((unsigned long long)hi << 32); }
        }
    }
}

typedef __attribute__((address_space(1))) unsigned long long gu64_t;
typedef __attribute__((address_space(1))) unsigned gu32_t;
typedef unsigned long long u64x2_t __attribute__((ext_vector_type(2)));
__device__ __forceinline__ void st_pub16(void* p, const f32x4 v) {
    const u64x2_t q = __builtin_bit_cast(u64x2_t, v);
    __hip_atomic_store((gu64_t*)p, q[0], __ATOMIC_RELAXED, __HIP_MEMORY_SCOPE_AGENT);
    __hip_atomic_store((gu64_t*)((char*)p + 8), q[1], __ATOMIC_RELAXED, __HIP_MEMORY_SCOPE_AGENT);
}
__device__ __forceinline__ f32x4 ld_pub16(const void* p) {
    const unsigned long long a = __hip_atomic_load((gu64_t*)p, __ATOMIC_RELAXED, __HIP_MEMORY_SCOPE_AGENT), b = __hip_atomic_load((gu64_t*)p + 1, __ATOMIC_RELAXED, __HIP_MEMORY_SCOPE_AGENT);
    f32x4 v; v[0] = __builtin_bit_cast(float, (unsigned)a); v[1] = __builtin_bit_cast(float, (unsigned)(a >> 32)); v[2] = __builtin_bit_cast(float, (unsigned)b); v[3] = __builtin_bit_cast(float, (unsigned)(b >> 32)); return v;
}
__device__ __forceinline__ void pub_flag(unsigned* flag, unsigned epoch, int tid) {
    asm volatile("s_waitcnt vmcnt(0)" ::: "memory");
    __syncthreads();
    if (tid == 0) __hip_atomic_store((gu32_t*)flag, epoch, __ATOMIC_RELAXED, __HIP_MEMORY_SCOPE_AGENT);
}
__device__ __forceinline__ void wait_flags(unsigned* flags, int n, unsigned epoch, int wave) {
    if (wave == 0) {
        for (int i = 0; i < n; ++i) { unsigned sp = 0;
            while (__hip_atomic_load((gu32_t*)(flags + i), __ATOMIC_RELAXED, __HIP_MEMORY_SCOPE_AGENT) != epoch) { __builtin_amdgcn_s_sleep(2); if (++sp > (1u << 22)) break; } }
        __builtin_amdgcn_fence(__ATOMIC_ACQUIRE, "agent");
        asm volatile("s_waitcnt vmcnt(0)" ::: "memory");
    }
    __syncthreads();
}

struct BLoad { u32x4 x0, x1; f32x4 rp[4]; bf16x8_t vf[2]; s16x4_t vl[2], vh[2]; u32x2 gt[4]; };
__device__ __forceinline__ void b_issue(BLoad& L, const bf16* P, const float* rope, const bf16* vrow, int b, int h, int ch, int tid, int w, int fr, int fq) {
    const int s0 = ch * 64; const size_t t0 = (size_t)b * SEQL + s0;
    const int which = tid >> 8, tk = (tid >> 2) & 63, c4 = tid & 3;
    const bf16* src = P + (t0 + tk) * PW + (which ? C_BK : C_BQ) + h * 64 + 8 * c4;
    L.x0 = *(const u32x4*)src; L.x1 = *(const u32x4*)(src + 32);
    const float* rp = rope + ((size_t)(s0 + tk) * 32 + 8 * c4) * 2;
#pragma unroll
    for (int q = 0; q < 4; ++q) L.rp[q] = *(const f32x4*)(rp + 4 * q);
#pragma unroll
    for (int ks = 0; ks < 2; ++ks) { L.vf[ks] = *(const bf16x8_t*)(vrow + s0 + ks * 32 + fq * 8); L.vl[ks] = *(const s16x4_t*)(vrow + s0 + ks * 32 + 4 * fq); L.vh[ks] = *(const s16x4_t*)(vrow + s0 + ks * 32 + 16 + 4 * fq); }
#pragma unroll
    for (int qb = 0; qb < 4; ++qb) L.gt[qb] = *(const u32x2*)(P + (t0 + qb * 16 + fr) * PW + C_BG + h * 128 + 16 * w + 4 * fq);
}
__device__ __forceinline__ void mixer_b_mfma(const Ctx& c, ArgP A, unsigned char* lds_raw, int l, int unit, int seg, int dry) {
    constexpr int NSEG = 4, CPS = 16;
    const int c0 = seg * CPS, n1 = (seg < NSEG - 1) ? CPS : 0, nv = n1 + CPS;
    float* hloc = (float*)(c.ws + WS_HB); unsigned* flg = (unsigned*)(c.ws + WS_MISC + MS_FLG) + 128 + unit * NSEG;
    bf16* P = (bf16*)(c.ws + WS_PROJ); const bf16* VTb = (const bf16*)(c.ws + WS_VT) + (size_t)VT_B * NT;
    const float* rope = (const float*)(c.ws + WS_MISC + MS_ROPE);
    unsigned char* sQ = lds_raw;
    unsigned char* sK = lds_raw + 9216;
    unsigned char* sKT0 = lds_raw + 18432;
    unsigned char* sP = lds_raw + 36864;
    float* sSt = (float*)(lds_raw + 45056);
    const int b = unit >> 2, h = unit & 3, tid = c.tid, lane = c.lane, w = c.wave, fr = lane & 15, fq = lane >> 4;
    const float lg = log2f(1.f - exp2f(-5.f - (float)h));
    const float* gn = A->in[4] + (size_t)l * 512 + h * 128;
    f32x4 R[4];
#pragma unroll
    for (int i = 0; i < 4; ++i) R[i] = (f32x4){0.f, 0.f, 0.f, 0.f};
    const bf16* vrow = VTb + (size_t)(h * 128 + 16 * w + fr) * NT + (size_t)b * SEQL;
    const int which = tid >> 8, tk_s = (tid >> 2) & 63, c4 = tid & 3;
    BLoad nx; b_issue(nx, P, rope, vrow, b, h, c0, tid, w, fr, fq);
    for (int v = 0; v < nv; ++v) {
        if (v == n1) {
            int lane_l = lane; asm volatile("" : "+v"(lane_l));
            if (n1 > 0) {
                char* pb_ = (char*)hloc + (unsigned)((((unit * NSEG + seg) * 8 + w) * 4) * 64 + lane_l) * 16u;
#pragma unroll
                for (int db = 0; db < 4; ++db) st_pub16(pb_ + db * 1024, R[db]);
                pub_flag(flg + seg, (unsigned)(l + 1), tid);
            }
#pragma unroll
            for (int db = 0; db < 4; ++db) R[db] = (f32x4){0.f, 0.f, 0.f, 0.f};
            if (seg > 0) {
                wait_flags(flg, seg, (unsigned)(l + 1), w);
                const float gg = ex2(64.f * (float)CPS * lg);
#pragma unroll 1
                for (int sp = 0; sp < seg; ++sp) { const char* cb_ = (const char*)hloc + (unsigned)((((unit * NSEG + sp) * 8 + w) * 4) * 64 + lane_l) * 16u;
#pragma unroll
                    for (int db = 0; db < 4; ++db) R[db] = R[db] * gg + *(const f32x4*)(cb_ + db * 1024); }
            }
        }
        const int ch = c0 + (v < n1 ? v : v - n1);
        const int s0 = ch * 64; const size_t t0 = (size_t)b * SEQL + s0;
        const bool full = v >= n1;
        unsigned char* sKT = sKT0 + (v & 1) * 9216;
        const BLoad cu = nx;
        {
            float xa[8], xb[8], r1[8], r2[8]; unpack8(cu.x0, xa); unpack8(cu.x1, xb);
#pragma unroll
            for (int e = 0; e < 8; ++e) { const float cs = cu.rp[e >> 1][(e & 1) * 2], sn = cu.rp[e >> 1][(e & 1) * 2 + 1]; r1[e] = xa[e] * cs - xb[e] * sn; r2[e] = xa[e] * sn + xb[e] * cs; }
            if (which == 0) { if (full) { *(bf16x8_t*)(sQ + tk_s * 144 + c4 * 16) = pack8(r1); *(bf16x8_t*)(sQ + tk_s * 144 + 64 + c4 * 16) = pack8(r2); } }
            else {
#pragma unroll
                for (int e = 0; e < 8; ++e) { r1[e] *= 0.125f; r2[e] *= 0.125f; }
                if (full) { *(bf16x8_t*)(sK + tk_s * 144 + c4 * 16) = pack8(r1); *(bf16x8_t*)(sK + tk_s * 144 + 64 + c4 * 16) = pack8(r2); }
                const float dk = ex2((float)(63 - tk_s) * lg);
#pragma unroll
                for (int e = 0; e < 8; ++e) { *(bf16*)(sKT + (8 * c4 + e) * 144 + tk_s * 2) = (bf16)f2bf(r1[e] * dk); *(bf16*)(sKT + (32 + 8 * c4 + e) * 144 + tk_s * 2) = (bf16)f2bf(r2[e] * dk); } }
        }
        if (v + 1 < nv) b_issue(nx, P, rope, vrow, b, h, c0 + (v + 1 < n1 ? v + 1 : v + 1 - n1), tid, w, fr, fq);
        WG_BARRIER();
        if (full && w < 6) {
            const int qb = (w == 0) ? 0 : (w == 1) ? 1 : (w < 4) ? 2 : 3, kp = (w == 3 || w == 5) ? 1 : 0;
            f32x4 sa = (f32x4){0.f, 0.f, 0.f, 0.f}, sb = sa;
            const bool two = (2 * kp + 1) <= qb;
#pragma unroll
            for (int ks = 0; ks < 2; ++ks) { const bf16x8_t qf = *(const bf16x8_t*)(sQ + (qb * 16 + fr) * 144 + (ks * 32 + fq * 8) * 2);
                const bf16x8_t ka = *(const bf16x8_t*)(sK + (kp * 32 + fr) * 144 + (ks * 32 + fq * 8) * 2);
                sa = MFMA16(ka, qf, sa);
                if (two) { const bf16x8_t kb = *(const bf16x8_t*)(sK + (kp * 32 + 16 + fr) * 144 + (ks * 32 + fq * 8) * 2); sb = MFMA16(kb, qf, sb); } }
            float p[8]; const int qi = qb * 16 + fr;
#pragma unroll
            for (int j = 0; j < 4; ++j) { const int k0 = kp * 32 + 4 * fq + j, k1 = k0 + 16;
                p[j] = (k0 <= qi) ? sa[j] * ex2((float)(qi - k0) * lg) : 0.f; p[4 + j] = (k1 <= qi) ? sb[j] * ex2((float)(qi - k1) * lg) : 0.f; }
            *(bf16x8_t*)(sP + (qb * 2 + kp) * 1024 + lane * 16) = pack8(p);
        }
        f32x4 acc[4];
        if (full) {
            bf16x8_t Rop[2];
#pragma unroll
            for (int ks = 0; ks < 2; ++ks) { float t8[8];
#pragma unroll
                for (int j = 0; j < 4; ++j) { t8[j] = R[2 * ks][j]; t8[4 + j] = R[2 * ks + 1][j]; }
                Rop[ks] = pack8(t8); }
#pragma unroll
            for (int qb = 0; qb < 4; ++qb) { acc[qb] = (f32x4){0.f, 0.f, 0.f, 0.f};
#pragma unroll
                for (int ks = 0; ks < 2; ++ks) { const unsigned char* qp = sQ + (qb * 16 + fr) * 144 + (ks * 32 + 4 * fq) * 2;
                    const s16x4_t lo = *(const s16x4_t*)qp, hi = *(const s16x4_t*)(qp + 32);
                    acc[qb] = MFMA16(Rop[ks], __builtin_shufflevector(lo, hi, 0, 1, 2, 3, 4, 5, 6, 7), acc[qb]); }
                acc[qb] = acc[qb] * ex2((float)(qb * 16 + fr + 1) * lg); }
        }
        {
            f32x4 kvn[4];
#pragma unroll
            for (int db = 0; db < 4; ++db) kvn[db] = (f32x4){0.f, 0.f, 0.f, 0.f};
#pragma unroll
            for (int ks = 0; ks < 2; ++ks) {
#pragma unroll
                for (int db = 0; db < 4; ++db) { const bf16x8_t kt = *(const bf16x8_t*)(sKT + (db * 16 + fr) * 144 + (ks * 32 + fq * 8) * 2); kvn[db] = MFMA16(kt, cu.vf[ks], kvn[db]); } }
            const float g64 = ex2(64.f * lg);
#pragma unroll
            for (int db = 0; db < 4; ++db) R[db] = R[db] * g64 + kvn[db];
        }
        if (full) {
        WG_BARRIER();
#pragma unroll
        for (int qb = 0; qb < 4; ++qb)
#pragma unroll
            for (int kp = 0; kp < 2; ++kp) { if (2 * kp > qb) continue;
                const bf16x8_t pf = *(const bf16x8_t*)(sP + (qb * 2 + kp) * 1024 + lane * 16);
                acc[qb] = MFMA16(__builtin_shufflevector(cu.vl[kp], cu.vh[kp], 0, 1, 2, 3, 4, 5, 6, 7), pf, acc[qb]); }
#pragma unroll
        for (int qb = 0; qb < 4; ++qb) { float s1 = (acc[qb][0] + acc[qb][1]) + (acc[qb][2] + acc[qb][3]);
            float s2 = (acc[qb][0] * acc[qb][0] + acc[qb][1] * acc[qb][1]) + (acc[qb][2] * acc[qb][2] + acc[qb][3] * acc[qb][3]);
            s1 += __shfl_xor(s1, 16); s1 += __shfl_xor(s1, 32); s2 += __shfl_xor(s2, 16); s2 += __shfl_xor(s2, 32);
            if (fq == 0) { sSt[((qb * 16 + fr) * 8 + w) * 2] = s1; sSt[((qb * 16 + fr) * 8 + w) * 2 + 1] = s2; } }
        WG_BARRIER();
#pragma unroll
        for (int qb = 0; qb < 4; ++qb) { const int tk = qb * 16 + fr; float s1 = 0.f, s2 = 0.f;
#pragma unroll
            for (int ww = 0; ww < 8; ww += 2) { const f32x4 v = *(const f32x4*)(sSt + (tk * 8 + ww) * 2); s1 += v[0] + v[2]; s2 += v[1] + v[3]; }
            const float mu = s1 * (1.f / 128.f); const float var = fmaxf(s2 * (1.f / 128.f) - mu * mu, 0.f); const float rstd = rsqrtf(var + EPSN);
            const int e0 = 16 * w + 4 * fq; bf16* gp = P + (t0 + tk) * PW + C_BG + h * 128 + e0;
            const u32x2 gw = cu.gt[qb]; const f32x4 g4 = *(const f32x4*)(gn + e0);
            const float y0 = siluf_(bflo(gw.x)) * (acc[qb][0] - mu) * rstd * g4[0], y1 = siluf_(bfhi(gw.x)) * (acc[qb][1] - mu) * rstd * g4[1];
            const float y2 = siluf_(bflo(gw.y)) * (acc[qb][2] - mu) * rstd * g4[2], y3 = siluf_(bfhi(gw.y)) * (acc[qb][3] - mu) * rstd * g4[3];
            u32x2 o; o.x = cvtpk(y0, y1); o.y = cvtpk(y2, y3); if (!dry) *(u32x2*)gp = o; }
        }
    }
    __syncthreads();
}

#define XB_TMO      128
#define XB_XCNT(j)  (256  + 64 * (j))
#define XB_XSUB(j)  (1280 + 64 * (j))
#define XB_XGEN(j)  (2304 + 64 * (j))
#define XB_TOP      3328
#define XB_TOPGEN   3392
#define XCD_BAR_WORDS 3456
#define XB_SPIN_CAP (1u << 23)

__device__ __forceinline__ unsigned xb_ld(unsigned* p)              { return __hip_atomic_load(p, __ATOMIC_RELAXED, __HIP_MEMORY_SCOPE_AGENT); }
__device__ __forceinline__ unsigned xb_add(unsigned* p, unsigned v) { return __hip_atomic_fetch_add(p, v, __ATOMIC_RELAXED, __HIP_MEMORY_SCOPE_AGENT); }
__device__ __forceinline__ unsigned xb_xcc_id() { return (unsigned)__builtin_amdgcn_s_getreg((3 << 11) | 20) & 0xFu; }
#define XB_SPIN(cond, bar) do { unsigned _sp = 0; while (cond) { __builtin_amdgcn_s_sleep(1); \
    if ((++_sp & 255u) == 0u) { if (xb_ld(&(bar)[XB_TMO])) break; if (_sp > XB_SPIN_CAP) { atomicAdd(&(bar)[XB_TMO], 1u); break; } } } } while (0)

struct XcdBarrier {
    unsigned* bar; unsigned x;
    volatile LAS unsigned* st;
};

__device__ __forceinline__ XcdBarrier xcd_barrier_post(unsigned* bar, volatile LAS unsigned* st) {
    XcdBarrier b; b.bar = bar; b.x = xb_xcc_id(); b.st = st;
    if (threadIdx.x == 0) (void)xb_add(&bar[XB_XCNT(b.x)], 1u);
    return b;
}
__device__ __forceinline__ void xcd_barrier_complete(unsigned* bar, unsigned x, unsigned& nloc, unsigned& nx) {
    const unsigned G = gridDim.x * gridDim.y * gridDim.z;
    unsigned sum, cnt, mine, sp = 0u;
    for (;;) {
        sum = 0u; cnt = 0u; mine = 0u;
#pragma unroll
        for (unsigned j = 0; j < 16; ++j) { const unsigned c = xb_ld(&bar[XB_XCNT(j)]); sum += c; cnt += (c > 0u) ? 1u : 0u; mine = (j == x) ? c : mine; }
        if (sum == G) break;
        __builtin_amdgcn_s_sleep(1);
        if ((++sp & 255u) == 0u) { if (xb_ld(&bar[XB_TMO])) break; if (sp > XB_SPIN_CAP) { atomicAdd(&bar[XB_TMO], 1u); break; } }
    }
    nloc = mine > 0u ? mine : 1u; nx = cnt > 0u ? cnt : 1u;
}

__device__ __forceinline__ void xcd_barrier(const XcdBarrier& b) {
    asm volatile("s_waitcnt vmcnt(0)" ::: "memory");
    __syncthreads();
    if (threadIdx.x == 0) {
        unsigned* bar = b.bar;
        __builtin_amdgcn_s_waitcnt(0);
        unsigned nloc = b.st[0], nx = b.st[1];
        if (nloc == 0u) { xcd_barrier_complete(bar, b.x, nloc, nx); b.st[0] = nloc; b.st[1] = nx; }
        const unsigned old = xb_add(&bar[XB_XSUB(b.x)], 1u);
        const unsigned gen = old / nloc;
        if (old + 1u == (gen + 1u) * nloc) {
            __builtin_amdgcn_fence(__ATOMIC_RELEASE, "agent");
            asm volatile("s_waitcnt vmcnt(0)" ::: "memory");
            const unsigned og = xb_add(&bar[XB_TOP], 1u);
            const unsigned tg = og / nx;
            if (og + 1u == (tg + 1u) * nx) xb_add(&bar[XB_TOPGEN], 1u);
            else XB_SPIN(xb_ld(&bar[XB_TOPGEN]) == tg, bar);
            __builtin_amdgcn_fence(__ATOMIC_ACQUIRE, "agent");
            xb_add(&bar[XB_XGEN(b.x)], 1u);
            asm volatile("s_waitcnt vmcnt(0)" ::: "memory");
        } else {
            XB_SPIN(xb_ld(&bar[XB_XGEN(b.x)]) == gen, bar);
            __builtin_amdgcn_fence(__ATOMIC_ACQUIRE, "agent");
            asm volatile("s_waitcnt vmcnt(0)" ::: "memory");
        }
    }
    __syncthreads();
}

#define CONV_GRID_BAR() do { XcdBarrier xb_; xb_.bar = (unsigned*)(ws + WS_MISC + MS_BAR); xb_.x = xb_xcc_id(); xb_.st = (volatile LAS unsigned*)((LAS unsigned char*)lds + LDS_BYTES - 64); xcd_barrier(xb_); } while (0)
__device__ __forceinline__ void conv_prepass(const Ctx& c, ArgP A, int l, unsigned char* ws, unsigned char* lds, int dry) {
    bf16* P = (bf16*)(c.ws + WS_PROJ); bf16* XCT = (bf16*)(c.ws + WS_XCT);
    const int item = c.wg * 512 + c.tid; const bool act = item < 131072;
    const int cg8 = item & 127, run = (item >> 7) & 1023, ch0 = cg8 * 8;
    const size_t tok0 = (size_t)run * 16; const int s_in = (int)(tok0 & (SEQL - 1));
    unsigned outp[16][4];
    if (act) {
        const float* cw = A->in[7] + (size_t)l * 4 * 1024 + ch0; const float* cb = A->in[8] + (size_t)l * 1024 + ch0;
        float wt[4][8], bias[8];
#pragma unroll
        for (int k = 0; k < 8; ++k) { bias[k] = cb[k];
#pragma unroll
            for (int w = 0; w < 4; ++w) wt[w][k] = cw[w * 1024 + k]; }
        float win[3][8];
#pragma unroll
        for (int r = 0; r < 3; ++r) {
            if (s_in == 0) {
#pragma unroll
                for (int k = 0; k < 8; ++k) win[r][k] = 0.f; }
            else unpack8(*(const u32x4*)(P + (tok0 - 3 + r) * PW + C_DX + ch0), win[r]); }
#pragma unroll
        for (int tk = 0; tk < 16; ++tk) { float cur[8]; unpack8(*(const u32x4*)(P + (tok0 + tk) * PW + C_DX + ch0), cur); float o[8];
#pragma unroll
            for (int k = 0; k < 8; ++k) { const float a = bias[k] + wt[0][k] * win[0][k] + wt[1][k] * win[1][k] + wt[2][k] * win[2][k] + wt[3][k] * cur[k]; o[k] = siluf_(a);
                win[0][k] = win[1][k]; win[1][k] = win[2][k]; win[2][k] = cur[k]; }
#pragma unroll
            for (int q = 0; q < 4; ++q) outp[tk][q] = cvtpk(o[2 * q], o[2 * q + 1]); }
        if (cg8 < 96) {
#pragma unroll
            for (int q = 0; q < 4; ++q) { u32x4 lo0, lo1, hi0, hi1;
#pragma unroll
                for (int m = 0; m < 4; ++m) { const unsigned a0 = outp[2 * m][q], a1 = outp[2 * m + 1][q], b0 = outp[8 + 2 * m][q], b1 = outp[8 + 2 * m + 1][q];
                    lo0[m] = (a0 & 0xffffu) | (a1 << 16); hi0[m] = (a0 >> 16) | (a1 & 0xffff0000u); lo1[m] = (b0 & 0xffffu) | (b1 << 16); hi1[m] = (b0 >> 16) | (b1 & 0xffff0000u); }
                bf16* r0 = XCT + (size_t)(ch0 + 2 * q) * NT + tok0; bf16* r1 = r0 + NT;
                *(u32x4*)r0 = lo0; *(u32x4*)(r0 + 8) = lo1; *(u32x4*)r1 = hi0; *(u32x4*)(r1 + 8) = hi1; } }
    }
    CONV_GRID_BAR();
    if (act && !dry) {
#pragma unroll
        for (int tk = 0; tk < 16; ++tk) { u32x4 o; o.x = outp[tk][0]; o.y = outp[tk][1]; o.z = outp[tk][2]; o.w = outp[tk][3]; *(u32x4*)(P + (tok0 + tk) * PW + C_DX + ch0) = o; }
    }
}

struct DLoad { u32x4 bc[4]; u32x4 bt[2]; float dtr; u32x4 xf[2]; s16x4_t xl[2], xh[2]; };
__device__ __forceinline__ void d_issue(DLoad& L, const bf16* P, const bf16* XCT, const float* dtr, unsigned xoff, int b, int g, int head, int head_s, int pb, int ch, int tid, int lane, int w, int fr, int fq) {
    const char* Pc = (const char*)P; const char* Xc = (const char*)XCT; const char* Dc = (const char*)dtr;
    const unsigned s0 = (unsigned)ch * 64u, t0 = (unsigned)b * SEQL + s0;
#pragma unroll
    for (int r = 0; r < 4; ++r) { const unsigned cn = tid + 512 * r, which = cn >> 10, tk = (cn >> 4) & 63, cc = cn & 15;
        L.bc[r] = *(const u32x4*)(Pc + ((t0 + tk) * PW + C_DX + 512 + which * 256 + g * 128 + cc * 8) * 2u); }
#pragma unroll
    for (int r = 0; r < 2; ++r) { const unsigned cn = tid + 512 * r, n = cn >> 3, cc = cn & 7; L.bt[r] = *(const u32x4*)(Xc + ((512u + g * 128 + n) * NT + t0 + cc * 8) * 2u); }
    L.dtr = (w < 2) ? *(const float*)(Dc + ((t0 + lane) * 8u + head_s) * 4u) : 0.f;
#pragma unroll
    for (int ks = 0; ks < 2; ++ks) { L.xf[ks] = *(const u32x4*)(Xc + xoff + (s0 + ks * 32 + fq * 8) * 2u); L.xl[ks] = *(const s16x4_t*)(Xc + xoff + (s0 + ks * 32 + 4 * fq) * 2u); L.xh[ks] = *(const s16x4_t*)(Xc + xoff + (s0 + ks * 32 + 16 + 4 * fq) * 2u); }
}
__device__ __forceinline__ void mixer_d_mfma(const Ctx& c, ArgP A, unsigned char* lds_raw, int l, int unit, int seg, int dry) {
    constexpr int NSEG = 4, CPS = 16;
    const int c0 = seg * CPS, n1 = (seg < NSEG - 1) ? CPS : 0, nv = n1 + CPS;
    float* hloc = (float*)(c.ws + WS_HD); unsigned* flg = (unsigned*)(c.ws + WS_MISC + MS_FLG) + unit * NSEG; float* gdl = (float*)(c.ws + WS_MISC + MS_GD) + unit * NSEG * 2;
    float gsum = 0.f;
    bf16* P = (bf16*)(c.ws + WS_PROJ); const bf16* XCT = (const bf16*)(c.ws + WS_XCT);
    unsigned char* sB = lds_raw;
    unsigned char* sC = lds_raw + 17408;
    unsigned char* sBT0 = lds_raw + 34816;
    unsigned char* sS = lds_raw + 71680;
    float* sDt = (float*)(lds_raw + 81920);
    float* sAc = sDt + 256;
    const int b = unit >> 2, pair = unit & 3, g = pair >> 1;
    const int tid = c.tid, lane = c.lane, w = c.wave, fr = lane & 15, fq = lane >> 4, hh = w >> 2, pb = w & 3, head = pair * 2 + hh;
    constexpr float L2E = 1.4426950408889634f;
    const int head_s = pair * 2 + (w & 1);
    const float* p_dtb = A->in[9] + l * 8 + head_s; const float* p_al = A->in[10] + l * 8 + head_s; const float* p_dsk = A->in[11] + l * 8 + head;
    const float* p_g4 = A->in[12] + (size_t)l * 512 + head * 64 + pb * 16 + 4 * fq;
    const float* dtr = (const float*)(c.ws + WS_MISC + MS_DT); float* ssq = (float*)(c.ws + WS_SSQ32);
    f32x4 H[8];
#pragma unroll
    for (int i = 0; i < 8; ++i) H[i] = (f32x4){0.f, 0.f, 0.f, 0.f};
    const unsigned xoff = ((unsigned)(head * 64 + pb * 16 + fr) * NT + (unsigned)b * SEQL) * 2u;
    DLoad nx; d_issue(nx, P, XCT, dtr, xoff, b, g, head, head_s, pb, c0, tid, lane, w, fr, fq);
    for (int v = 0; v < nv; ++v) {
        if (v == n1) {
            int lane_l = lane; asm volatile("" : "+v"(lane_l));
            if (n1 > 0) {
                char* pb_ = (char*)hloc + (unsigned)((((unit * NSEG + seg) * 8 + w) * 8) * 64 + lane_l) * 16u;
#pragma unroll
                for (int nb = 0; nb < 8; ++nb) st_pub16(pb_ + nb * 1024, H[nb]);
                if (pb == 0 && lane == 0) __hip_atomic_store((gu32_t*)(gdl + seg * 2 + hh), __builtin_bit_cast(unsigned, gsum), __ATOMIC_RELAXED, __HIP_MEMORY_SCOPE_AGENT);
                pub_flag(flg + seg, (unsigned)(l + 1), tid);
            }
#pragma unroll
            for (int nb = 0; nb < 8; ++nb) H[nb] = (f32x4){0.f, 0.f, 0.f, 0.f};
            if (seg > 0) {
                wait_flags(flg, seg, (unsigned)(l + 1), w);
#pragma unroll 1
                for (int sp = 0; sp < seg; ++sp) { const float gg = ex2(gdl[sp * 2 + hh]);
                    const char* cb_ = (const char*)hloc + (unsigned)((((unit * NSEG + sp) * 8 + w) * 8) * 64 + lane_l) * 16u;
#pragma unroll
                    for (int nb = 0; nb < 8; ++nb) H[nb] = H[nb] * gg + *(const f32x4*)(cb_ + nb * 1024); }
            }
        }
        const int ch = c0 + (v < n1 ? v : v - n1);
        const int s0 = ch * 64, par = v & 1; const size_t t0 = (size_t)b * SEQL + s0;
        const bool full = v >= n1;
        unsigned char* sBT = sBT0 + par * 18432;
        const DLoad cu = nx;
        if (full) {
#pragma unroll
            for (int r = 0; r < 4; ++r) { const int cn = tid + 512 * r, which = cn >> 10, tk = (cn >> 4) & 63, cc = cn & 15; *(u32x4*)((which ? sC : sB) + tk * 272 + cc * 16) = cu.bc[r]; } }
#pragma unroll
        for (int r = 0; r < 2; ++r) { const int cn = tid + 512 * r, n = cn >> 3, cc = cn & 7; *(u32x4*)(sBT + n * 144 + cc * 16) = cu.bt[r]; }
        if (w < 2) { const float x = cu.dtr + *p_dtb; const float dt = fmaxf(x, 0.f) + log1pf(__expf(-fabsf(x)));
            float a = dt * (-__expf(*p_al)) * L2E;
#pragma unroll
            for (int off = 1; off < 64; off <<= 1) { const float v = __shfl_up(a, off); if (lane >= off) a += v; }
            sDt[(par * 2 + w) * 64 + lane] = dt; sAc[(par * 2 + w) * 64 + lane] = a; }
        if (v + 1 < nv) d_issue(nx, P, XCT, dtr, xoff, b, g, head, head_s, pb, c0 + (v + 1 < n1 ? v + 1 : v + 1 - n1), tid, lane, w, fr, fq);
        WG_BARRIER();
        const float* dtv = sDt + (par * 2 + hh) * 64; const float* acv = sAc + (par * 2 + hh) * 64;
        f32x4 acc[4];
        if (full) {
        for (int ti = w; ti < 10; ti += 8) { const int qb = (ti >= 6) ? 3 : (ti >= 3) ? 2 : (ti >= 1) ? 1 : 0, kb = ti - qb * (qb + 1) / 2;
            f32x4 sacc = (f32x4){0.f, 0.f, 0.f, 0.f};
#pragma unroll
            for (int ks = 0; ks < 4; ++ks) { const bf16x8_t bfv = *(const bf16x8_t*)(sB + (kb * 16 + fr) * 272 + (ks * 32 + fq * 8) * 2), cfv = *(const bf16x8_t*)(sC + (qb * 16 + fr) * 272 + (ks * 32 + fq * 8) * 2);
                sacc = MFMA16(bfv, cfv, sacc); }
            *(f32x4*)(sS + ti * 1024 + lane * 16) = sacc; }
        {
            bf16x8_t Hop[4];
#pragma unroll
            for (int ks = 0; ks < 4; ++ks) { float t8[8];
#pragma unroll
                for (int j = 0; j < 4; ++j) { t8[j] = H[2 * ks][j]; t8[4 + j] = H[2 * ks + 1][j]; }
                Hop[ks] = pack8(t8); }
#pragma unroll
            for (int qb = 0; qb < 4; ++qb) { acc[qb] = (f32x4){0.f, 0.f, 0.f, 0.f};
#pragma unroll
                for (int ks = 0; ks < 4; ++ks) { const unsigned char* cp = sC + (qb * 16 + fr) * 272 + (ks * 32 + 4 * fq) * 2;
                    const s16x4_t lo = *(const s16x4_t*)cp, hi = *(const s16x4_t*)(cp + 32);
                    acc[qb] = MFMA16(Hop[ks], __builtin_shufflevector(lo, hi, 0, 1, 2, 3, 4, 5, 6, 7), acc[qb]); }
                acc[qb] = acc[qb] * ex2(acv[qb * 16 + fr]); }
        }
        }
        {
            const float aend = acv[63]; if (!full) gsum += aend;
            bf16x8_t xw[2];
#pragma unroll
            for (int ks = 0; ks < 2; ++ks) { float xv[8]; unpack8(cu.xf[ks], xv);
                const f32x4 d0 = *(const f32x4*)(dtv + ks * 32 + fq * 8), d1 = *(const f32x4*)(dtv + ks * 32 + fq * 8 + 4), a0 = *(const f32x4*)(acv + ks * 32 + fq * 8), a1 = *(const f32x4*)(acv + ks * 32 + fq * 8 + 4);
#pragma unroll
                for (int j = 0; j < 4; ++j) { xv[j] *= d0[j] * ex2(aend - a0[j]); xv[4 + j] *= d1[j] * ex2(aend - a1[j]); }
                xw[ks] = pack8(xv); }
            const float ge = ex2(aend);
#pragma unroll
            for (int nh = 0; nh < 2; ++nh) {
                f32x4 kvn[4];
#pragma unroll
                for (int nb = 0; nb < 4; ++nb) kvn[nb] = (f32x4){0.f, 0.f, 0.f, 0.f};
#pragma unroll
                for (int ks = 0; ks < 2; ++ks)
#pragma unroll
                    for (int nb = 0; nb < 4; ++nb) { const bf16x8_t bt = *(const bf16x8_t*)(sBT + ((nh * 4 + nb) * 16 + fr) * 144 + (ks * 32 + fq * 8) * 2); kvn[nb] = MFMA16(bt, xw[ks], kvn[nb]); }
#pragma unroll
                for (int nb = 0; nb < 4; ++nb) H[nh * 4 + nb] = H[nh * 4 + nb] * ge + kvn[nb];
            }
        }
        if (full) {
        WG_BARRIER();
        u32x2 xr[4], zr[4];
#pragma unroll
        for (int qb = 0; qb < 4; ++qb) { const unsigned t = (unsigned)t0 + qb * 16 + fr; const unsigned p0 = head * 64 + pb * 16 + 4 * fq;
            xr[qb] = *(const u32x2*)((const char*)P + (t * PW + C_DX + p0) * 2u); zr[qb] = *(const u32x2*)((const char*)P + (t * PW + C_DZ + p0) * 2u); }
#pragma unroll
        for (int qb = 0; qb < 4; ++qb) { const int qi = qb * 16 + fr; const float aq = acv[qi];
#pragma unroll
            for (int kp = 0; kp < 2; ++kp) { if (2 * kp > qb) continue;
                const int ti = qb * (qb + 1) / 2 + 2 * kp; const bool two = (2 * kp + 1) <= qb;
                const f32x4 sa = *(const f32x4*)(sS + ti * 1024 + lane * 16); f32x4 sb = (f32x4){0.f, 0.f, 0.f, 0.f}; if (two) sb = *(const f32x4*)(sS + (ti + 1) * 1024 + lane * 16);
                const int k0 = kp * 32 + 4 * fq;
                const f32x4 da = *(const f32x4*)(dtv + k0), db = *(const f32x4*)(dtv + k0 + 16), aa = *(const f32x4*)(acv + k0), ab = *(const f32x4*)(acv + k0 + 16);
                float p[8];
#pragma unroll
                for (int j = 0; j < 4; ++j) { p[j] = (k0 + j <= qi) ? sa[j] * da[j] * ex2(aq - aa[j]) : 0.f; p[4 + j] = (k0 + 16 + j <= qi) ? sb[j] * db[j] * ex2(aq - ab[j]) : 0.f; }
                acc[qb] = MFMA16(__builtin_shufflevector(cu.xl[kp], cu.xh[kp], 0, 1, 2, 3, 4, 5, 6, 7), pack8(p), acc[qb]); } }
        const float Dsk = *p_dsk; const f32x4 g4 = *(const f32x4*)p_g4;
#pragma unroll
        for (int qb = 0; qb < 4; ++qb) { const unsigned t = (unsigned)t0 + qb * 16 + fr; const unsigned p0 = head * 64 + pb * 16 + 4 * fq;
            const u32x2 xw = xr[qb]; bf16* zp = (bf16*)((char*)P + (t * PW + C_DZ + p0) * 2u); const u32x2 zw = zr[qb];
            const float y0 = (acc[qb][0] + Dsk * bflo(xw.x)) * siluf_(bflo(zw.x)), y1 = (acc[qb][1] + Dsk * bfhi(xw.x)) * siluf_(bfhi(zw.x));
            const float y2 = (acc[qb][2] + Dsk * bflo(xw.y)) * siluf_(bflo(zw.y)), y3 = (acc[qb][3] + Dsk * bfhi(xw.y)) * siluf_(bfhi(zw.y));
            float sq = (y0 * y0 + y1 * y1) + (y2 * y2 + y3 * y3); sq += __shfl_xor(sq, 16); sq += __shfl_xor(sq, 32);
            if (fq == 0 && !dry) ssq[t * 32 + head * 4 + pb] = sq;
            u32x2 o; o.x = cvtpk(y0 * g4[0], y1 * g4[1]); o.y = cvtpk(y2 * g4[2], y3 * g4[3]); if (!dry) *(u32x2*)zp = o; }
        }
    }
    __syncthreads();
}

__device__ __forceinline__ void xattn_mfma(const Ctx& c, unsigned char* lds_raw) {
    const bf16* XQ = (const bf16*)(c.ws + WS_PROJ); bf16* AO = (bf16*)(c.ws + WS_PROJ + 16 * MiB);
    const bf16* KX = (const bf16*)(c.ws + WS_MISC + MS_KV);
    const bf16* VTX = (const bf16*)(c.ws + WS_MISC + MS_VTX);
    unsigned char* sK = lds_raw;
    unsigned char* sV = lds_raw + 256 * 272;
    const int tid = c.tid, lane = c.lane, fr = lane & 15, fq = lane >> 4;
    constexpr float C2 = 0.08838834764831845f * 1.4426950408889634f;
    for (int u = c.wg; u < 256; u += c.nwg) {
        const int b = u >> 6, h = (u >> 4) & 3, tq = u & 15;
        __syncthreads();
#pragma unroll
        for (int i = 0; i < 8; ++i) { const int ch = tid + 512 * i;
            { const int rr = ch >> 4, cc = ch & 15; *(u32x4*)(sK + rr * 272 + cc * 16) = *(const u32x4*)(KX + (size_t)(b * 256 + rr) * 512 + h * 128 + cc * 8); }
            { const int e = ch >> 5, cc = ch & 31; *(u32x4*)(sV + e * 528 + cc * 16) = *(const u32x4*)(VTX + (size_t)(h * 128 + e) * 1024 + b * 256 + cc * 8); } }
        __syncthreads();
#pragma unroll 1
        for (int gi = 0; gi < 2; ++gi) {
            const size_t t = (size_t)b * SEQL + tq * 256 + (c.wave * 2 + gi) * 16 + fr;
            bf16x8_t qf[4];
#pragma unroll
            for (int ks = 0; ks < 4; ++ks) qf[ks] = *(const bf16x8_t*)(XQ + t * 512 + h * 128 + ks * 32 + fq * 8);
            f32x4 oacc[8];
#pragma unroll
            for (int eb = 0; eb < 8; ++eb) oacc[eb] = (f32x4){0.f, 0.f, 0.f, 0.f};
            float mrun = -1e30f, lrun = 0.f;
#pragma unroll 2
            for (int kp = 0; kp < 8; ++kp) {
                const unsigned char* k0p = sK + (kp * 32 + fr) * 272 + fq * 16;
                f32x4 s0 = (f32x4){0.f, 0.f, 0.f, 0.f}, s1 = s0;
#pragma unroll
                for (int ks = 0; ks < 4; ++ks) { const bf16x8_t ka = *(const bf16x8_t*)(k0p + ks * 64), kb = *(const bf16x8_t*)(k0p + 16 * 272 + ks * 64);
                    s0 = MFMA16(ka, qf[ks], s0); s1 = MFMA16(kb, qf[ks], s1); }
                float sc[8];
#pragma unroll
                for (int j = 0; j < 4; ++j) { sc[j] = s0[j]; sc[4 + j] = s1[j]; }
                float mx = fmaxf(fmaxf(fmaxf(sc[0], sc[1]), fmaxf(sc[2], sc[3])), fmaxf(fmaxf(sc[4], sc[5]), fmaxf(sc[6], sc[7])));
                mx = fmaxf(mx, __shfl_xor(mx, 16)); mx = fmaxf(mx, __shfl_xor(mx, 32));
                const float mnew = fmaxf(mrun, mx); const float alpha = ex2((mrun - mnew) * C2); mrun = mnew; const float nm = -mnew * C2;
                float pr[8], ps = 0.f;
#pragma unroll
                for (int i = 0; i < 8; ++i) { pr[i] = ex2(__builtin_fmaf(sc[i], C2, nm)); ps += pr[i]; }
                lrun = lrun * alpha + ps;
                const bf16x8_t pf = pack8(pr);
#pragma unroll
                for (int eb = 0; eb < 8; ++eb) { const unsigned char* vp = sV + (eb * 16 + fr) * 528 + (kp * 32 + 4 * fq) * 2;
                    const s16x4_t lo = *(const s16x4_t*)vp, hi = *(const s16x4_t*)(vp + 32);
                    oacc[eb] = oacc[eb] * alpha; oacc[eb] = MFMA16(__builtin_shufflevector(lo, hi, 0, 1, 2, 3, 4, 5, 6, 7), pf, oacc[eb]); }
            }
            float lt = lrun; lt += __shfl_xor(lt, 16); lt += __shfl_xor(lt, 32); const float linv = 1.f / lt;
            bf16* op = AO + t * 512 + h * 128 + 4 * fq;
#pragma unroll
            for (int eb = 0; eb < 8; ++eb) { u32x2 o; o.x = cvtpk(oacc[eb][0] * linv, oacc[eb][1] * linv); o.y = cvtpk(oacc[eb][2] * linv, oacc[eb][3] * linv); *(u32x2*)(op + eb * 16) = o; }
        }
    }
    __syncthreads();
}

__device__ __forceinline__ void mixer_b_naive(const Ctx& c, ArgP A, unsigned char* lds_raw, int l, int unit) {
    bf16* P = (bf16*)(c.ws + WS_PROJ); const bf16* VTb = (const bf16*)(c.ws + WS_VT) + (size_t)VT_B * NT;
    float* sQ = (float*)lds_raw;
    float* sKk = sQ + 32 * 64;
    float* sVv = sKk + 32 * 64;
    float* sP = sVv + 32 * 128;
    const int b = unit >> 2, h = unit & 3, tid = c.tid, e = tid & 127, dg = tid >> 7;
    const float gamma = 1.f - exp2f(-5.f - (float)h);
    const float* gn = A->in[4] + (size_t)l * 512 + h * 128;
    float S[16];
#pragma unroll
    for (int i = 0; i < 16; ++i) S[i] = 0.f;
    for (int s0 = 0; s0 < SEQL; s0 += 32) {
        const size_t t0 = (size_t)b * SEQL + s0;
#pragma unroll
        for (int r = 0; r < 4; ++r) { const int it = tid + 512 * r, which = it >> 10, st = (it >> 5) & 31, i = it & 31;
            const bf16* src = P + (t0 + st) * PW + (which ? C_BK : C_BQ) + h * 64;
            const float t1 = bf2f(src[i]), t2 = bf2f(src[i + 32]);
            const float invf = powf(10000.f, -(float)i / 32.f); const float ang = (float)(s0 + st) * invf;
            float sn, cs; sincosf(ang, &sn, &cs);
            const float sc = which ? 0.125f : 1.f; float* dst = (which ? sKk : sQ) + st * 64;
            dst[i] = (t1 * cs - t2 * sn) * sc; dst[i + 32] = (t1 * sn + t2 * cs) * sc; }
#pragma unroll
        for (int r = 0; r < 8; ++r) { const int it = tid + 512 * r, st = it >> 7, ee = it & 127; sVv[st * 128 + ee] = bf2f(VTb[(size_t)(h * 128 + ee) * NT + t0 + st]); }
        __syncthreads();
        for (int st = 0; st < 32; ++st) {
            const float vv = sVv[st * 128 + e]; float po = 0.f;
#pragma unroll
            for (int i4 = 0; i4 < 4; ++i4) { const f32x4 kk = *(const f32x4*)(sKk + st * 64 + dg * 16 + 4 * i4), qq = *(const f32x4*)(sQ + st * 64 + dg * 16 + 4 * i4);
#pragma unroll
                for (int j = 0; j < 4; ++j) { S[4 * i4 + j] = gamma * S[4 * i4 + j] + kk[j] * vv; po += qq[j] * S[4 * i4 + j]; } }
            sP[(st * 4 + dg) * 128 + e] = po;
        }
        __syncthreads();
#pragma unroll
        for (int r = 0; r < 4; ++r) { const int st = c.wave * 4 + r, lane = c.lane;
            float o0 = 0.f, o1 = 0.f;
#pragma unroll
            for (int g = 0; g < 4; ++g) { o0 += sP[(st * 4 + g) * 128 + lane]; o1 += sP[(st * 4 + g) * 128 + lane + 64]; }
            const float mu = wave_sum(o0 + o1) * (1.f / 128.f); const float a0 = o0 - mu, a1 = o1 - mu;
            const float var = wave_sum(a0 * a0 + a1 * a1) * (1.f / 128.f); const float rstd = rsqrtf(var + EPSN);
            bf16* gp = P + (t0 + st) * PW + C_BG + h * 128;
            const float g0 = bf2f(gp[lane]), g1 = bf2f(gp[lane + 64]);
            gp[lane] = (bf16)f2bf(siluf_(g0) * a0 * rstd * gn[lane]); gp[lane + 64] = (bf16)f2bf(siluf_(g1) * a1 * rstd * gn[lane + 64]); }
    }
    __syncthreads();
}

__device__ __forceinline__ void mixer_d_naive(const Ctx& c, ArgP A, unsigned char* lds_raw, int l, int unit) {
    bf16* P = (bf16*)(c.ws + WS_PROJ);
    float* sXs = (float*)lds_raw;
    float* sB = sXs + 32 * 64;
    float* sC = sB + 32 * 128;
    float* sDt = sC + 32 * 128;
    float* sA = sDt + 32;
    float* sP = sA + 32;
    const int b = unit >> 3, hd = unit & 7, g = hd >> 2, tid = c.tid, p = tid & 63, ng = tid >> 6;
    const float* cw = A->in[7] + (size_t)l * 4 * 1024; const float* cb = A->in[8] + (size_t)l * 1024;
    const float dtb = A->in[9][l * 8 + hd], Aneg = -expf(A->in[10][l * 8 + hd]), Dsk = A->in[11][l * 8 + hd];
    const float* ng_ = A->in[12] + (size_t)l * 512 + hd * 64;
    const float* dtr = (const float*)(c.ws + WS_MISC + MS_DT); float* ssq = (float*)(c.ws + WS_MISC + MS_SSQ);
    float S[16];
#pragma unroll
    for (int i = 0; i < 16; ++i) S[i] = 0.f;
    for (int s0 = 0; s0 < SEQL; s0 += 32) {
        const size_t t0 = (size_t)b * SEQL + s0;
        for (int it = tid; it < 32 * 320; it += 512) { const int st = it / 320, ch = it % 320;
            int cc; float* dst;
            if (ch < 64) { cc = hd * 64 + ch; dst = sXs + st * 64 + ch; } else if (ch < 192) { cc = 512 + g * 128 + (ch - 64); dst = sB + st * 128 + (ch - 64); } else { cc = 768 + g * 128 + (ch - 192); dst = sC + st * 128 + (ch - 192); }
            float a = cb[cc];
#pragma unroll
            for (int w = 0; w < 4; ++w) { const int sp = s0 + st - 3 + w; if (sp >= 0) a += cw[w * 1024 + cc] * bf2f(P[((size_t)b * SEQL + sp) * PW + C_DX + cc]); }
            *dst = siluf_(a); }
        if (tid < 32) { const float x = dtr[(t0 + tid) * 8 + hd] + dtb; const float dt = fmaxf(x, 0.f) + log1pf(__expf(-fabsf(x))); sDt[tid] = dt; sA[tid] = __expf(dt * Aneg); }
        __syncthreads();
        for (int st = 0; st < 32; ++st) {
            const float a = sA[st], xdt = sDt[st] * sXs[st * 64 + p]; float po = 0.f;
#pragma unroll
            for (int i4 = 0; i4 < 4; ++i4) { const f32x4 bb = *(const f32x4*)(sB + st * 128 + ng * 16 + 4 * i4), cc4 = *(const f32x4*)(sC + st * 128 + ng * 16 + 4 * i4);
#pragma unroll
                for (int j = 0; j < 4; ++j) { S[4 * i4 + j] = a * S[4 * i4 + j] + bb[j] * xdt; po += cc4[j] * S[4 * i4 + j]; } }
            sP[(st * 8 + ng) * 64 + p] = po;
        }
        __syncthreads();
#pragma unroll
        for (int r = 0; r < 4; ++r) { const int st = c.wave * 4 + r, lane = c.lane;
            float y = 0.f;
#pragma unroll
            for (int q = 0; q < 8; ++q) y += sP[(st * 8 + q) * 64 + lane];
            y += Dsk * sXs[st * 64 + lane];
            bf16* zp = P + (t0 + st) * PW + C_DZ + hd * 64;
            const float yz = y * siluf_(bf2f(zp[lane]));
            const float sq = wave_sum(yz * yz);
            if (lane == 0) ssq[(t0 + st) * 8 + hd] = sq;
            zp[lane] = (bf16)f2bf(yz * ng_[lane]); }
    }
    __syncthreads();
}

__device__ __forceinline__ void xattn_naive(const Ctx& c) {
    const bf16* XQ = (const bf16*)(c.ws + WS_PROJ); bf16* AO = (bf16*)(c.ws + WS_PROJ + 16 * MiB);
    const bf16* KV = (const bf16*)(c.ws + WS_MISC + MS_KV);
    for (int item = c.wg * 512 + c.tid; item < NT * 8; item += c.nwg * 512) {
        const int w = item >> 6, h = w & 3, t = (w >> 2) * 32 + ((item & 63) >> 1), half = item & 1, b = t >> 12;
        const bf16* qp = XQ + (size_t)t * 512 + h * 128 + half * 64;
        float q[64], o[64];
#pragma unroll
        for (int i = 0; i < 8; ++i) { float f[8]; unpack8(*(const u32x4*)(qp + 8 * i), f);
#pragma unroll
            for (int j = 0; j < 8; ++j) { q[8 * i + j] = f[j] * 0.08838834764831845f; o[8 * i + j] = 0.f; } }
        float mrun = -1e30f, lrun = 0.f;
        for (int m = 0; m < 256; ++m) {
            const bf16* kr = KV + (size_t)(b * 256 + m) * 1024 + h * 128 + half * 64; const bf16* vr = kr + 512;
            float sc = 0.f;
#pragma unroll
            for (int i = 0; i < 8; ++i) { float f[8]; unpack8(*(const u32x4*)(kr + 8 * i), f);
#pragma unroll
                for (int jj = 0; jj < 8; ++jj) sc += q[8 * i + jj] * f[jj]; }
            sc += __shfl_xor(sc, 1);
            float p_; if (sc > mrun) { const float r = __expf(mrun - sc); lrun *= r;
#pragma unroll
                for (int i = 0; i < 64; ++i) o[i] *= r;
                mrun = sc; p_ = 1.f; } else p_ = __expf(sc - mrun);
            lrun += p_;
#pragma unroll
            for (int i = 0; i < 8; ++i) { float f[8]; unpack8(*(const u32x4*)(vr + 8 * i), f);
#pragma unroll
                for (int jj = 0; jj < 8; ++jj) o[8 * i + jj] += p_ * f[jj]; }
        }
        const float inv = 1.f / lrun;
        bf16* op = AO + (size_t)t * 512 + h * 128 + half * 64;
#pragma unroll
        for (int i = 0; i < 8; ++i) { u32x4 wv; wv.x = pk2(o[8 * i] * inv, o[8 * i + 1] * inv); wv.y = pk2(o[8 * i + 2] * inv, o[8 * i + 3] * inv);
            wv.z = pk2(o[8 * i + 4] * inv, o[8 * i + 5] * inv); wv.w = pk2(o[8 * i + 6] * inv, o[8 * i + 7] * inv); *(u32x4*)(op + 8 * i) = wv; }
    }
}


#define GEMM_PHASE(EPI_T, Aptr, LDA, Bptr, MM, NN, KK, ...) do { \
    pg8::Gemm g_{(const pg8::bf16_t*)(Aptr), (const pg8::bf16_t*)(Bptr), (MM), (NN), (KK), (LDA)}; pg8::StaticOrder S_; S_.init((MM), (NN), c.nwg, c.wg); \
    EPI_T E_{__VA_ARGS__}; pg8::gemm_phase<EPI_T, pg8::StaticOrder, true, true>((PG8_LAS unsigned char*)lds, g_, S_, E_); } while (0)
#define GEMM_PHASE_C(CIDX, EPI_T, Aptr, LDA, Bptr, MM, NN, KK, ...) do { \
    pg8::Gemm g_{(const pg8::bf16_t*)(Aptr), (const pg8::bf16_t*)(Bptr), (MM), (NN), (KK), (LDA)}; pg8::StaticOrder S_; S_.init((MM), (NN), c.nwg, (CIDX)); \
    EPI_T E_{__VA_ARGS__}; pg8::gemm_phase<EPI_T, pg8::StaticOrder, true, true>((PG8_LAS unsigned char*)lds, g_, S_, E_); } while (0)

__global__ void __launch_bounds__(512, 2) mega_fwd(Args args) {
    extern __shared__ __attribute__((aligned(16))) unsigned char lds[];
    cg::grid_group grid = cg::this_grid();
    {
        volatile LAS unsigned* st0 = (volatile LAS unsigned*)((LAS unsigned char*)lds + LDS_BYTES - 64);
        if (threadIdx.x == 0) { st0[0] = 0u; st0[1] = 0u; }
        __syncthreads();
        (void)xcd_barrier_post((unsigned*)(args.ws + WS_MISC + MS_BAR), st0);
    }
#define GRID_BAR() do { XcdBarrier xb_; xb_.bar = (unsigned*)(ws + WS_MISC + MS_BAR); xb_.x = xb_xcc_id(); xb_.st = (volatile LAS unsigned*)((LAS unsigned char*)lds + LDS_BYTES - 64); xcd_barrier(xb_); } while (0)
#if XSYNC
    { unsigned char* ws = args.ws; for (int i_ = 0; i_ < XSYNC; ++i_) { asm volatile("" : "+s"(i_)); GRID_BAR(); } }
#endif
    int ph = 0;
    const int lo = args.ph_lo, hi = args.ph_hi;
#define PHASE_BEGIN if (ph >= lo && ph < hi) { ArgP ap = (ArgP)__builtin_amdgcn_kernarg_segment_ptr(); asm volatile("" : "+s"(ap)); unsigned char* ws = ap->ws; Ctx c; c.ws = ws; \
    { int t_ = threadIdx.x, g_ = blockIdx.x, n_ = gridDim.x; asm volatile("" : "+v"(t_), "+s"(g_), "+s"(n_)); c.tid = t_; c.lane = t_ & 63; c.wave = __builtin_amdgcn_readfirstlane(t_ >> 6); c.wg = g_; c.nwg = n_; } \
    bf16* Wb = (bf16*)(ws + WS_W); bf16* XN = (bf16*)(ws + WS_XN); bf16* PJ = (bf16*)(ws + WS_PROJ); float* X = ap->out; (void)Wb; (void)XN; (void)PJ; (void)X;
#define PHASE_END   if (ph + 1 < hi) { if (ph == 0) grid.sync(); else GRID_BAR(); } } ++ph;

    for (int l = 0; l < 2; ++l) {
        asm volatile("" : "+s"(l));
        PHASE_BEGIN for (int rep_ = 0; rep_ <= ((REPMASK >> 0) & 1); ++rep_) {
            convert_layer(c, ap, lds, l);
            if (c.wg == 0 && c.tid < 16) ((unsigned*)(ws + WS_MISC + MS_CNT))[l * 16 + c.tid] = 0u;
            { float* rz = (float*)(ws + WS_MISC + MS_SSQ); for (int i = c.wg * 512 + c.tid; i < 2 * NT; i += c.nwg * 512) rz[i] = 0.f; }
            if (l == 0) { float* rope = (float*)(ws + WS_MISC + MS_ROPE);
                for (int it = c.wg * 512 + c.tid; it < SEQL * 32; it += c.nwg * 512) { const int i = it & 31; const float ang = (float)(it >> 5) * powf(10000.f, -(float)i / 32.f); float sn, cs; sincosf(ang, &sn, &cs); rope[2 * it] = cs; rope[2 * it + 1] = sn; } }
            { float* wdt = (float*)(lds + 32768); const float* wsrc = ap->in[3] + (size_t)l * DM * INW + 6144;
                __syncthreads();
                for (int i = c.tid; i < 2048; i += 512) *(f32x4*)(wdt + i * 4) = *(const f32x4*)(wsrc + (size_t)(i >> 1) * INW + (i & 1) * 4);
                __syncthreads();
                norm_rows(c, (l == 0) ? ap->in[0] : X, ap->in[2] + (size_t)l * DM, XN, NT, wdt, (float*)(ws + WS_MISC + MS_DT)); }
            norm_rows(c, ap->in[1], ap->in[16] + (size_t)l * DM, (bf16*)(ws + WS_MISC + MS_MN), 1024, nullptr, nullptr);
        } PHASE_END
        PHASE_BEGIN for (int rep_ = 0; rep_ <= ((REPMASK >> 1) & 1); ++rep_) {
            GEMM_PHASE(pg8::EpiStore<0>, XN, 1024, Wb + W_IN, NT, 5120, 1024, PJ, PW, nullptr);
            GEMM_PHASE(pg8::EpiStore<0>, (bf16*)(ws + WS_WVT), 1024, XN, 1024, NT, 1024, (bf16*)(ws + WS_VT), NT, nullptr);
        } PHASE_END
        PHASE_BEGIN for (int rep_ = 0; rep_ <= ((REPMASK >> 2) & 1); ++rep_) {
#if DRYMASK & 128
            { int dry1_ = 1; asm volatile("" : "+s"(dry1_)); conv_prepass(c, ap, l, ws, lds, dry1_); }
#endif
#if PROBE
            if (c.wg == 0 && c.tid == 0) ((unsigned long long*)(ws + WS_MISC + MS_CNT + 1024))[0] = __builtin_amdgcn_s_memrealtime();
#endif
            conv_prepass(c, ap, l, ws, lds, 0);
            GRID_BAR();
#if PROBE
            if (c.wg == 0 && c.tid == 0) ((unsigned long long*)(ws + WS_MISC + MS_CNT + 1024))[1] = __builtin_amdgcn_s_memrealtime();
#endif
            int dry0 = 0; asm volatile("" : "+s"(dry0));
            unsigned* cnt = (unsigned*)(ws + WS_MISC + MS_CNT) + l * 16;
#if DRYMASK & 256
            for (int rr_ = 0; rr_ < 2; ++rr_) { int dryr = 1 - rr_; asm volatile("" : "+s"(dryr)); unsigned* cntr = cnt + 8 * (1 - rr_);
            if (c.wg < 64) mixer_d_mfma(c, ap, lds, l, c.wg >> 2, c.wg & 3, dryr);
            else if (c.wg < 128) mixer_b_mfma(c, ap, lds, l, (c.wg - 64) >> 2, c.wg & 3, dryr);
            mixer_c_mfma(c, ap, lds, l, dryr, cntr);
            mixer_a_mfma(c, lds, dryr, cntr + 1);
            GRID_BAR(); }
#else
            if (c.wg < 64) mixer_d_mfma(c, ap, lds, l, c.wg >> 2, c.wg & 3, dry0);
            else if (c.wg < 128) mixer_b_mfma(c, ap, lds, l, (c.wg - 64) >> 2, c.wg & 3, dry0);
#if DRYMASK & 4
            { int dry1 = 1; asm volatile("" : "+s"(dry1)); mixer_c_mfma(c, ap, lds, l, dry1, cnt + 3); }
#endif
            mixer_c_mfma(c, ap, lds, l, dry0, cnt);
#if DRYMASK & 2
            { int dry1 = 1; asm volatile("" : "+s"(dry1)); mixer_a_mfma(c, lds, dry1, cnt + 2); __syncthreads(); }
#endif
            mixer_a_mfma(c, lds, dry0, cnt + 1);
#endif
        } PHASE_END
        PHASE_BEGIN for (int rep_ = 0; rep_ <= ((REPMASK >> 3) & 1); ++rep_) {
#if PROBE
            if (c.wg == 0 && c.tid == 0 && rep_ == 0) ((unsigned long long*)(ws + WS_MISC + MS_CNT + 1024))[2] = __builtin_amdgcn_s_memrealtime();
#endif
            {
                pg8::Gemm g_{(const pg8::bf16_t*)XN, (const pg8::bf16_t*)(Wb + W_G), NT, 1024, 1024, 1024, 0u, 0u, 0u, 0u, 1024u * 1024u * 2u};
                pg8::BranchOrder S_; S_.init(NT, 1024, c.nwg, c.wg, 4);
                pg8::EpiGate8 E_{(unsigned char*)PJ, PW * 2};
                pg8::gemm_phase<pg8::EpiGate8, pg8::BranchOrder, true, true>((PG8_LAS unsigned char*)lds, g_, S_, E_); }
            {
                pg8::Gemm g_{(const pg8::bf16_t*)PJ, (const pg8::bf16_t*)(Wb + W_B), NT, 1024, 512, PW, (unsigned)C_AQ * 2u, (unsigned)C_BG * 2u, (unsigned)C_CQ * 2u, (unsigned)C_DZ * 2u, 1024u * 512u * 2u};
                pg8::BranchOrder S_; S_.init(NT, 1024, c.nwg, c.wg, 4);
                pg8::EpiGateAcc8 E_{(const unsigned char*)PJ, PW * 2, (pg8::bf16_t*)(PJ + C_MG), PW, (const float*)(ws + WS_SSQ32)};
                pg8::gemm_phase<pg8::EpiGateAcc8, pg8::BranchOrder, true, true>((PG8_LAS unsigned char*)lds, g_, S_, E_); }
        } PHASE_END
        PHASE_BEGIN for (int rep_ = 0; rep_ <= ((REPMASK >> 4) & 1); ++rep_) {
#if DRYMASK & 64
            { int dry1_ = 1; asm volatile("" : "+s"(dry1_));
            GEMM_PHASE(pg8::EpiResid, PJ + C_MG, PW, Wb + W_MO, NT, 1024, 1024, (l == 0) ? ap->in[0] : X, X, XN, (float*)(ws + WS_MISC + MS_SSQ), dry1_);
            }
#endif
            GEMM_PHASE(pg8::EpiResid, PJ + C_MG, PW, Wb + W_MO, NT, 1024, 1024, (l == 0) ? ap->in[0] : X, X, XN, (float*)(ws + WS_MISC + MS_SSQ), 0);
        } PHASE_END
        PHASE_BEGIN for (int rep_ = 0; rep_ <= ((REPMASK >> 5) & 1); ++rep_) {
            GEMM_PHASE(pg8::EpiStore<0>, XN, 1024, Wb + W_XQ, NT, 512, 1024, PJ, 512, (const float*)(ws + WS_MISC + MS_SSQ));
            GEMM_PHASE_C((c.wg + c.nwg - 128) % c.nwg, pg8::EpiStore<0>, (bf16*)(ws + WS_MISC + MS_MN), 1024, Wb + W_XKV, 1024, 512, 1024, (bf16*)(ws + WS_MISC + MS_KV), 512, nullptr);
            GEMM_PHASE_C((c.wg + c.nwg - 144) % c.nwg, pg8::EpiStore<0>, Wb + W_XKV + (size_t)512 * 1024, 1024, (bf16*)(ws + WS_MISC + MS_MN), 512, 1024, 1024, (bf16*)(ws + WS_MISC + MS_VTX), 1024, nullptr);
        } PHASE_END
        PHASE_BEGIN for (int rep_ = 0; rep_ <= ((REPMASK >> 6) & 1); ++rep_) {
#if DRYMASK & 32
            { int dry1 = 1; asm volatile("" : "+s"(dry1)); if (c.wg < 16) mixer_d_mfma(c, ap, lds, l, c.wg, DRYSEG, dry1); }
#endif
            xattn_mfma(c, lds);
        } PHASE_END
        PHASE_BEGIN for (int rep_ = 0; rep_ <= ((REPMASK >> 7) & 1); ++rep_) {
#if DRYMASK & 64
            { int dry1_ = 1; asm volatile("" : "+s"(dry1_));
            GEMM_PHASE(pg8::EpiResid, (bf16*)(ws + WS_PROJ + 16 * MiB), 512, Wb + W_XO, NT, 1024, 512, X, X, XN, (float*)(ws + WS_MISC + MS_SSQ) + NT, dry1_);
            }
#endif
            GEMM_PHASE(pg8::EpiResid, (bf16*)(ws + WS_PROJ + 16 * MiB), 512, Wb + W_XO, NT, 1024, 512, X, X, XN, (float*)(ws + WS_MISC + MS_SSQ) + NT, 0);
        } PHASE_END
        PHASE_BEGIN for (int rep_ = 0; rep_ <= ((REPMASK >> 8) & 1); ++rep_) {
            GEMM_PHASE(pg8::EpiSwiglu, XN, 1024, Wb + W_FI, NT, 5632, 1024, PJ, FFH, (const float*)(ws + WS_MISC + MS_SSQ) + NT);
        } PHASE_END
        PHASE_BEGIN for (int rep_ = 0; rep_ <= ((REPMASK >> 9) & 1); ++rep_) {
#if DRYMASK & 64
            { int dry1_ = 1; asm volatile("" : "+s"(dry1_));
            GEMM_PHASE(pg8::EpiResid, PJ, FFH, Wb + W_FO, NT, 1024, FFH, X, X, nullptr, nullptr, dry1_);
            }
#endif
            GEMM_PHASE(pg8::EpiResid, PJ, FFH, Wb + W_FO, NT, 1024, FFH, X, X, nullptr, nullptr, 0);
        } PHASE_END
    }
    PHASE_BEGIN for (int rep_ = 0; rep_ <= ((REPMASK >> 10) & 1); ++rep_) {
        final_norm(c, X, ap->in[23]);
#if PROBE
        GRID_BAR();
        if (c.wg == 0) { const unsigned long long* tsb = (const unsigned long long*)(ws + WS_MISC + MS_CNT + 1024);
            const float T = (float)(tsb[PROBE_HI] - tsb[PROBE_LO]) * 0.01f;
            const int n = (int)(T * 800.f);
            for (int i = c.tid; i < n && i < 4000000; i += 512) X[i] += 0.08f; }
#endif
    } PHASE_END
}

extern "C" void kernel_launch(void* const* d_in, const int* in_sizes, int n_in, void* d_out, int out_size, void* d_ws, size_t ws_size, hipStream_t stream) {
    static int grid_blocks = 0;
    if (grid_blocks == 0) {
        if (n_in != 24 || out_size != NT * DM || ws_size < WS_END) { fprintf(stderr, "kernel_launch: unexpected shapes (n_in %d out %d ws %zu)\n", n_in, out_size, ws_size); grid_blocks = -1; return; }
        int dev = 0, cus = 0, per_cu = 0;
        hipGetDevice(&dev);
        hipDeviceGetAttribute(&cus, hipDeviceAttributeMultiprocessorCount, dev);
        if (hipFuncSetAttribute((const void*)mega_fwd, hipFuncAttributeMaxDynamicSharedMemorySize, LDS_BYTES) != hipSuccess) { fprintf(stderr, "kernel_launch: hipFuncSetAttribute failed\n"); grid_blocks = -1; return; }
        if (hipOccupancyMaxActiveBlocksPerMultiprocessor(&per_cu, (const void*)mega_fwd, 512, LDS_BYTES) != hipSuccess || per_cu < 1) { fprintf(stderr, "kernel_launch: occupancy query says %d\n", per_cu); per_cu = 1; }
        (void)hipGetLastError();
        grid_blocks = cus * 1;
        fprintf(stderr, "kernel_launch: grid %d (cus %d, per_cu %d)\n", grid_blocks, cus, per_cu);
    }
    if (grid_blocks < 0) return;
    if (hipMemsetAsync((char*)d_ws + WS_MISC + MS_FLG, 0, 1024, stream) != hipSuccess) { fprintf(stderr, "kernel_launch: memset failed\n"); return; }
    if (hipMemsetAsync((char*)d_ws + WS_MISC + MS_BAR, 0, XCD_BAR_WORDS * 4, stream) != hipSuccess) { fprintf(stderr, "kernel_launch: memset failed\n"); return; }
    Args a{};
    for (int i = 0; i < 24; ++i) a.in[i] = (const float*)d_in[i];
    a.out = (float*)d_out; a.ws = (unsigned char*)d_ws; a.ph_lo = 0; a.ph_hi = 1000;
    void* kargs[] = {&a};
    hipError_t e = hipLaunchCooperativeKernel((const void*)mega_fwd, dim3(grid_blocks), dim3(512), kargs, LDS_BYTES, stream);
    if (e != hipSuccess) fprintf(stderr, "kernel_launch: cooperative launch failed: %s (grid %d)\n", hipGetErrorString(e), grid_blocks);
}
```
